# Optimizing an MI355X kernel written in HIP

```python
import math
import jax
import jax.numpy as jnp
from jax import lax
import numpy as np

D_MODEL = 1024
BATCH = 8
SEQ = 2048
DEPTH = 2

GRID_W = 64
CTX_LEN = 256
HEAD_DIM = 64
ROPE_BASE = 10000.0
ROPE_QUARTER = HEAD_DIM // 4
NORM_EPS = 1e-6
NEG_INF = -1e30
F32 = jnp.float32

S5_WIDTH = D_MODEL // 2
S5_GROUP = 16
S5_GROUPS = S5_WIDTH // S5_GROUP
S5_STATE = 64
WA_Q_HEADS = (D_MODEL // 2) // HEAD_DIM
WA_KV_HEADS = 2
WA_GROUP = WA_Q_HEADS // WA_KV_HEADS
WINDOW = 128
WIN_BLOCK = 128
WA_Q_WIDTH = WA_Q_HEADS * HEAD_DIM
WA_KV_WIDTH = WA_KV_HEADS * HEAD_DIM
EVEN_IN_WIDTH = S5_WIDTH + WA_Q_WIDTH + 2 * WA_KV_WIDTH
EVEN_MIX_WIDTH = S5_WIDTH + WA_Q_WIDTH
DA_HEADS = D_MODEL // (2 * HEAD_DIM)
DA_BLOCK = 128
DA_WIDTH = DA_HEADS * 2 * HEAD_DIM
N_EXPERTS = 16
D_EXPERT = 2 * D_MODEL
CAPACITY_FACTOR = 2

N_EVEN = (DEPTH + 1) // 2
N_ODD = DEPTH // 2

kernel_name = 'hybrid_s5_swa_diffattn_ecmoe_diffusion'


def rmsnorm(t, g):
    tf = t.astype(F32)
    y = tf * lax.rsqrt(jnp.mean(tf * tf, axis=-1, keepdims=True) + NORM_EPS)
    return (y * g.astype(F32)).astype(t.dtype)


def modulate(h, shift, scale):
    return h * (1 + scale) + shift


def axial_rope_tables(n_tokens, dtype):
    rows = n_tokens // GRID_W
    row = jnp.repeat(jnp.arange(rows), GRID_W).astype(F32)
    col = jnp.tile(jnp.arange(GRID_W), rows).astype(F32)
    inv = ROPE_BASE ** (-jnp.arange(ROPE_QUARTER, dtype=F32) / ROPE_QUARTER)
    ang_r = row[:, None] * inv[None, :]
    ang_c = col[:, None] * inv[None, :]
    ang = jnp.concatenate([ang_r, ang_r, ang_c, ang_c], axis=-1)
    return jnp.cos(ang).astype(dtype), jnp.sin(ang).astype(dtype)


def apply_rope(t, cos, sin):
    r = ROPE_QUARTER
    rot = jnp.concatenate([-t[..., r:2 * r], t[..., :r], -t[..., 3 * r:], t[..., 2 * r:3 * r]], axis=-1)
    shape = (1, cos.shape[0]) + (1,) * (t.ndim - 3) + (HEAD_DIM,)
    return t * cos.reshape(shape) + rot * sin.reshape(shape)


def s5_discretise(lam_re, lam_im, log_step, b_re, b_im):
    dt = jnp.exp(log_step)[:, None]
    mag = jnp.exp(lam_re * dt)
    a_re = mag * jnp.cos(lam_im * dt)
    a_im = mag * jnp.sin(lam_im * dt)
    den = lam_re * lam_re + lam_im * lam_im
    f_re = ((a_re - 1.0) * lam_re + a_im * lam_im) / den
    f_im = (a_im * lam_re - (a_re - 1.0) * lam_im) / den
    bb_re = f_re[..., None] * b_re - f_im[..., None] * b_im
    bb_im = f_re[..., None] * b_im + f_im[..., None] * b_re
    return a_re, a_im, bb_re, bb_im


def _cscan_op(e1, e2):
    a1r, a1i, b1r, b1i = e1
    a2r, a2i, b2r, b2i = e2
    return (a2r * a1r - a2i * a1i, a2r * a1i + a2i * a1r,
            a2r * b1r - a2i * b1i + b2r, a2r * b1i + a2i * b1r + b2i)


def complex_diag_scan(a_re, a_im, bu_re, bu_im, reverse):
    shape = (bu_re.shape[0], 1) + a_re.shape
    ar = jnp.broadcast_to(a_re[None, None], shape)
    ai = jnp.broadcast_to(a_im[None, None], shape)
    _, _, h_re, h_im = lax.associative_scan(_cscan_op, (ar, ai, bu_re, bu_im), reverse=reverse, axis=0)
    return h_re, h_im


def s5_readout(c_re, c_im, h_re, h_im):
    return jnp.einsum('gcp,lbgp->blgc', c_re, h_re) - jnp.einsum('gcp,lbgp->blgc', c_im, h_im)


def s5_output(y, u, dtype, d_skip, glu_w, glu_b):
    bsz, n = y.shape[:2]
    y = y.reshape(bsz, n, S5_WIDTH) + d_skip.astype(F32) * u.reshape(bsz, n, S5_WIDTH)
    z = jax.nn.gelu(y.astype(dtype))
    return z * jax.nn.sigmoid(z @ glu_w + glu_b)


def s5_mixer(u_lat, u_ctx, lam_re, lam_im, log_step, b_re, b_im, c_re, c_im, d_skip, glu_w, glu_b, need_ctx):
    bsz, n_lat, _ = u_lat.shape
    n_ctx = u_ctx.shape[1]
    ul = u_lat.astype(F32).reshape(bsz, n_lat, S5_GROUPS, S5_GROUP)
    uc = u_ctx.astype(F32).reshape(bsz, n_ctx, S5_GROUPS, S5_GROUP)
    y_lat = 0.0
    y_ctx = 0.0
    for k, rev in ((0, False), (1, True)):
        a_re, a_im, bb_re, bb_im = s5_discretise(lam_re[k].astype(F32), lam_im[k].astype(F32),
                                                 log_step[k].astype(F32), b_re[k].astype(F32), b_im[k].astype(F32))
        cr, ci = c_re[k].astype(F32), c_im[k].astype(F32)
        hc_re, hc_im = complex_diag_scan(a_re, a_im, jnp.einsum('blgh,gph->lbgp', uc, bb_re),
                                         jnp.einsum('blgh,gph->lbgp', uc, bb_im), rev)
        end = 0 if rev else -1
        h0_re, h0_im = hc_re[end], hc_im[end]
        bl_re = jnp.einsum('blgh,gph->lbgp', ul, bb_re)
        bl_im = jnp.einsum('blgh,gph->lbgp', ul, bb_im)
        first = -1 if rev else 0
        bl_re = bl_re.at[first].add(a_re * h0_re - a_im * h0_im)
        bl_im = bl_im.at[first].add(a_re * h0_im + a_im * h0_re)
        hl_re, hl_im = complex_diag_scan(a_re, a_im, bl_re, bl_im, rev)
        y_lat = y_lat + s5_readout(cr, ci, hl_re, hl_im)
        if need_ctx:
            y_ctx = y_ctx + s5_readout(cr, ci, hc_re, hc_im)
    out_lat = s5_output(y_lat, ul, u_lat.dtype, d_skip, glu_w, glu_b)
    out_ctx = s5_output(y_ctx, uc, u_ctx.dtype, d_skip, glu_w, glu_b) if need_ctx else None
    return out_lat, out_ctx


def window_attn_latent(q, k, v, kc, vc, sink):
    bsz, n = q.shape[:2]
    n_ctx = kc.shape[1]
    nb = n // WIN_BLOCK
    scale = HEAD_DIM ** -0.5
    qb = q.reshape(bsz, nb, WIN_BLOCK, WA_KV_HEADS, WA_GROUP, HEAD_DIM)

    def band(t):
        tp = jnp.pad(t, ((0, 0), (WIN_BLOCK, WIN_BLOCK), (0, 0), (0, 0)))
        tp = tp.reshape(bsz, nb + 2, WIN_BLOCK, WA_KV_HEADS, HEAD_DIM)
        return jnp.concatenate([tp[:, :-2], tp[:, 1:-1], tp[:, 2:]], axis=2)

    kw, vw = band(k), band(v)
    s_win = jnp.einsum('bnqkgd,bnskd->bnkgqs', qb, kw).astype(F32) * scale
    s_ctx = jnp.einsum('bnqkgd,bckd->bnkgqc', qb, kc).astype(F32) * scale
    qpos = jnp.arange(nb)[:, None, None] * WIN_BLOCK + jnp.arange(WIN_BLOCK)[None, :, None]
    kpos = (jnp.arange(nb)[:, None, None] - 1) * WIN_BLOCK + jnp.arange(3 * WIN_BLOCK)[None, None, :]
    valid = (jnp.abs(kpos - qpos) <= WINDOW) & (kpos >= 0) & (kpos < n)
    s_win = jnp.where(valid[None, :, None, None], s_win, NEG_INF)
    s_sink = jnp.broadcast_to(sink.astype(F32).reshape(1, 1, WA_KV_HEADS, WA_GROUP, 1, 1), s_ctx.shape[:-1] + (1,))
    p = jax.nn.softmax(jnp.concatenate([s_ctx, s_win, s_sink], axis=-1), axis=-1).astype(v.dtype)
    o = (jnp.einsum('bnkgqc,bckd->bnqkgd', p[..., :n_ctx], vc)
         + jnp.einsum('bnkgqs,bnskd->bnqkgd', p[..., n_ctx:n_ctx + 3 * WIN_BLOCK], vw))
    return o.reshape(bsz, n, WA_Q_WIDTH)


def window_attn_context(qc, kc, vc, sink):
    bsz, n_ctx = qc.shape[:2]
    scale = HEAD_DIM ** -0.5
    qg = qc.reshape(bsz, n_ctx, WA_KV_HEADS, WA_GROUP, HEAD_DIM)
    s = jnp.einsum('bqkgd,bckd->bkgqc', qg, kc).astype(F32) * scale
    s_sink = jnp.broadcast_to(sink.astype(F32).reshape(1, WA_KV_HEADS, WA_GROUP, 1, 1), s.shape[:-1] + (1,))
    p = jax.nn.softmax(jnp.concatenate([s, s_sink], axis=-1), axis=-1)[..., :n_ctx].astype(vc.dtype)
    o = jnp.einsum('bkgqc,bckd->bqkgd', p, vc)
    return o.reshape(bsz, n_ctx, WA_Q_WIDTH)


def even_mixer(hx, hc, cos, sin, w_in, w_out, lam_re, lam_im, log_step, b_re, b_im, c_re, c_im,
               d_skip, glu_w, glu_b, sink, need_ctx):
    def split(p):
        bsz, n = p.shape[:2]
        o = S5_WIDTH
        u = p[..., :o]
        q = p[..., o:o + WA_Q_WIDTH].reshape(bsz, n, WA_Q_HEADS, HEAD_DIM)
        o += WA_Q_WIDTH
        k = p[..., o:o + WA_KV_WIDTH].reshape(bsz, n, WA_KV_HEADS, HEAD_DIM)
        o += WA_KV_WIDTH
        v = p[..., o:].reshape(bsz, n, WA_KV_HEADS, HEAD_DIM)
        return u, q, k, v

    ux, qx, kx, vx = split(hx @ w_in)
    uc, qc, kc, vc = split(hc @ w_in)
    qx = apply_rope(qx, cos, sin)
    kx = apply_rope(kx, cos, sin)
    sx, sc = s5_mixer(ux, uc, lam_re, lam_im, log_step, b_re, b_im, c_re, c_im, d_skip, glu_w, glu_b, need_ctx)
    ax = window_attn_latent(qx, kx, vx, kc, vc, sink)
    ox = jnp.concatenate([sx, ax], axis=-1) @ w_out
    oc = None
    if need_ctx:
        ac = window_attn_context(qc, kc, vc, sink)
        oc = jnp.concatenate([sc, ac], axis=-1) @ w_out
    return ox, oc


def diff_attn_block(q, k_all, v_all, lam):
    s = jnp.einsum('bqhjd,bshjd->bhjqs', q, k_all).astype(F32) * (HEAD_DIM ** -0.5)
    p = jax.nn.softmax(s, axis=-1)
    a = (p[:, :, 0] - lam * p[:, :, 1]).astype(v_all.dtype)
    return jnp.einsum('bhqs,bshe->bqhe', a, v_all)


def diff_attn_latent(q, k, v, kc, vc, lam):
    bsz, n = q.shape[:2]
    nb = n // DA_BLOCK
    k_all = jnp.concatenate([kc, k], axis=1)
    v_all = jnp.concatenate([vc, v], axis=1)
    qb = q.reshape(bsz, nb, DA_BLOCK, DA_HEADS, 2, HEAD_DIM).transpose(1, 0, 2, 3, 4, 5)
    o = lax.map(lambda qblk: diff_attn_block(qblk, k_all, v_all, lam), qb)
    return o.transpose(1, 0, 2, 3, 4).reshape(bsz, n, DA_HEADS, 2 * HEAD_DIM)


def odd_mixer(hx, hc, cos, sin, w_in, w_out, lq1, lk1, lq2, lk2, subln_g, lam_init, need_ctx):
    def split(p):
        bsz, n = p.shape[:2]
        q = p[..., :DA_WIDTH].reshape(bsz, n, DA_HEADS, 2, HEAD_DIM)
        k = p[..., DA_WIDTH:2 * DA_WIDTH].reshape(bsz, n, DA_HEADS, 2, HEAD_DIM)
        v = p[..., 2 * DA_WIDTH:].reshape(bsz, n, DA_HEADS, 2 * HEAD_DIM)
        return q, k, v

    qx, kx, vx = split(hx @ w_in)
    qc, kc, vc = split(hc @ w_in)
    qx = apply_rope(qx, cos, sin)
    kx = apply_rope(kx, cos, sin)
    lam = (jnp.exp(jnp.sum(lq1.astype(F32) * lk1.astype(F32)))
           - jnp.exp(jnp.sum(lq2.astype(F32) * lk2.astype(F32))) + lam_init)

    def post(o):
        bsz, n = o.shape[:2]
        return (rmsnorm(o, subln_g) * (1.0 - lam_init)).reshape(bsz, n, DA_WIDTH) @ w_out

    ox = post(diff_attn_latent(qx, kx, vx, kc, vc, lam))
    oc = post(diff_attn_block(qc, kc, vc, lam)) if need_ctx else None
    return ox, oc


def ec_moe(h, w_router, w_gate, w_up, w_down):
    bsz, n, d = h.shape
    cap = CAPACITY_FACTOR * n // N_EXPERTS
    aff = jax.nn.softmax(jnp.einsum('bld,de->ble', h, w_router).astype(F32), axis=-1)
    gates, idx = lax.top_k(aff.transpose(0, 2, 1), cap)
    xg = jax.vmap(lambda hb, ib: hb[ib])(h, idx)
    hid = jax.nn.silu(jnp.einsum('becd,edf->becf', xg, w_gate)) * jnp.einsum('becd,edf->becf', xg, w_up)
    y = jnp.einsum('becf,efd->becd', hid, w_down) * gates[..., None].astype(h.dtype)
    return jax.vmap(lambda yb, ib: jnp.zeros((n, d), h.dtype).at[ib.reshape(-1)].add(yb.reshape(-1, d)))(y, idx)


def setup_inputs(seed: int = 0) -> dict:
    key = jax.random.key(seed)
    ks = iter(jax.random.split(key, 48))

    def nrm(shape, s):
        return jax.random.normal(next(ks), shape, F32) * s

    D = D_MODEL
    G, P, GH = S5_GROUPS, S5_STATE, S5_GROUP
    n_idx = jnp.arange(P, dtype=F32)
    return {
        'x': nrm((BATCH, SEQ, D), 1.0),
        'c': nrm((BATCH, D), 1.0),
        'ctx': nrm((BATCH, CTX_LEN, D), 1.0),
        'c_ctx': nrm((D,), 1.0),
        'ada_w': nrm((DEPTH, D, 6 * D), 0.3 * D ** -0.5),
        'ada_b': nrm((DEPTH, 6 * D), 0.02),
        'norm_mix_g': 1.0 + nrm((DEPTH, D), 0.05),
        'norm_ffn_g': 1.0 + nrm((DEPTH, D), 0.05),
        'ev_w_in': nrm((N_EVEN, D, EVEN_IN_WIDTH), D ** -0.5),
        'ev_w_out': nrm((N_EVEN, EVEN_MIX_WIDTH, D), EVEN_MIX_WIDTH ** -0.5),
        's5_lam_re': -0.5 + nrm((N_EVEN, 2, G, P), 0.01),
        's5_lam_im': math.pi * n_idx + nrm((N_EVEN, 2, G, P), 0.01),
        's5_log_step': jax.random.uniform(next(ks), (N_EVEN, 2, G), F32, math.log(1e-3), math.log(1e-1)),
        's5_b_re': nrm((N_EVEN, 2, G, P, GH), (2 * GH) ** -0.5),
        's5_b_im': nrm((N_EVEN, 2, G, P, GH), (2 * GH) ** -0.5),
        's5_c_re': nrm((N_EVEN, 2, G, GH, P), (2 * P) ** -0.5),
        's5_c_im': nrm((N_EVEN, 2, G, GH, P), (2 * P) ** -0.5),
        's5_d': nrm((N_EVEN, S5_WIDTH), 1.0),
        's5_glu_w': nrm((N_EVEN, S5_WIDTH, S5_WIDTH), S5_WIDTH ** -0.5),
        's5_glu_b': nrm((N_EVEN, S5_WIDTH), 0.02),
        'wa_sink': nrm((N_EVEN, WA_Q_HEADS), 0.5),
        'od_w_in': nrm((N_ODD, D, 3 * DA_WIDTH), D ** -0.5),
        'od_w_out': nrm((N_ODD, DA_WIDTH, D), DA_WIDTH ** -0.5),
        'da_lq1': nrm((N_ODD, HEAD_DIM), 0.1),
        'da_lk1': nrm((N_ODD, HEAD_DIM), 0.1),
        'da_lq2': nrm((N_ODD, HEAD_DIM), 0.1),
        'da_lk2': nrm((N_ODD, HEAD_DIM), 0.1),
        'da_subln_g': 1.0 + nrm((N_ODD, 2 * HEAD_DIM), 0.05),
        'moe_router': nrm((DEPTH, D, N_EXPERTS), D ** -0.5),
        'moe_w_gate': nrm((DEPTH, N_EXPERTS, D, D_EXPERT), D ** -0.5),
        'moe_w_up': nrm((DEPTH, N_EXPERTS, D, D_EXPERT), D ** -0.5),
        'moe_w_down': nrm((DEPTH, N_EXPERTS, D_EXPERT, D), D_EXPERT ** -0.5),
        'final_g': 1.0 + nrm((D,), 0.05),
    }


def reference(x, c, ctx, c_ctx, ada_w, ada_b, norm_mix_g, norm_ffn_g, ev_w_in, ev_w_out,
              s5_lam_re, s5_lam_im, s5_log_step, s5_b_re, s5_b_im, s5_c_re, s5_c_im, s5_d,
              s5_glu_w, s5_glu_b, wa_sink, od_w_in, od_w_out, da_lq1, da_lk1, da_lq2, da_lk2,
              da_subln_g, moe_router, moe_w_gate, moe_w_up, moe_w_down, final_g):
    n_lat = x.shape[1]
    cos, sin = axial_rope_tables(n_lat, x.dtype)
    xs, cs = x, ctx
    for l in range(DEPTH):
        need_ctx = l < DEPTH - 1
        ml = jnp.split((jax.nn.silu(c) @ ada_w[l] + ada_b[l])[:, None, :], 6, axis=-1)
        mc = jnp.split((jax.nn.silu(c_ctx) @ ada_w[l] + ada_b[l])[None, None, :], 6, axis=-1)
        hx = modulate(rmsnorm(xs, norm_mix_g[l]), ml[0], ml[1])
        hc = modulate(rmsnorm(cs, norm_mix_g[l]), mc[0], mc[1])
        i = l // 2
        if l % 2 == 0:
            ox, oc = even_mixer(hx, hc, cos, sin, ev_w_in[i], ev_w_out[i], s5_lam_re[i], s5_lam_im[i],
                                s5_log_step[i], s5_b_re[i], s5_b_im[i], s5_c_re[i], s5_c_im[i], s5_d[i],
                                s5_glu_w[i], s5_glu_b[i], wa_sink[i], need_ctx)
        else:
            lam_init = 0.8 - 0.6 * math.exp(-0.3 * l)
            ox, oc = odd_mixer(hx, hc, cos, sin, od_w_in[i], od_w_out[i], da_lq1[i], da_lk1[i],
                               da_lq2[i], da_lk2[i], da_subln_g[i], lam_init, need_ctx)
        xs = xs + ml[2] * ox
        hx = modulate(rmsnorm(xs, norm_ffn_g[l]), ml[3], ml[4])
        xs = xs + ml[5] * ec_moe(hx, moe_router[l], moe_w_gate[l], moe_w_up[l], moe_w_down[l])
        if need_ctx:
            cs = cs + mc[2] * oc
            hc = modulate(rmsnorm(cs, norm_ffn_g[l]), mc[3], mc[4])
            cs = cs + mc[5] * ec_moe(hc, moe_router[l], moe_w_gate[l], moe_w_up[l], moe_w_down[l])
    return rmsnorm(xs, final_g)
```

```cpp
#include <hip/hip_runtime.h>
#include <cstdio>
#include <cstdint>
#include <cmath>

#define LAS __attribute__((address_space(3)))
#define GAS __attribute__((address_space(1)))
#define DI __device__ __forceinline__
typedef unsigned short bf16_t;
typedef short bf16x8 __attribute__((ext_vector_type(8)));
typedef short s16x4 __attribute__((ext_vector_type(4)));
typedef float f32x4 __attribute__((ext_vector_type(4)));
typedef float f32x2 __attribute__((ext_vector_type(2)));
typedef float f32x16 __attribute__((ext_vector_type(16)));
typedef unsigned u32x4 __attribute__((ext_vector_type(4)));
typedef unsigned u32x2 __attribute__((ext_vector_type(2)));
typedef __bf16 bf16x2_t __attribute__((ext_vector_type(2)));

constexpr int DM = 1024, NB = 8, NL = 2048, NC = 256;
constexpr int ROWS_L = NB * NL, ROWS_C = NB * NC, ROWS = ROWS_L + ROWS_C;
constexpr int NPOS = NC + NL;
constexpr int NE = 16, DE = 2048, CAP_L = 256, CAP_C = 32;
constexpr int S5G = 32, S5P = 64, S5T = 64;
constexpr int S5_MROWS = 512, S5_VALID = 288, S5_KC = 1280;
constexpr float NORM_EPS = 1e-6f;
constexpr float LAM_INIT1 = 0.35550906759f;

constexpr size_t MiB = 1u << 20;
constexpr size_t WS_CTL = 0, CTL_BYTES = 1 * MiB;
constexpr size_t WS_MOD = 1 * MiB;
constexpr size_t WS_ROPE = 2 * MiB;
constexpr size_t WS_APOW = 2 * MiB + 65536;
constexpr size_t WS_DBG = 2 * MiB + 262144;
constexpr size_t WS_KTAB = 3 * MiB;
constexpr size_t WS_WIN0T = 8 * MiB;
constexpr size_t WS_WGLUT = 11 * MiB;
constexpr size_t WS_WOUT0T = 12 * MiB;
constexpr size_t WS_WIN1T = 14 * MiB;
constexpr size_t WS_WOUT1T = 20 * MiB;
constexpr size_t WS_AFFL = 22 * MiB;
constexpr size_t WS_AFFC = 23 * MiB;
constexpr size_t WS_TOKSLOT = 24 * MiB;
constexpr size_t WS_GATE = 26 * MiB;
constexpr size_t WS_XS = 32 * MiB;
constexpr size_t WS_HX = 104 * MiB;
constexpr size_t WS_MIX = 140 * MiB;
constexpr size_t WS_W1T = 176 * MiB;
constexpr size_t WS_W2T = 432 * MiB;
constexpr size_t WS_OV = 560 * MiB;
constexpr size_t OV_BTA = WS_OV + 0 * MiB;
constexpr size_t OV_BTC = WS_OV + 16 * MiB;
constexpr size_t OV_AS5 = WS_OV + 96 * MiB;
constexpr size_t OV_S = WS_OV + 136 * MiB;
constexpr size_t OV_Z = WS_OV + 152 * MiB;
constexpr size_t OV_Q0 = WS_OV + 170 * MiB;
constexpr size_t OV_K0 = WS_OV + 188 * MiB;
constexpr size_t OV_VT0 = WS_OV + 193 * MiB;
constexpr size_t OV_XG = WS_OV + 0 * MiB;
constexpr size_t OV_HID = WS_OV + 72 * MiB;
constexpr size_t OV_YB = WS_OV + 216 * MiB;
constexpr size_t OV_Q1 = WS_OV + 0 * MiB;
constexpr size_t OV_K1 = WS_OV + 32 * MiB;
constexpr size_t OV_VT1 = WS_OV + 68 * MiB;
constexpr size_t WS_END = WS_OV + 288 * MiB;

constexpr int NTHREADS = 512, NWAVES = 8;
constexpr int RING_BYTES = 131072, MISC_OFF = RING_BYTES + 320, LDS_BYTES = 147456;

DI unsigned f2bf(float f) { unsigned u = __builtin_bit_cast(unsigned, f); return (u + 0x7fffu + ((u >> 16) & 1u)) >> 16; }
DI unsigned pk2(float lo, float hi) { f32x2 v = {lo, hi}; bf16x2_t b = __builtin_convertvector(v, bf16x2_t); return __builtin_bit_cast(unsigned, b); }
DI float bf2f(unsigned short h) { return __builtin_bit_cast(float, (unsigned)h << 16); }
DI float bflo(unsigned w) { return __builtin_bit_cast(float, w << 16); }
DI float bfhi(unsigned w) { return __builtin_bit_cast(float, w & 0xffff0000u); }
DI float wave_sum(float v) {
#pragma unroll
    for (int o = 1; o < 64; o <<= 1) v += __shfl_xor(v, o);
    return v;
}
namespace pg8 {
#define PG8_LAS __attribute__((address_space(3)))
typedef unsigned short bf16_t;
typedef short bf16x8 __attribute__((ext_vector_type(8)));
typedef float f32x4 __attribute__((ext_vector_type(4)));
typedef unsigned u32x4 __attribute__((ext_vector_type(4)));
constexpr int BM = 256, BK = 64, HALF = 128, HTB = HALF * BK * 2  , STAGE_BYTES = 8 * HTB, NXCD = 8, WGM = 8;

__host__ __device__ __forceinline__ int lds_byte(int r, int c) { const int st = (r >> 4) * 2 + (c >> 5), rr = r & 15, cc = c & 31, ob = rr * 64 + cc * 2; return st * 1024 + (ob ^ (((ob >> 9) & 1) << 5)); }
__host__ __device__ __forceinline__ void stage_rc(int b, int& R, int& C) { const int st = b / 1024, sb = b % 1024, swz = sb ^ (((sb >> 9) & 1) << 5); R = (st >> 1) * 16 + swz / 64; C = (st & 1) * 32 + (swz % 64) / 2; }
__host__ __device__ __forceinline__ int perm32(int rho) { const int n = rho >> 4, i = rho & 15; return 8 * (i >> 2) + 4 * n + (i & 3); }

struct Unit { int pm, pn; };
struct Gemm { const bf16_t* A; const bf16_t* Bt; int K, lda, ldb; };

struct StaticOrder {
    int nM, nN, nwg, G, c;
    __host__ __device__ void init(int M, int N, int G_, int c_) { nM = M / BM; nN = N / BM; nwg = nM * nN; G = G_; c = c_; }
    __host__ __device__ bool next(int i, Unit& u) const {
        const long L = (long)i * G + c; if (L >= nwg) return false;
        int wgid = (int)L; { const int q = nwg / NXCD, r = nwg % NXCD, xcd = wgid % NXCD, off = wgid / NXCD; wgid = (xcd < r ? xcd * (q + 1) : r * (q + 1) + (xcd - r) * q) + off; }
        const int nig = WGM * nN, gid = wgid / nig, fm = gid * WGM, gsz = (nM - fm) < WGM ? (nM - fm) : WGM;
        u.pm = fm + ((wgid % nig) % gsz); u.pn = (wgid % nig) / gsz; return true;
    }
    __device__ __forceinline__ void a_ready(const Unit&) const {}
    __device__ __forceinline__ void done(const Unit&) const {}
};


template <class Epi, class Sched, bool ALIGN_EPI = false, bool SP2 = false>
__device__ __forceinline__ void gemm_phase(PG8_LAS unsigned char* lds, const Gemm g, const Sched& S, const Epi& E) {
    const int tid = threadIdx.x, wid = __builtin_amdgcn_readfirstlane(tid >> 6), lane = tid & 63, wr = wid >> 2, wc = wid & 3, fr = lane & 15, fq = lane >> 4;
    const int K = g.K, nt = K / BK, lda = g.lda, ldb = g.ldb;
    unsigned voffA[2], voffB[2];
#pragma unroll
    for (int i = 0; i < 2; ++i) { int R, C; stage_rc(tid * 16 + i * 8192, R, C); const int Rb = Epi::PERM ? ((R & ~31) + perm32(R & 31)) : R;
        voffA[i] = (unsigned)(R * lda + C) * 2u; voffB[i] = (unsigned)(Rb * ldb + C) * 2u; }
    const size_t kstep = (size_t)(BK * 2);
    const size_t hstepA = (size_t)HALF * lda * 2, hstepB = (size_t)HALF * ldb * 2;
    const size_t tstepA = 2 * hstepA, tstepB = 2 * hstepB;
    const unsigned ldsw = (unsigned)wid * 1024u;
    const int aoff = lds_byte(wr * 64 + fr, fq * 8), boff = lds_byte(wc * 32 + fr, fq * 8);
#define PG8_SA(b, h) (((b) * 2 + (h)) * HTB)
#define PG8_SB(b, h) ((4 + (b) * 2 + (h)) * HTB)
#define PG8_STAGE(bufoff, gbase, voff) do { _Pragma("unroll") for (int _i = 0; _i < 2; ++_i) \
        __builtin_amdgcn_global_load_lds((const unsigned*)((const char*)(gbase) + (voff)[_i]), (PG8_LAS unsigned*)(lds + (bufoff) + ldsw + _i * 8192), 16, 0, 0); } while (0)
#define PG8_LDA(dst, b, h) do { _Pragma("unroll") for (int m = 0; m < 4; ++m) _Pragma("unroll") for (int k = 0; k < 2; ++k) dst[m][k] = *(const PG8_LAS bf16x8*)(lds + PG8_SA(b, h) + aoff + m * 2048 + k * 1024); } while (0)
#define PG8_LDB(dst, b, h) do { _Pragma("unroll") for (int n = 0; n < 2; ++n) _Pragma("unroll") for (int k = 0; k < 2; ++k) dst[n][k] = *(const PG8_LAS bf16x8*)(lds + PG8_SB(b, h) + boff + n * 2048 + k * 1024); } while (0)
#define PG8_MMA(ai, bj, At, Bt) do { __builtin_amdgcn_s_setprio(1); _Pragma("unroll") for (int m = 0; m < 4; ++m) _Pragma("unroll") for (int n = 0; n < 2; ++n) _Pragma("unroll") for (int k = 0; k < 2; ++k) \
        acc[ai][bj][m][n] = __builtin_amdgcn_mfma_f32_16x16x32_bf16(Bt[n][k], At[m][k], acc[ai][bj][m][n], 0, 0, 0); __builtin_amdgcn_s_setprio(0); } while (0)
#define PG8_WAIT_V(n) asm volatile("s_waitcnt vmcnt(" #n ")" ::: "memory")
#define PG8_WAIT_L(n) asm volatile("s_waitcnt lgkmcnt(" #n ")" ::: "memory")
#define PG8_BAR __builtin_amdgcn_s_barrier()
#define PG8_SCHED __builtin_amdgcn_sched_barrier(0)
    Unit cur, nxt; int ui = 0;
    if (!S.next(0, cur)) return;
    f32x4 acc[2][2][4][2];
#pragma unroll
    for (int a = 0; a < 2; ++a)
#pragma unroll
        for (int b = 0; b < 2; ++b)
#pragma unroll
            for (int m = 0; m < 4; ++m)
#pragma unroll
                for (int n = 0; n < 2; ++n) acc[a][b][m][n] = (f32x4){0.f, 0.f, 0.f, 0.f};
    bf16x8 At[4][2], B0[2][2], B1[2][2];
    const char* cA = (const char*)g.A + (size_t)cur.pm * tstepA; const char* cB = (const char*)g.Bt + (size_t)cur.pn * tstepB;
    S.a_ready(cur);
    if constexpr (SP2) {
        PG8_STAGE(PG8_SB(0, 0), cB, voffB); PG8_STAGE(PG8_SB(0, 1), cB + hstepB, voffB); PG8_STAGE(PG8_SA(0, 0), cA, voffA); PG8_STAGE(PG8_SA(0, 1), cA + hstepA, voffA);
        if (wr == 1) PG8_BAR;
        PG8_WAIT_V(2); PG8_BAR;
        PG8_STAGE(PG8_SB(1, 0), cB + kstep, voffB); PG8_STAGE(PG8_SA(1, 0), cA + kstep, voffA); PG8_STAGE(PG8_SB(1, 1), cB + hstepB + kstep, voffB);
        PG8_WAIT_V(6); PG8_BAR;
    } else {
        PG8_STAGE(PG8_SB(0, 0), cB, voffB); PG8_STAGE(PG8_SA(0, 0), cA, voffA); PG8_STAGE(PG8_SB(0, 1), cB + hstepB, voffB); PG8_STAGE(PG8_SA(0, 1), cA + hstepA, voffA);
        if (wr == 1) PG8_BAR;
        PG8_WAIT_V(4); PG8_BAR;
        PG8_STAGE(PG8_SB(1, 0), cB + kstep, voffB); PG8_STAGE(PG8_SA(1, 0), cA + kstep, voffA); PG8_STAGE(PG8_SB(1, 1), cB + hstepB + kstep, voffB);
        PG8_WAIT_V(6); PG8_BAR;
    }
    for (;;) {
        const bool has_next = S.next(ui + 1, nxt);
        const char* nA = has_next ? (const char*)g.A + (size_t)nxt.pm * tstepA : cA; const char* nB = has_next ? (const char*)g.Bt + (size_t)nxt.pn * tstepB : cB;
        for (int t = 0; t < nt; t += 2) {
            const bool last = (t == nt - 2);
            const char* a1 = cA + (size_t)(t + 1) * kstep;
            const char* a2 = last ? nA : cA + (size_t)(t + 2) * kstep; const char* b2 = last ? nB : cB + (size_t)(t + 2) * kstep;
            const char* a3 = a2 + kstep; const char* b3 = b2 + kstep;
            if (last && has_next) S.a_ready(nxt);
            if constexpr (SP2) {
            PG8_LDB(B0, 0, 0); PG8_LDB(B1, 0, 1); PG8_SCHED; PG8_LDA(At, 0, 0); PG8_STAGE(PG8_SA(1, 1), a1 + hstepA, voffA);
            PG8_WAIT_V(8); PG8_WAIT_L(0); PG8_BAR; PG8_MMA(0, 0, At, B0); PG8_MMA(0, 1, At, B1); PG8_BAR; PG8_SCHED;
            PG8_LDA(At, 0, 1); PG8_STAGE(PG8_SB(0, 0), b2, voffB); PG8_STAGE(PG8_SB(0, 1), b2 + hstepB, voffB); PG8_STAGE(PG8_SA(0, 0), a2, voffA);
            PG8_WAIT_V(8); PG8_WAIT_L(0); PG8_BAR; PG8_MMA(1, 0, At, B0); PG8_MMA(1, 1, At, B1); PG8_BAR; PG8_SCHED;
            PG8_LDB(B0, 1, 0); PG8_LDB(B1, 1, 1); PG8_SCHED; PG8_LDA(At, 1, 0); PG8_STAGE(PG8_SA(0, 1), a2 + hstepA, voffA);
            PG8_WAIT_V(8); PG8_WAIT_L(0); PG8_BAR; PG8_MMA(0, 0, At, B0); PG8_MMA(0, 1, At, B1); PG8_BAR; PG8_SCHED;
            PG8_LDA(At, 1, 1); PG8_STAGE(PG8_SB(1, 0), b3, voffB); PG8_STAGE(PG8_SB(1, 1), b3 + hstepB, voffB); PG8_STAGE(PG8_SA(1, 0), a3, voffA);
            PG8_WAIT_V(8); PG8_WAIT_L(0); PG8_BAR; PG8_MMA(1, 0, At, B0); PG8_MMA(1, 1, At, B1); PG8_BAR; PG8_SCHED;
            } else {
            PG8_LDB(B0, 0, 0); PG8_SCHED; PG8_LDA(At, 0, 0); PG8_STAGE(PG8_SA(1, 1), a1 + hstepA, voffA);
            PG8_WAIT_L(8); PG8_BAR; PG8_WAIT_L(0); PG8_MMA(0, 0, At, B0); PG8_BAR; PG8_SCHED;
            PG8_LDB(B1, 0, 1); PG8_STAGE(PG8_SB(0, 0), b2, voffB);
            PG8_BAR; PG8_WAIT_L(0); PG8_MMA(0, 1, At, B1); PG8_BAR;
            PG8_LDA(At, 0, 1); PG8_STAGE(PG8_SA(0, 0), a2, voffA);
            PG8_BAR; PG8_WAIT_L(0); PG8_MMA(1, 0, At, B0); PG8_BAR; PG8_SCHED;
            PG8_STAGE(PG8_SB(0, 1), b2 + hstepB, voffB);
            PG8_WAIT_V(6); PG8_BAR; PG8_MMA(1, 1, At, B1); PG8_BAR;
            PG8_LDB(B0, 1, 0); PG8_SCHED; PG8_LDA(At, 1, 0); PG8_STAGE(PG8_SA(0, 1), a2 + hstepA, voffA);
            PG8_WAIT_L(8); PG8_BAR; PG8_WAIT_L(0); PG8_MMA(0, 0, At, B0); PG8_BAR; PG8_SCHED;
            PG8_LDB(B1, 1, 1); PG8_STAGE(PG8_SB(1, 0), b3, voffB);
            PG8_BAR; PG8_WAIT_L(0); PG8_MMA(0, 1, At, B1); PG8_BAR;
            PG8_LDA(At, 1, 1); PG8_STAGE(PG8_SA(1, 0), a3, voffA);
            PG8_BAR; PG8_WAIT_L(0); PG8_MMA(1, 0, At, B0); PG8_BAR; PG8_SCHED;
            PG8_STAGE(PG8_SB(1, 1), b3 + hstepB, voffB);
            PG8_WAIT_V(6); PG8_BAR; PG8_MMA(1, 1, At, B1); PG8_BAR;
            }
        }
        if constexpr (ALIGN_EPI) { if (wr == 0) PG8_BAR; }
        if constexpr (!Epi::AFTER_DRAIN) { E(acc, cur, wr, wc, fr, fq); S.done(cur); }
        if (!has_next) break;
#pragma unroll
        for (int a = 0; a < 2; ++a)
#pragma unroll
            for (int b = 0; b < 2; ++b)
#pragma unroll
                for (int m = 0; m < 4; ++m)
#pragma unroll
                    for (int n = 0; n < 2; ++n) acc[a][b][m][n] = (f32x4){0.f, 0.f, 0.f, 0.f};
        cur = nxt; cA = nA; cB = nB; ++ui;
        if constexpr (ALIGN_EPI) { if (wr == 1) PG8_BAR; }
    }
    PG8_WAIT_V(0);
    if constexpr (!ALIGN_EPI) { if (wr == 0) PG8_BAR; }
    PG8_BAR;
    if constexpr (Epi::AFTER_DRAIN) { E.fused(acc, cur, wr, wc, fr, fq, lds, wid, lane); S.done(cur); }
#undef PG8_SA
#undef PG8_SB
#undef PG8_STAGE
#undef PG8_LDA
#undef PG8_LDB
#undef PG8_MMA
#undef PG8_WAIT_V
#undef PG8_WAIT_L
#undef PG8_BAR
#undef PG8_SCHED
}
}

#define XB_TMO      128
#define XB_XCNT(j)  (256  + 64 * (j))
#define XB_XSUB(j)  (1280 + 64 * (j))
#define XB_XGEN(j)  (2304 + 64 * (j))
#define XB_TOP      3328
#define XB_TOPGEN   3392
#define XCD_BAR_WORDS 3456
#define XB_SPIN_CAP (1u << 24)

__device__ __forceinline__ unsigned xb_ld(unsigned* p)              { return __hip_atomic_load(p, __ATOMIC_RELAXED, __HIP_MEMORY_SCOPE_AGENT); }
__device__ __forceinline__ unsigned xb_add(unsigned* p, unsigned v) { return __hip_atomic_fetch_add(p, v, __ATOMIC_RELAXED, __HIP_MEMORY_SCOPE_AGENT); }
__device__ __forceinline__ unsigned xb_xcc_id() { return (unsigned)__builtin_amdgcn_s_getreg((3 << 11) | 20) & 0xFu; }
#define XB_SPIN(cond, bar) do { unsigned _sp = 0; while (cond) { __builtin_amdgcn_s_sleep(1); \
    if ((++_sp & 255u) == 0u) { if (xb_ld(&(bar)[XB_TMO])) break; if (_sp > XB_SPIN_CAP) { atomicAdd(&(bar)[XB_TMO], 1u); break; } } } } while (0)

struct XcdBarrier {
    unsigned* bar; unsigned x;
    volatile LAS unsigned* st;
};

__device__ __forceinline__ XcdBarrier xcd_barrier_post(unsigned* bar, volatile LAS unsigned* st) {
    XcdBarrier b; b.bar = bar; b.x = xb_xcc_id(); b.st = st;
    if (threadIdx.x == 0) (void)xb_add(&bar[XB_XCNT(b.x)], 1u);
    return b;
}
__device__ __forceinline__ void xcd_barrier_complete(unsigned* bar, unsigned x, unsigned& nloc, unsigned& nx) {
    const unsigned G = gridDim.x * gridDim.y * gridDim.z;
    unsigned sum, cnt, mine, sp = 0u;
    for (;;) {
        sum = 0u; cnt = 0u; mine = 0u;
#pragma unroll
        for (unsigned j = 0; j < 16; ++j) { const unsigned c = xb_ld(&bar[XB_XCNT(j)]); sum += c; cnt += (c > 0u) ? 1u : 0u; mine = (j == x) ? c : mine; }
        if (sum == G) break;
        __builtin_amdgcn_s_sleep(1);
        if ((++sp & 255u) == 0u) { if (xb_ld(&bar[XB_TMO])) break; if (sp > XB_SPIN_CAP) { atomicAdd(&bar[XB_TMO], 1u); break; } }
    }
    nloc = mine > 0u ? mine : 1u; nx = cnt > 0u ? cnt : 1u;
}

__device__ __forceinline__ void xcd_barrier(const XcdBarrier& b) {
    asm volatile("s_waitcnt vmcnt(0)" ::: "memory");
    __syncthreads();
    if (threadIdx.x == 0) {
        unsigned* bar = b.bar;
        __builtin_amdgcn_s_waitcnt(0);
        unsigned nloc = b.st[0], nx = b.st[1];
        if (nloc == 0u) { xcd_barrier_complete(bar, b.x, nloc, nx); b.st[0] = nloc; b.st[1] = nx; }
        const unsigned old = xb_add(&bar[XB_XSUB(b.x)], 1u);
        const unsigned gen = old / nloc;
        if (old + 1u == (gen + 1u) * nloc) {
            __builtin_amdgcn_fence(__ATOMIC_RELEASE, "agent");
            asm volatile("s_waitcnt vmcnt(0)" ::: "memory");
            const unsigned og = xb_add(&bar[XB_TOP], 1u);
            const unsigned tg = og / nx;
            if (og + 1u == (tg + 1u) * nx) xb_add(&bar[XB_TOPGEN], 1u);
            else XB_SPIN(xb_ld(&bar[XB_TOPGEN]) == tg, bar);
            __builtin_amdgcn_fence(__ATOMIC_ACQUIRE, "agent");
            xb_add(&bar[XB_XGEN(b.x)], 1u);
            asm volatile("s_waitcnt vmcnt(0)" ::: "memory");
        } else {
            XB_SPIN(xb_ld(&bar[XB_XGEN(b.x)]) == gen, bar);
            __builtin_amdgcn_fence(__ATOMIC_ACQUIRE, "agent");
            asm volatile("s_waitcnt vmcnt(0)" ::: "memory");
        }
    }
    __syncthreads();
}
struct Args { const float* in[33]; float* out; unsigned char* ws; int ph_lo, ph_hi; };
enum { I_X = 0, I_C, I_CTX, I_CCTX, I_ADAW, I_ADAB, I_NMIXG, I_NFFNG, I_EVWIN, I_EVWOUT, I_LAMRE, I_LAMIM, I_LOGSTEP, I_BRE, I_BIM, I_CRE, I_CIM, I_S5D, I_GLUW, I_GLUB,
       I_SINK, I_ODWIN, I_ODWOUT, I_LQ1, I_LK1, I_LQ2, I_LK2, I_SUBLN, I_ROUTER, I_WGATE, I_WUP, I_WDOWN, I_FINALG };

DI void p0_ada_item(const Args& a, LAS unsigned char* lds, int item) {
    const int tid = threadIdx.x, lane = tid & 63, wave = tid >> 6;
    const int l = item / 96, j0 = (item % 96) * 64;
    LAS float* sc = (LAS float*)lds;
    LAS float* red = (LAS float*)(lds + 9 * 1024 * 4);
    for (int i = tid; i < 9 * 1024; i += NTHREADS) {
        const int r = i >> 10, k = i & 1023;
        const float v = (r < 8) ? a.in[I_C][r * 1024 + k] : a.in[I_CCTX][k];
        sc[i] = v / (1.0f + __expf(-v));
    }
    __syncthreads();
    float acc[9];
#pragma unroll
    for (int r = 0; r < 9; ++r) acc[r] = 0.f;
    const float* W = a.in[I_ADAW] + (size_t)l * 1024 * 6144 + j0 + lane;
    const int k0 = wave * 128;
#pragma unroll 4
    for (int k = 0; k < 128; ++k) {
        const float w = W[(size_t)(k0 + k) * 6144];
#pragma unroll
        for (int r = 0; r < 9; ++r) acc[r] += sc[r * 1024 + k0 + k] * w;
    }
#pragma unroll
    for (int r = 0; r < 9; ++r) red[(wave * 9 + r) * 64 + lane] = acc[r];
    __syncthreads();
    for (int i = tid; i < 9 * 64; i += NTHREADS) {
        const int r = i >> 6, jj = i & 63; float s = 0.f;
#pragma unroll
        for (int w = 0; w < 8; ++w) s += red[(w * 9 + r) * 64 + jj];
        ((float*)(a.ws + WS_MOD))[(size_t)(l * 9 + r) * 6144 + j0 + jj] = s + a.in[I_ADAB][l * 6144 + j0 + jj];
    }
    __syncthreads();
}
DI void p0_rope(const Args& a) {
    for (int i = threadIdx.x; i < 1024; i += NTHREADS) {
        const int pos = i >> 4, fi = i & 15;
        const float inv = powf(10000.0f, -(float)fi / 16.0f);
        const float ang = (float)pos * inv;
        ((float*)(a.ws + WS_ROPE))[2 * i] = cosf(ang); ((float*)(a.ws + WS_ROPE))[2 * i + 1] = sinf(ang);
    }
}
DI void p0_s5_item(const Args& a, LAS unsigned char* lds, int item) {
    const int tid = threadIdx.x, g = item >> 1, dir = item & 1;
    LAS float* apr = (LAS float*)lds;
    LAS float* api = apr + 65 * 64;
    LAS float* bbr = api + 65 * 64;
    LAS float* bbi = bbr + 1024;
    LAS float* ccr = bbi + 1024;
    LAS float* cci = ccr + 1024;
    const int gp = (dir * S5G + g) * S5P;
    const float dt = __expf(a.in[I_LOGSTEP][dir * S5G + g]);
    for (int i = tid; i < 65 * 64; i += NTHREADS) {
        const int j = i >> 6, p = i & 63;
        const float lr = a.in[I_LAMRE][gp + p], li = a.in[I_LAMIM][gp + p];
        const float mag = expf((float)j * lr * dt), ang = (float)j * li * dt;
        apr[i] = mag * cosf(ang); api[i] = mag * sinf(ang);
    }
    for (int i = tid; i < 1024; i += NTHREADS) {
        const int p = i >> 4;
        const float lr = a.in[I_LAMRE][gp + p], li = a.in[I_LAMIM][gp + p];
        const float mag = expf(lr * dt), are = mag * cosf(li * dt), aim = mag * sinf(li * dt);
        const float den = lr * lr + li * li;
        const float fre = ((are - 1.0f) * lr + aim * li) / den, fim = (aim * lr - (are - 1.0f) * li) / den;
        const float br = a.in[I_BRE][(size_t)gp * 16 + i], bi = a.in[I_BIM][(size_t)gp * 16 + i];
        bbr[i] = fre * br - fim * bi; bbi[i] = fre * bi + fim * br;
        ccr[i] = a.in[I_CRE][(size_t)(dir * S5G + g) * 1024 + i]; cci[i] = a.in[I_CIM][(size_t)(dir * S5G + g) * 1024 + i];
    }
    __syncthreads();
    if (tid < 64) { float* ap = (float*)(a.ws + WS_APOW) + ((g * 2 + dir) * 64 + tid) * 2; ap[0] = apr[64 * 64 + tid]; ap[1] = api[64 * 64 + tid]; }
    {
        const int c = (tid >> 4) & 15, h = tid & 15, jh = tid >> 8;
        float cbr[64], cbi[64];
#pragma unroll
        for (int p = 0; p < 64; ++p) { const float cr = ccr[c * 64 + p], ci = cci[c * 64 + p], br = bbr[p * 16 + h], bi = bbi[p * 16 + h]; cbr[p] = cr * br - ci * bi; cbi[p] = cr * bi + ci * br; }
        float* kt = (float*)(a.ws + WS_KTAB) + (size_t)(g * 2 + dir) * 64 * 256;
        for (int j = jh * 32; j < jh * 32 + 32; ++j) {
            float s = 0.f;
#pragma unroll
            for (int p = 0; p < 64; p += 4) {
                const f32x4 ar = *(const LAS f32x4*)(apr + j * 64 + p), ai = *(const LAS f32x4*)(api + j * 64 + p);
#pragma unroll
                for (int q = 0; q < 4; ++q) s += cbr[p + q] * ar[q] - cbi[p + q] * ai[q];
            }
            kt[j * 256 + c * 16 + h] = s;
        }
    }
    bf16_t* bta = (bf16_t*)(a.ws + OV_BTA) + (size_t)g * 256 * 1024;
    for (int i = tid; i < 128 * 512; i += NTHREADS) {
        const int row = i >> 9, cp = i & 511, ri = row >> 6, p = row & 63, s = cp >> 3, h = (cp & 7) * 2;
        const int e = dir ? s : 63 - s;
        const float pr = apr[e * 64 + p], pi = api[e * 64 + p];
        float v0, v1;
        if (ri == 0) { v0 = pr * bbr[p * 16 + h] - pi * bbi[p * 16 + h]; v1 = pr * bbr[p * 16 + h + 1] - pi * bbi[p * 16 + h + 1]; }
        else         { v0 = pr * bbi[p * 16 + h] + pi * bbr[p * 16 + h]; v1 = pr * bbi[p * 16 + h + 1] + pi * bbr[p * 16 + h + 1]; }
        *(unsigned*)(bta + (size_t)(dir * 128 + row) * 1024 + s * 16 + h) = pk2(v0, v1);
    }
    bf16_t* btc = (bf16_t*)(a.ws + OV_BTC) + (size_t)g * 1024 * S5_KC;
    for (int i = tid; i < 1024 * 64; i += NTHREADS) {
        const int row = i >> 6, cp = i & 63, ri = cp >> 5, p = (cp & 31) * 2, t = row >> 4, c = row & 15;
        const int f = dir ? 64 - t : t + 1;
        float v[2];
#pragma unroll
        for (int q = 0; q < 2; ++q) {
            const float cr = ccr[c * 64 + p + q], ci = cci[c * 64 + p + q], pr = apr[f * 64 + p + q], pi = api[f * 64 + p + q];
            v[q] = ri == 0 ? (cr * pr - ci * pi) : -(cr * pi + ci * pr);
        }
        *(unsigned*)(btc + (size_t)row * S5_KC + 1024 + dir * 128 + ri * 64 + p) = pk2(v[0], v[1]);
    }
    __syncthreads();
}
DI void p0_conv_item(const float* W, int K, int N, bf16_t* WT, int mode, int sel, int kb, int nb, int lane) {
    const int n4 = nb * 256 + lane * 4;
    const float* src = W + (size_t)(kb * 64) * N + n4;
    int rowb = n4; if (mode == 1) rowb = (n4 >> 7) * 256 + sel * 128 + (n4 & 127);
    bf16_t* dst = WT + (size_t)rowb * K + kb * 64;
#pragma unroll 2
    for (int ks = 0; ks < 8; ++ks) {
        f32x4 v[8];
#pragma unroll
        for (int i = 0; i < 8; ++i) v[i] = *(const f32x4*)(src + (size_t)(ks * 8 + i) * N);
#pragma unroll
        for (int j = 0; j < 4; ++j) {
            u32x4 o; o.x = pk2(v[0][j], v[1][j]); o.y = pk2(v[2][j], v[3][j]); o.z = pk2(v[4][j], v[5][j]); o.w = pk2(v[6][j], v[7][j]);
            *(u32x4*)(dst + (size_t)j * K + ks * 8) = o;
        }
    }
}
DI void p0_phase(const Args& a, LAS unsigned char* lds, int G) {
    const int tid = threadIdx.x, lane = tid & 63, wave = __builtin_amdgcn_readfirstlane(tid >> 6);
    for (int it = blockIdx.x; it < 257; it += G) {
        if (it < 64) p0_s5_item(a, lds, it);
        else if (it < 256) p0_ada_item(a, lds, it - 64);
        else p0_rope(a);
    }
    const int gw = blockIdx.x * NWAVES + wave, NGW = G * NWAVES;
    constexpr int I_IN0 = 16 * 5, I_GLU = 8 * 2, I_OUT0 = 16 * 4, I_IN1 = 16 * 12, I_OUT1 = 16 * 4, I_SMALL = I_IN0 + I_GLU + I_OUT0 + I_IN1 + I_OUT1;
    constexpr int I_GU = 16 * 8, I_DN = 32 * 4;
    constexpr int I_MOE = 2 * 16 * (2 * I_GU + I_DN), NITEMS = I_SMALL + I_MOE;
    for (int it = gw; it < NITEMS; it += NGW) {
        int r = it;
        if (r < I_IN0) { p0_conv_item(a.in[I_EVWIN], 1024, 1280, (bf16_t*)(a.ws + WS_WIN0T), 0, 0, r / 5, r % 5, lane); continue; } r -= I_IN0;
        if (r < I_GLU) { p0_conv_item(a.in[I_GLUW], 512, 512, (bf16_t*)(a.ws + WS_WGLUT), 0, 0, r / 2, r % 2, lane); continue; } r -= I_GLU;
        if (r < I_OUT0) { p0_conv_item(a.in[I_EVWOUT], 1024, 1024, (bf16_t*)(a.ws + WS_WOUT0T), 0, 0, r / 4, r % 4, lane); continue; } r -= I_OUT0;
        if (r < I_IN1) { p0_conv_item(a.in[I_ODWIN], 1024, 3072, (bf16_t*)(a.ws + WS_WIN1T), 0, 0, r / 12, r % 12, lane); continue; } r -= I_IN1;
        if (r < I_OUT1) { p0_conv_item(a.in[I_ODWOUT], 1024, 1024, (bf16_t*)(a.ws + WS_WOUT1T), 0, 0, r / 4, r % 4, lane); continue; } r -= I_OUT1;
        const int le = r / (2 * I_GU + I_DN); r -= le * (2 * I_GU + I_DN);
        if (r < I_GU) { p0_conv_item(a.in[I_WGATE] + (size_t)le * 1024 * 2048, 1024, 2048, (bf16_t*)(a.ws + WS_W1T) + (size_t)le * 4096 * 1024, 1, 0, r / 8, r % 8, lane); continue; } r -= I_GU;
        if (r < I_GU) { p0_conv_item(a.in[I_WUP] + (size_t)le * 1024 * 2048, 1024, 2048, (bf16_t*)(a.ws + WS_W1T) + (size_t)le * 4096 * 1024, 1, 1, r / 8, r % 8, lane); continue; } r -= I_GU;
        p0_conv_item(a.in[I_WDOWN] + (size_t)le * 2048 * 1024, 2048, 1024, (bf16_t*)(a.ws + WS_W2T) + (size_t)le * 1024 * 2048, 0, 0, r / 4, r % 4, lane);
    }
}
DI const float* mod_ptr(const Args& a, int layer, int row) {
    const int r = row < ROWS_L ? (row >> 11) : 8;
    return (const float*)(a.ws + WS_MOD) + (size_t)(layer * 9 + r) * 6144;
}
DI void load_row(const float* p, int lane, f32x4 (&v)[4]) {
#pragma unroll
    for (int j = 0; j < 4; ++j) v[j] = *(const f32x4*)(p + lane * 4 + 256 * j);
}
DI float row_rstd(const f32x4 (&v)[4]) {
    float s = 0.f;
#pragma unroll
    for (int j = 0; j < 4; ++j) s += (v[j].x * v[j].x + v[j].y * v[j].y) + (v[j].z * v[j].z + v[j].w * v[j].w);
    return 1.0f / sqrtf(wave_sum(s) * (1.0f / 1024.0f) + NORM_EPS);
}
DI void norm_mod(f32x4 (&v)[4], const float* g, const float* shift, const float* scale, int lane) {
    const float rs = row_rstd(v);
#pragma unroll
    for (int j = 0; j < 4; ++j) {
        const f32x4 gg = *(const f32x4*)(g + lane * 4 + 256 * j), sh = *(const f32x4*)(shift + lane * 4 + 256 * j), sc = *(const f32x4*)(scale + lane * 4 + 256 * j);
        v[j] = (v[j] * rs) * gg * (sc + 1.0f) + sh;
    }
}
DI void store_row_bf16(bf16_t* p, int lane, const f32x4 (&v)[4]) {
#pragma unroll
    for (int j = 0; j < 4; ++j) { u32x2 w; w.x = pk2(v[j].x, v[j].y); w.y = pk2(v[j].z, v[j].w); *(u32x2*)(p + lane * 4 + 256 * j) = w; }
}
DI void router_row(const Args& a, int layer, int row, const f32x4 (&v)[4], int lane) {
    const float* wr = a.in[I_ROUTER] + (size_t)layer * 1024 * 16;
    float lg[16];
#pragma unroll
    for (int e = 0; e < 16; ++e) lg[e] = 0.f;
#pragma unroll
    for (int j = 0; j < 4; ++j)
#pragma unroll
        for (int q = 0; q < 4; ++q) {
            const float x = v[j][q]; const float* w = wr + (size_t)(lane * 4 + 256 * j + q) * 16;
#pragma unroll
            for (int e4 = 0; e4 < 4; ++e4) { const f32x4 ww = *(const f32x4*)(w + 4 * e4); lg[4 * e4] += x * ww.x; lg[4 * e4 + 1] += x * ww.y; lg[4 * e4 + 2] += x * ww.z; lg[4 * e4 + 3] += x * ww.w; }
        }
    float mx = -1e30f;
#pragma unroll
    for (int e = 0; e < 16; ++e) { lg[e] = wave_sum(lg[e]); mx = fmaxf(mx, lg[e]); }
    float den = 0.f;
#pragma unroll
    for (int e = 0; e < 16; ++e) { lg[e] = expf(lg[e] - mx); den += lg[e]; }
    float mine = 0.f;
#pragma unroll
    for (int e = 0; e < 16; ++e) if (lane == e) mine = lg[e] / den;
    if (lane < 16) {
        if (row < ROWS_L) ((float*)(a.ws + WS_AFFL))[((size_t)(row >> 11) * 16 + lane) * NL + (row & 2047)] = mine;
        else { const int rc = row - ROWS_L; ((float*)(a.ws + WS_AFFC))[((size_t)(rc >> 8) * 16 + lane) * NC + (rc & 255)] = mine; }
    }
}
DI void p1_phase(const Args& a, int G) {
    const int tid = threadIdx.x, lane = tid & 63, wave = __builtin_amdgcn_readfirstlane(tid >> 6);
    const int gw = blockIdx.x * NWAVES + wave, NGW = G * NWAVES;
    for (int it = gw; it < S5G * 64; it += NGW) {
        const int g = it >> 6, t = it & 63;
        const float* kf = (const float*)(a.ws + WS_KTAB) + (size_t)(g * 2 + 0) * 64 * 256;
        const float* kr = kf + 64 * 256;
        bf16_t* base = (bf16_t*)(a.ws + OV_BTC) + ((size_t)g * 1024 + t * 16) * S5_KC;
        for (int c = 0; c < 16; ++c)
#pragma unroll
            for (int q = 0; q < 4; ++q) {
                const int col = q * 256 + lane * 4, s = col >> 4, h0 = col & 15;
                f32x4 v = {0.f, 0.f, 0.f, 0.f};
                if (s <= t) v += *(const f32x4*)(kf + ((t - s) * 16 + c) * 16 + h0);
                if (s >= t) v += *(const f32x4*)(kr + ((s - t) * 16 + c) * 16 + h0);
                u32x2 w; w.x = pk2(v.x, v.y); w.y = pk2(v.z, v.w);
                *(u32x2*)(base + (size_t)c * S5_KC + col) = w;
            }
    }
    for (int row = gw; row < ROWS; row += NGW) {
        const float* src = row < ROWS_L ? a.in[I_X] + (size_t)row * DM : a.in[I_CTX] + (size_t)(row - ROWS_L) * DM;
        f32x4 v[4]; load_row(src, lane, v);
        const float* md = mod_ptr(a, 0, row);
        norm_mod(v, a.in[I_NMIXG], md, md + 1024, lane);
        store_row_bf16((bf16_t*)(a.ws + WS_HX) + (size_t)row * DM, lane, v);
    }
}
DI void pnorm_router_phase(const Args& a, int G, int layer, int nrows) {
    const int tid = threadIdx.x, lane = tid & 63, wave = __builtin_amdgcn_readfirstlane(tid >> 6);
    const int gw = blockIdx.x * NWAVES + wave, NGW = G * NWAVES;
    for (int row = gw; row < nrows; row += NGW) {
        f32x4 v[4]; load_row((const float*)(a.ws + WS_XS) + (size_t)row * DM, lane, v);
        const float* md = mod_ptr(a, layer, row);
        norm_mod(v, a.in[I_NFFNG] + layer * 1024, md + 3 * 1024, md + 4 * 1024, lane);
        store_row_bf16((bf16_t*)(a.ws + WS_HX) + (size_t)row * DM, lane, v);
        router_row(a, layer, row, v, lane);
    }
}
DI void pcombine_phase(const Args& a, int G, int layer, int nrows, int mrows) {
    const int tid = threadIdx.x, lane = tid & 63, wave = __builtin_amdgcn_readfirstlane(tid >> 6);
    const int gw = blockIdx.x * NWAVES + wave, NGW = G * NWAVES;
    const bf16_t* yb = (const bf16_t*)(a.ws + OV_YB);
    for (int row = gw; row < nrows; row += NGW) {
        float* xr = (float*)(a.ws + WS_XS) + (size_t)row * DM;
        f32x4 v[4]; load_row(xr, lane, v);
        f32x4 acc[4];
#pragma unroll
        for (int j = 0; j < 4; ++j) acc[j] = (f32x4){0.f, 0.f, 0.f, 0.f};
        const int* ts = (const int*)(a.ws + WS_TOKSLOT) + (size_t)row * 16;
        for (int e = 0; e < 16; ++e) {
            const int sl = __builtin_amdgcn_readfirstlane(ts[e]);
            if (sl >= 0) {
                const bf16_t* yr = yb + ((size_t)e * mrows + sl) * DM;
#pragma unroll
                for (int j = 0; j < 4; ++j) { const u32x2 w = *(const u32x2*)(yr + lane * 4 + 256 * j); acc[j].x += bflo(w.x); acc[j].y += bfhi(w.x); acc[j].z += bflo(w.y); acc[j].w += bfhi(w.y); }
            }
        }
        const float* md = mod_ptr(a, layer, row);
#pragma unroll
        for (int j = 0; j < 4; ++j) v[j] += *(const f32x4*)(md + 5 * 1024 + lane * 4 + 256 * j) * acc[j];
        if (layer == 0) {
#pragma unroll
            for (int j = 0; j < 4; ++j) *(f32x4*)(xr + lane * 4 + 256 * j) = v[j];
            const float* m1 = mod_ptr(a, 1, row);
            norm_mod(v, a.in[I_NMIXG] + 1024, m1, m1 + 1024, lane);
            store_row_bf16((bf16_t*)(a.ws + WS_HX) + (size_t)row * DM, lane, v);
        } else {
            const float rs = row_rstd(v);
#pragma unroll
            for (int j = 0; j < 4; ++j) *(f32x4*)(a.out + (size_t)row * DM + lane * 4 + 256 * j) = (v[j] * rs) * *(const f32x4*)(a.in[I_FINALG] + lane * 4 + 256 * j);
        }
    }
}
DI void ptopk_phase(const Args& a, LAS unsigned char* lds, int G, int with_ctx, int mrows) {
    const int tid = threadIdx.x, lane = tid & 63, wave = __builtin_amdgcn_readfirstlane(tid >> 6);
    LAS float* av = (LAS float*)lds;
    LAS int* list = (LAS int*)(lds + 8192);
    LAS int* cnt = (LAS int*)(lds + 8192 + 4096);
    const int nitems = with_ctx ? 640 : 512;
    for (int it = blockIdx.x; it < nitems; it += G) {
        const bool lat = it < 512;
        int b, e, q4, n, cap;
        if (lat) { b = it >> 6; e = (it >> 2) & 15; q4 = it & 3; n = NL; cap = CAP_L; } else { const int r = it - 512; b = r >> 4; e = r & 15; q4 = 0; n = NC; cap = CAP_C; }
        const float* src = lat ? (const float*)(a.ws + WS_AFFL) + ((size_t)b * 16 + e) * NL : (const float*)(a.ws + WS_AFFC) + ((size_t)b * 16 + e) * NC;
        for (int i = tid; i < n; i += NTHREADS) av[i] = src[i];
        if (tid == 0) *cnt = 0;
        __syncthreads();
        const int t = q4 * 512 + tid;
        if (t < n) {
            const float v = av[t]; int rank = 0;
            for (int j = 0; j < n; j += 4) {
                const f32x4 w = *(const LAS f32x4*)(av + j);
                rank += (w.x > v || (w.x == v && j < t)) ? 1 : 0;
                rank += (w.y > v || (w.y == v && j + 1 < t)) ? 1 : 0;
                rank += (w.z > v || (w.z == v && j + 2 < t)) ? 1 : 0;
                rank += (w.w > v || (w.w == v && j + 3 < t)) ? 1 : 0;
            }
            const int trow = lat ? b * NL + t : ROWS_L + b * NC + t;
            int erow = -1;
            if (rank < cap) {
                erow = lat ? b * CAP_L + rank : NB * CAP_L + b * CAP_C + rank;
                ((float*)(a.ws + WS_GATE))[(size_t)e * mrows + erow] = v;
                const int k = __hip_atomic_fetch_add(cnt, 1, __ATOMIC_RELAXED, __HIP_MEMORY_SCOPE_WORKGROUP);
                list[2 * k] = trow; list[2 * k + 1] = erow;
            }
            ((int*)(a.ws + WS_TOKSLOT))[(size_t)trow * 16 + e] = erow;
        }
        __syncthreads();
        const int nsel = *cnt;
        for (int k = wave; k < nsel; k += NWAVES) {
            const int trow = list[2 * k], erow = list[2 * k + 1];
            const u32x4* s = (const u32x4*)((const bf16_t*)(a.ws + WS_HX) + (size_t)trow * DM);
            u32x4* d = (u32x4*)((bf16_t*)(a.ws + OV_XG) + ((size_t)e * mrows + erow) * DM);
            d[lane] = s[lane]; d[lane + 64] = s[lane + 64];
        }
        __syncthreads();
    }
}
DI void ps5_rec_phase(const Args& a, int G) {
    for (int it = blockIdx.x; it < 64; it += G) {
        const int gid = it * NTHREADS + threadIdx.x;
        const int p = gid & 63, dir = (gid >> 6) & 1, b = (gid >> 7) & 7, g = gid >> 10;
        const float* ap = (const float*)(a.ws + WS_APOW) + ((g * 2 + dir) * 64 + p) * 2;
        const float ar = ap[0], ai = ap[1];
        const float* S = (const float*)(a.ws + OV_S) + (size_t)g * S5_MROWS * 256 + dir * 128 + p;
        bf16_t* H = (bf16_t*)(a.ws + OV_AS5) + (size_t)g * S5_MROWS * S5_KC + 1024 + dir * 128 + p;
        float sr = 0.f, si = 0.f;
        for (int k = 0; k < 36; ++k) {
            int row;
            if (dir == 0) row = k < 4 ? 256 + b * 4 + k : b * 32 + (k - 4);
            else          row = k < 4 ? 256 + b * 4 + (3 - k) : b * 32 + (31 - (k - 4));
            H[(size_t)row * S5_KC] = (bf16_t)f2bf(sr); H[(size_t)row * S5_KC + 64] = (bf16_t)f2bf(si);
            const float cr = S[(size_t)row * 256], ci = S[(size_t)row * 256 + 64];
            const float nr = ar * sr - ai * si + cr, ni = ar * si + ai * sr + ci;
            sr = nr; si = ni;
        }
    }
}
struct ListOrder {
    int n, G, c;
    DI int idx(int i) const {
        const long L = (long)i * G + c; if (L >= n) return -1;
        const int w = (int)L, q = n / 8, r = n % 8, x = w % 8, off = w / 8;
        return (x < r ? x * (q + 1) : r * (q + 1) + (x - r) * q) + off;
    }
};
struct GroupOrder {
    ListOrder lo; int MT, NT;
    DI void init(int groups, int MT_, int NT_, int G, int c) { MT = MT_; NT = NT_; lo.n = groups * MT_ * NT_; lo.G = G; lo.c = c; }
    DI bool next(int i, pg8::Unit& u) const {
        const int w = lo.idx(i); if (w < 0) return false;
        const int g = w / (MT * NT), rem = w % (MT * NT), j = rem / MT, mi = rem % MT;
        u.pm = g * MT + mi; u.pn = g * NT + j; return true;
    }
    DI void a_ready(const pg8::Unit&) const {}
    DI void done(const pg8::Unit&) const {}
};
struct Win1Order {
    ListOrder lo;
    DI void init(int G, int c) { lo.n = 64 * 12 + 8 * 8; lo.G = G; lo.c = c; }
    DI bool next(int i, pg8::Unit& u) const {
        const int w = lo.idx(i); if (w < 0) return false;
        if (w < 768) { const int mg = w / 96, rem = w % 96; u.pn = rem / 8; u.pm = mg * 8 + rem % 8; }
        else { const int r = w - 768; u.pn = 4 + r / 8; u.pm = 64 + r % 8; }
        return true;
    }
    DI void a_ready(const pg8::Unit&) const {}
    DI void done(const pg8::Unit&) const {}
};

typedef pg8::f32x4 (ACC_T)[2][2][4][2];
DI void st_bf16x4(bf16_t* p, f32x4 v) { u32x2 w; w.x = pk2(v.x, v.y); w.y = pk2(v.z, v.w); *(u32x2*)p = w; }
DI f32x4 ld_bf16x4(const bf16_t* p) { const u32x2 w = *(const u32x2*)p; return (f32x4){bflo(w.x), bfhi(w.x), bflo(w.y), bfhi(w.y)}; }
DI void rope_pair(f32x4& x0, f32x4& x1, const float* tab, int pos, int fq) {
    const float* t = tab + (size_t)(pos * 16 + 4 * fq) * 2;
    const f32x4 cs0 = *(const f32x4*)t, cs1 = *(const f32x4*)(t + 4);
    const f32x4 c = {cs0.x, cs0.z, cs1.x, cs1.z}, s = {cs0.y, cs0.w, cs1.y, cs1.w};
    const f32x4 a = x0, b = x1;
    x0 = a * c - b * s; x1 = b * c + a * s;
}
struct EpiWin0 {
    static constexpr bool PERM = false, AFTER_DRAIN = false;
    unsigned char* ws;
    DI void operator()(const ACC_T& acc, const pg8::Unit& u, int wr, int wc, int fr, int fq) const {
        const float* tab = (const float*)(ws + WS_ROPE);
#pragma unroll
        for (int ai = 0; ai < 2; ++ai)
#pragma unroll
            for (int m = 0; m < 4; ++m) {
                const int row = u.pm * 256 + ai * 128 + wr * 64 + m * 16 + fr;
                const bool lat = row < ROWS_L;
                const int b = lat ? row >> 11 : (row - ROWS_L) >> 8, tok = lat ? row & 2047 : (row - ROWS_L) & 255;
                if (u.pn < 2) {
                    const int mrow = lat ? b * 32 + (tok >> 6) : 256 + b * 4 + (tok >> 6), s = tok & 63;
#pragma unroll
                    for (int bj = 0; bj < 2; ++bj)
#pragma unroll
                        for (int n = 0; n < 2; ++n) {
                            const int col = u.pn * 256 + bj * 128 + wc * 32 + n * 16 + fq * 4, g = col >> 4, h0 = col & 15;
                            st_bf16x4((bf16_t*)(ws + OV_AS5) + ((size_t)g * S5_MROWS + mrow) * S5_KC + s * 16 + h0, acc[ai][bj][m][n]);
                        }
                } else if (u.pn < 4) {
                    const int pos = (wc & 1) ? (tok & 63) : (tok >> 6);
#pragma unroll
                    for (int bj = 0; bj < 2; ++bj) {
                        f32x4 x0 = acc[ai][bj][m][0], x1 = acc[ai][bj][m][1];
                        if (lat) rope_pair(x0, x1, tab, pos, fq);
                        bf16_t* dst = (bf16_t*)(ws + OV_Q0) + (size_t)row * 512 + (u.pn - 2) * 256 + bj * 128 + wc * 32 + fq * 4;
                        st_bf16x4(dst, x0); st_bf16x4(dst + 16, x1);
                    }
                } else {
                    const int kp = lat ? NC + tok : tok;
                    {
                        const int pos = (wc & 1) ? (tok & 63) : (tok >> 6);
                        f32x4 x0 = acc[ai][0][m][0], x1 = acc[ai][0][m][1];
                        if (lat) rope_pair(x0, x1, tab, pos, fq);
                        bf16_t* dst = (bf16_t*)(ws + OV_K0) + ((size_t)b * NPOS + kp) * 128 + wc * 32 + fq * 4;
                        st_bf16x4(dst, x0); st_bf16x4(dst + 16, x1);
                    }
#pragma unroll
                    for (int n = 0; n < 2; ++n)
#pragma unroll
                        for (int j = 0; j < 4; ++j) {
                            const int cv = wc * 32 + n * 16 + fq * 4 + j;
                            ((bf16_t*)(ws + OV_VT0))[((size_t)b * 128 + cv) * NPOS + kp] = (bf16_t)f2bf(acc[ai][1][m][n][j]);
                        }
                }
            }
    }
};
struct EpiS5a {
    static constexpr bool PERM = false, AFTER_DRAIN = false;
    unsigned char* ws;
    DI void operator()(const ACC_T& acc, const pg8::Unit& u, int wr, int wc, int fr, int fq) const {
        const int g = u.pn, mt = u.pm & 1;
#pragma unroll
        for (int ai = 0; ai < 2; ++ai)
#pragma unroll
            for (int m = 0; m < 4; ++m) {
                const int n = mt * 256 + ai * 128 + wr * 64 + m * 16 + fr;
                if (n < S5_VALID) {
                    float* dst = (float*)(ws + OV_S) + ((size_t)g * S5_MROWS + n) * 256 + wc * 32 + fq * 4;
#pragma unroll
                    for (int bj = 0; bj < 2; ++bj)
#pragma unroll
                        for (int nn = 0; nn < 2; ++nn) *(f32x4*)(dst + bj * 128 + nn * 16) = acc[ai][bj][m][nn];
                }
            }
    }
};
DI float gelu_tanh(float x) {
    const float u = 0.7978845608028654f * (x + 0.044715f * x * x * x);
    const float e = __expf(2.0f * u);
    const float th = 1.0f - 2.0f / (e + 1.0f);
    return 0.5f * x * (1.0f + th);
}
struct EpiS5c {
    static constexpr bool PERM = false, AFTER_DRAIN = false;
    unsigned char* ws; const float* dskip;
    DI void operator()(const ACC_T& acc, const pg8::Unit& u, int wr, int wc, int fr, int fq) const {
        const int g = u.pm >> 1, mt = u.pm & 1, nt = u.pn & 3;
#pragma unroll
        for (int ai = 0; ai < 2; ++ai)
#pragma unroll
            for (int m = 0; m < 4; ++m) {
                const int n = mt * 256 + ai * 128 + wr * 64 + m * 16 + fr;
                if (n < S5_VALID) {
                    const int tokrow0 = n < 256 ? (n >> 5) * NL + (n & 31) * 64 : ROWS_L + ((n - 256) >> 2) * NC + ((n - 256) & 3) * 64;
                    const bf16_t* ur = (const bf16_t*)(ws + OV_AS5) + ((size_t)g * S5_MROWS + n) * S5_KC;
#pragma unroll
                    for (int bj = 0; bj < 2; ++bj)
#pragma unroll
                        for (int nn = 0; nn < 2; ++nn) {
                            const int oc = nt * 256 + bj * 128 + wc * 32 + nn * 16 + fq * 4, t = oc >> 4, c0 = oc & 15;
                            const f32x4 uu = ld_bf16x4(ur + oc), dd = *(const f32x4*)(dskip + g * 16 + c0);
                            f32x4 y = acc[ai][bj][m][nn] + dd * uu;
                            y.x = gelu_tanh(y.x); y.y = gelu_tanh(y.y); y.z = gelu_tanh(y.z); y.w = gelu_tanh(y.w);
                            st_bf16x4((bf16_t*)(ws + OV_Z) + (size_t)(tokrow0 + t) * 512 + g * 16 + c0, y);
                        }
                }
            }
    }
};
struct EpiGlu {
    static constexpr bool PERM = false, AFTER_DRAIN = false;
    unsigned char* ws; const float* bias;
    DI void operator()(const ACC_T& acc, const pg8::Unit& u, int wr, int wc, int fr, int fq) const {
#pragma unroll
        for (int ai = 0; ai < 2; ++ai)
#pragma unroll
            for (int m = 0; m < 4; ++m) {
                const int row = u.pm * 256 + ai * 128 + wr * 64 + m * 16 + fr;
#pragma unroll
                for (int bj = 0; bj < 2; ++bj)
#pragma unroll
                    for (int n = 0; n < 2; ++n) {
                        const int col = u.pn * 256 + bj * 128 + wc * 32 + n * 16 + fq * 4;
                        const f32x4 z = ld_bf16x4((const bf16_t*)(ws + OV_Z) + (size_t)row * 512 + col), t = acc[ai][bj][m][n] + *(const f32x4*)(bias + col);
                        f32x4 o; o.x = z.x / (1.0f + __expf(-t.x)); o.y = z.y / (1.0f + __expf(-t.y)); o.z = z.z / (1.0f + __expf(-t.z)); o.w = z.w / (1.0f + __expf(-t.w));
                        st_bf16x4((bf16_t*)(ws + WS_MIX) + (size_t)row * DM + col, o);
                    }
            }
    }
};
struct EpiResid {
    static constexpr bool PERM = false, AFTER_DRAIN = false;
    unsigned char* ws; const float* x; const float* ctx; int layer;
    DI void operator()(const ACC_T& acc, const pg8::Unit& u, int wr, int wc, int fr, int fq) const {
#pragma unroll
        for (int ai = 0; ai < 2; ++ai)
#pragma unroll
            for (int m = 0; m < 4; ++m) {
                const int row = u.pm * 256 + ai * 128 + wr * 64 + m * 16 + fr;
                const int r = row < ROWS_L ? (row >> 11) : 8;
                const float* md = (const float*)(ws + WS_MOD) + (size_t)(layer * 9 + r) * 6144 + 2 * 1024;
                float* xs = (float*)(ws + WS_XS) + (size_t)row * DM;
                const float* base = layer == 0 ? (row < ROWS_L ? x + (size_t)row * DM : ctx + (size_t)(row - ROWS_L) * DM) : xs;
#pragma unroll
                for (int bj = 0; bj < 2; ++bj)
#pragma unroll
                    for (int n = 0; n < 2; ++n) {
                        const int col = u.pn * 256 + bj * 128 + wc * 32 + n * 16 + fq * 4;
                        *(f32x4*)(xs + col) = *(const f32x4*)(base + col) + *(const f32x4*)(md + col) * acc[ai][bj][m][n];
                    }
            }
    }
};
struct EpiSwiglu {
    static constexpr bool PERM = false, AFTER_DRAIN = false;
    unsigned char* ws; int MT;
    DI void operator()(const ACC_T& acc, const pg8::Unit& u, int wr, int wc, int fr, int fq) const {
        const int j = u.pn & 15;
#pragma unroll
        for (int ai = 0; ai < 2; ++ai)
#pragma unroll
            for (int m = 0; m < 4; ++m) {
                const size_t row = (size_t)u.pm * 256 + ai * 128 + wr * 64 + m * 16 + fr;
#pragma unroll
                for (int n = 0; n < 2; ++n) {
                    const f32x4 gt = acc[ai][0][m][n], up = acc[ai][1][m][n];
                    f32x4 o; o.x = gt.x / (1.0f + __expf(-gt.x)) * up.x; o.y = gt.y / (1.0f + __expf(-gt.y)) * up.y; o.z = gt.z / (1.0f + __expf(-gt.z)) * up.z; o.w = gt.w / (1.0f + __expf(-gt.w)) * up.w;
                    st_bf16x4((bf16_t*)(ws + OV_HID) + row * DE + j * 128 + wc * 32 + n * 16 + fq * 4, o);
                }
            }
    }
};
struct EpiMoeOut {
    static constexpr bool PERM = false, AFTER_DRAIN = false;
    unsigned char* ws;
    DI void operator()(const ACC_T& acc, const pg8::Unit& u, int wr, int wc, int fr, int fq) const {
        const int j = u.pn & 3;
#pragma unroll
        for (int ai = 0; ai < 2; ++ai)
#pragma unroll
            for (int m = 0; m < 4; ++m) {
                const size_t row = (size_t)u.pm * 256 + ai * 128 + wr * 64 + m * 16 + fr;
                const float gt = ((const float*)(ws + WS_GATE))[row];
#pragma unroll
                for (int bj = 0; bj < 2; ++bj)
#pragma unroll
                    for (int n = 0; n < 2; ++n)
                        st_bf16x4((bf16_t*)(ws + OV_YB) + row * DM + j * 256 + bj * 128 + wc * 32 + n * 16 + fq * 4, acc[ai][bj][m][n] * gt);
            }
    }
};
struct EpiWin1 {
    static constexpr bool PERM = false, AFTER_DRAIN = false;
    unsigned char* ws;
    DI void operator()(const ACC_T& acc, const pg8::Unit& u, int wr, int wc, int fr, int fq) const {
        const float* tab = (const float*)(ws + WS_ROPE);
        const int sec = u.pn >> 2, pq = u.pn & 3;
#pragma unroll
        for (int ai = 0; ai < 2; ++ai)
#pragma unroll
            for (int m = 0; m < 4; ++m) {
                const int row = u.pm * 256 + ai * 128 + wr * 64 + m * 16 + fr;
                const bool lat = row < ROWS_L;
                const int b = lat ? row >> 11 : (row - ROWS_L) >> 8, tok = lat ? row & 2047 : (row - ROWS_L) & 255;
                const int kp = lat ? NC + tok : tok;
                if (sec < 2) {
                    const int pos = (wc & 1) ? (tok & 63) : (tok >> 6);
                    bf16_t* dst = sec == 0 ? (bf16_t*)(ws + OV_Q1) + (size_t)row * DM : (bf16_t*)(ws + OV_K1) + ((size_t)b * NPOS + kp) * DM;
#pragma unroll
                    for (int bj = 0; bj < 2; ++bj) {
                        f32x4 x0 = acc[ai][bj][m][0], x1 = acc[ai][bj][m][1];
                        if (lat) rope_pair(x0, x1, tab, pos, fq);
                        bf16_t* d = dst + pq * 256 + bj * 128 + wc * 32 + fq * 4;
                        st_bf16x4(d, x0); st_bf16x4(d + 16, x1);
                    }
                } else {
#pragma unroll
                    for (int bj = 0; bj < 2; ++bj)
#pragma unroll
                        for (int n = 0; n < 2; ++n)
#pragma unroll
                            for (int j = 0; j < 4; ++j) {
                                const int cv = pq * 256 + bj * 128 + wc * 32 + n * 16 + fq * 4 + j;
                                ((bf16_t*)(ws + OV_VT1))[((size_t)b * 1024 + cv) * NPOS + kp] = (bf16_t)f2bf(acc[ai][bj][m][n][j]);
                            }
                }
            }
    }
};
DI int crow(int r, int hi) { return (r & 3) + 8 * (r >> 2) + 4 * hi; }
constexpr float ATT_C2 = 0.125f * 1.4426950408889634f;
constexpr int VPITCH = 136;
constexpr int ATT_K_OFF = 0, ATT_V_OFF = 16384, ATT_WS_OFF = 16384 + 128 * VPITCH, ATT_X_OFF = 40960;
struct AttnJob {
    const bf16_t* q; int qld;
    const bf16_t* k; int kld;
    const bf16_t* vt; int vld;
    int kchunk0;
    int nt;
    int nfree;
    int wpos0;
    int qpos0;
};
template <int DV, int KW, bool WINDOW>
DI void attn_core(LAS unsigned char* lds, const AttnJob& J, f32x16 (&o)[DV / 32], float& m_out, float& l_out) {
    constexpr int NDB = DV / 32, ROWB = KW * 2, NKC = KW / 8;
    const int tid = threadIdx.x, lane = tid & 63, r32 = lane & 31, hi = lane >> 5;
    LAS unsigned char* Kb = lds + ATT_K_OFF; LAS unsigned char* Vb = lds + ATT_V_OFF;
    bf16x8 qf[4];
#pragma unroll
    for (int ks = 0; ks < 4; ++ks) qf[ks] = *(const bf16x8*)(J.q + (size_t)r32 * J.qld + ks * 16 + hi * 8);
#pragma unroll
    for (int d = 0; d < NDB; ++d)
#pragma unroll
        for (int r = 0; r < 16; ++r) o[d][r] = 0.f;
    float m = -1e30f, l = 0.f;
    u32x4 kreg[KW / 64], vreg[DV / 64];
#define ATT_LOAD(t) do { const int k0_ = (t) < J.nfree ? (t) * 64 : NC + J.wpos0 + ((t) - J.nfree) * 64; \
        _Pragma("unroll") for (int i = 0; i < KW / 64; ++i) { const int c = tid + 512 * i, row = c / NKC, ch = c % NKC; kreg[i] = *(const u32x4*)(J.k + (size_t)(k0_ + row) * J.kld + ch * 8); } \
        _Pragma("unroll") for (int i = 0; i < DV / 64; ++i) { const int c = tid + 512 * i, row = c >> 3, ch = c & 7; vreg[i] = *(const u32x4*)(J.vt + (size_t)row * J.vld + k0_ + ch * 8); } } while (0)
    ATT_LOAD(0);
    for (int t = 0; t < J.nt; ++t) {
        __syncthreads();
#pragma unroll
        for (int i = 0; i < KW / 64; ++i) { const int c = tid + 512 * i, row = c / NKC, ch = c % NKC; const int sw = KW == 128 ? (row & 15) : ((row >> 1) & 7);
            *(LAS u32x4*)(Kb + row * ROWB + ((ch ^ sw) << 4)) = kreg[i]; }
#pragma unroll
        for (int i = 0; i < DV / 64; ++i) { const int c = tid + 512 * i, row = c >> 3, ch = c & 7;
            *(LAS u32x2*)(Vb + row * VPITCH + ch * 16) = (u32x2){vreg[i].x, vreg[i].y}; *(LAS u32x2*)(Vb + row * VPITCH + ch * 16 + 8) = (u32x2){vreg[i].z, vreg[i].w}; }
        __syncthreads();
        if (t + 1 < J.nt) ATT_LOAD(t + 1);
        f32x16 s0, s1;
#pragma unroll
        for (int r = 0; r < 16; ++r) { s0[r] = 0.f; s1[r] = 0.f; }
#pragma unroll
        for (int ks = 0; ks < 4; ++ks) {
            const int ch = J.kchunk0 + ks * 2 + hi;
            const int key_a = r32, key_b = 32 + r32;
            const int swa = KW == 128 ? (key_a & 15) : ((key_a >> 1) & 7), swb = KW == 128 ? (key_b & 15) : ((key_b >> 1) & 7);
            const bf16x8 ka = *(const LAS bf16x8*)(Kb + key_a * ROWB + ((ch ^ swa) << 4));
            const bf16x8 kb = *(const LAS bf16x8*)(Kb + key_b * ROWB + ((ch ^ swb) << 4));
            s0 = __builtin_amdgcn_mfma_f32_32x32x16_bf16(ka, qf[ks], s0, 0, 0, 0);
            s1 = __builtin_amdgcn_mfma_f32_32x32x16_bf16(kb, qf[ks], s1, 0, 0, 0);
        }
        if (WINDOW && t >= J.nfree) {
            const int qp = J.qpos0 + r32, kp0 = J.wpos0 + (t - J.nfree) * 64;
#pragma unroll
            for (int r = 0; r < 16; ++r) {
                const int d0 = kp0 + crow(r, hi) - qp, d1 = d0 + 32;
                if (d0 > 128 || d0 < -128) s0[r] = -1e30f;
                if (d1 > 128 || d1 < -128) s1[r] = -1e30f;
            }
        }
        float mx = fmaxf(s0[0], s1[0]);
#pragma unroll
        for (int r = 1; r < 16; ++r) mx = fmaxf(mx, fmaxf(s0[r], s1[r]));
        mx = fmaxf(mx, __shfl_xor(mx, 32));
        if (__any(mx > m + 16.0f)) {
            const float mn = fmaxf(m, mx), al = exp2f((m - mn) * ATT_C2);
            l *= al; m = mn;
            LAS float* wsf = (LAS float*)(lds + ATT_WS_OFF) + (tid >> 6) * 32;
            if (hi == 0) wsf[r32] = al;
#pragma unroll
            for (int r = 0; r < 16; ++r) { const float f = wsf[crow(r, hi)];
#pragma unroll
                for (int d = 0; d < NDB; ++d) o[d][r] *= f; }
        }
        const float mc = m * ATT_C2;
        float ls = 0.f;
#pragma unroll
        for (int r = 0; r < 16; ++r) { s0[r] = exp2f(s0[r] * ATT_C2 - mc); s1[r] = exp2f(s1[r] * ATT_C2 - mc); ls += s0[r] + s1[r]; }
        l += ls;
        bf16x8 pa[4];
#pragma unroll
        for (int kk = 0; kk < 2; ++kk) {
            u32x4 w0, w1;
            w0.x = pk2(s0[8 * kk + 0], s0[8 * kk + 1]); w0.y = pk2(s0[8 * kk + 2], s0[8 * kk + 3]); w0.z = pk2(s0[8 * kk + 4], s0[8 * kk + 5]); w0.w = pk2(s0[8 * kk + 6], s0[8 * kk + 7]);
            w1.x = pk2(s1[8 * kk + 0], s1[8 * kk + 1]); w1.y = pk2(s1[8 * kk + 2], s1[8 * kk + 3]); w1.z = pk2(s1[8 * kk + 4], s1[8 * kk + 5]); w1.w = pk2(s1[8 * kk + 6], s1[8 * kk + 7]);
            pa[kk] = __builtin_bit_cast(bf16x8, w0); pa[2 + kk] = __builtin_bit_cast(bf16x8, w1);
        }
#pragma unroll
        for (int d = 0; d < NDB; ++d)
#pragma unroll
            for (int kk = 0; kk < 4; ++kk) {
                LAS unsigned char* vp = Vb + (d * 32 + r32) * VPITCH + (kk * 16 + hi * 4) * 2;
                const s16x4 lo = *(const LAS s16x4*)vp, hh = *(const LAS s16x4*)(vp + 16);
                const bf16x8 vf = __builtin_shufflevector(lo, hh, 0, 1, 2, 3, 4, 5, 6, 7);
                o[d] = __builtin_amdgcn_mfma_f32_32x32x16_bf16(pa[kk], vf, o[d], 0, 0, 0);
            }
    }
#undef ATT_LOAD
    m_out = m; l_out = l + __shfl_xor(l, 32);
}
template <int NDB> DI void attn_scale_rows(LAS unsigned char* lds, f32x16 (&o)[NDB], float f) {
    const int tid = threadIdx.x, lane = tid & 63, r32 = lane & 31, hi = lane >> 5;
    LAS float* wsf = (LAS float*)(lds + ATT_WS_OFF) + (tid >> 6) * 32;
    if (hi == 0) wsf[r32] = f;
#pragma unroll
    for (int r = 0; r < 16; ++r) { const float g = wsf[crow(r, hi)];
#pragma unroll
        for (int d = 0; d < NDB; ++d) o[d][r] *= g; }
}
DI void pwin_attn_phase(const Args& a, LAS unsigned char* lds, int G, int first_wg) {
    const int tid = threadIdx.x, lane = tid & 63, r32 = lane & 31, hi = lane >> 5, wave = __builtin_amdgcn_readfirstlane(tid >> 6);
    const bf16_t* Q0 = (const bf16_t*)(a.ws + OV_Q0); const bf16_t* K0 = (const bf16_t*)(a.ws + OV_K0); const bf16_t* VT0 = (const bf16_t*)(a.ws + OV_VT0);
    bf16_t* MIX = (bf16_t*)(a.ws + WS_MIX);
    const int vb = (blockIdx.x - first_wg + G) % G;
    for (int it = vb; it < 576; it += G) {
        AttnJob J; int qh, row0;
        int b, kvh;
        if (it < 512) {
            b = it >> 6; kvh = (it >> 5) & 1; const int nb = (it >> 1) & 15, pr = it & 1;
            qh = kvh * 4 + pr * 2 + (wave >> 2); const int ql = nb * 128 + (wave & 3) * 32; row0 = b * NL + ql;
            const int first = nb == 0 ? 0 : (nb - 1) * 128, last = nb == 15 ? NL : (nb + 2) * 128;
            J.nfree = 4; J.nt = 4 + (last - first) / 64; J.wpos0 = first; J.qpos0 = ql;
        } else {
            const int r = it - 512; b = r >> 3; kvh = (r >> 2) & 1; const int idx = (r & 3) * 8 + wave;
            qh = kvh * 4 + (idx >> 3); row0 = ROWS_L + b * NC + (idx & 7) * 32;
            J.nfree = 4; J.nt = 4; J.wpos0 = 0; J.qpos0 = 0;
        }
        J.q = Q0 + (size_t)row0 * 512 + qh * 64; J.qld = 512;
        J.k = K0 + (size_t)b * NPOS * 128 + kvh * 64; J.kld = 128;
        J.vt = VT0 + (size_t)(b * 2 + kvh) * 64 * NPOS; J.vld = NPOS;
        J.kchunk0 = 0;
        f32x16 o[2]; float m, l;
        attn_core<64, 64, true>(lds, J, o, m, l);
        l += exp2f(a.in[I_SINK][qh] * 1.4426950408889634f - m * ATT_C2);
        attn_scale_rows<2>(lds, o, 1.0f / l);
#pragma unroll
        for (int d = 0; d < 2; ++d)
#pragma unroll
            for (int r = 0; r < 16; ++r)
                MIX[(size_t)(row0 + crow(r, hi)) * DM + 512 + qh * 64 + d * 32 + r32] = (bf16_t)f2bf(o[d][r]);
    }
}
DI void pdiff_attn_phase(const Args& a, LAS unsigned char* lds, int G) {
    const int tid = threadIdx.x, lane = tid & 63, r32 = lane & 31, hi = lane >> 5, wave = __builtin_amdgcn_readfirstlane(tid >> 6);
    const bf16_t* Q1 = (const bf16_t*)(a.ws + OV_Q1); const bf16_t* K1 = (const bf16_t*)(a.ws + OV_K1); const bf16_t* VT1 = (const bf16_t*)(a.ws + OV_VT1);
    bf16_t* MIX = (bf16_t*)(a.ws + WS_MIX);
    float d1 = a.in[I_LQ1][lane] * a.in[I_LK1][lane], d2 = a.in[I_LQ2][lane] * a.in[I_LK2][lane];
    d1 = wave_sum(d1); d2 = wave_sum(d2);
    const float lam = expf(d1) - expf(d2) + LAM_INIT1;
    for (int it = blockIdx.x; it < 1024; it += G) {
        const int b = it >> 7, h = (it >> 4) & 7, qb = it & 15, mp = wave >> 2;
        const int row0 = b * NL + qb * 128 + (wave & 3) * 32;
        AttnJob J;
        J.q = Q1 + (size_t)row0 * DM + h * 128 + mp * 64; J.qld = DM;
        J.k = K1 + (size_t)b * NPOS * DM + h * 128; J.kld = DM;
        J.vt = VT1 + (size_t)(b * 8 + h) * 128 * NPOS; J.vld = NPOS;
        J.kchunk0 = mp * 8; J.nt = NPOS / 64; J.nfree = NPOS / 64; J.wpos0 = 0; J.qpos0 = 0;
        f32x16 o[4]; float m, l;
        attn_core<128, 128, false>(lds, J, o, m, l);
        attn_scale_rows<4>(lds, o, 1.0f / l);
        __syncthreads();
        LAS float* xb = (LAS float*)(lds + ATT_X_OFF) + (wave & 3) * 32 * 128;
        if (mp == 1) {
#pragma unroll
            for (int d = 0; d < 4; ++d)
#pragma unroll
                for (int r = 0; r < 16; ++r) xb[crow(r, hi) * 128 + d * 32 + r32] = o[d][r];
        }
        __syncthreads();
        if (mp == 0) {
            float ss[16];
#pragma unroll
            for (int r = 0; r < 16; ++r) {
                float s = 0.f;
#pragma unroll
                for (int d = 0; d < 4; ++d) { const float v = o[d][r] - lam * xb[crow(r, hi) * 128 + d * 32 + r32]; o[d][r] = v; s += v * v; }
                ss[r] = s;
            }
#pragma unroll
            for (int r = 0; r < 16; ++r) {
#pragma unroll
                for (int x = 1; x < 32; x <<= 1) ss[r] += __shfl_xor(ss[r], x);
                ss[r] = (1.0f - LAM_INIT1) / sqrtf(ss[r] * (1.0f / 128.0f) + NORM_EPS);
            }
#pragma unroll
            for (int d = 0; d < 4; ++d) {
                const float gsub = a.in[I_SUBLN][d * 32 + r32];
#pragma unroll
                for (int r = 0; r < 16; ++r)
                    MIX[(size_t)(row0 + crow(r, hi)) * DM + h * 128 + d * 32 + r32] = (bf16_t)f2bf(o[d][r] * ss[r] * gsub);
            }
        }
        __syncthreads();
    }
}
__global__ void __launch_bounds__(NTHREADS, 2) fwd_megakernel(Args a) {
    extern __shared__ __attribute__((aligned(16))) unsigned char lds_raw[];
    LAS unsigned char* lds = (LAS unsigned char*)lds_raw;
    volatile LAS unsigned* MISC = (volatile LAS unsigned*)(lds + MISC_OFF);
    const int tid = threadIdx.x, G = gridDim.x;
    for (int u = tid; u < (LDS_BYTES - RING_BYTES) / 4; u += NTHREADS) ((LAS unsigned*)(lds + RING_BYTES))[u] = 0u;
    __syncthreads();
    unsigned char* ws = a.ws;
    XcdBarrier bar = xcd_barrier_post((unsigned*)(ws + WS_CTL) + 4096, MISC + 8);
    const int lo = a.ph_lo, hi = a.ph_hi;
#define IN(k) (lo <= (k) && (k) < hi)
#define SEAM(k) do { if (IN(k) && IN((k) + 1)) xcd_barrier(bar); } while (0)
    const int cblk = (int)blockIdx.x;
    if (IN(0)) { p0_phase(a, lds, G); } SEAM(0);
    if (IN(1)) { p1_phase(a, G); } SEAM(1);
    if (IN(2)) {
        pg8::Gemm g{(const bf16_t*)(ws + WS_HX), (const bf16_t*)(ws + WS_WIN0T), 1024, 1024, 1024}; pg8::StaticOrder S; S.init(ROWS, 1280, G, cblk);
        EpiWin0 E{ws}; pg8::gemm_phase<EpiWin0, pg8::StaticOrder, true, true>(lds, g, S, E);
    } SEAM(2);
    if (IN(3)) {
        pg8::Gemm g{(const bf16_t*)(ws + OV_AS5), (const bf16_t*)(ws + OV_BTA), 1024, S5_KC, 1024}; GroupOrder S; S.init(S5G, 2, 1, G, cblk);
        EpiS5a E{ws}; pg8::gemm_phase<EpiS5a, GroupOrder, true, true>(lds, g, S, E);
        pwin_attn_phase(a, lds, G, 64);
    } SEAM(3);
    if (IN(4)) { ps5_rec_phase(a, G); } SEAM(4);
    if (IN(5)) {
        pg8::Gemm g{(const bf16_t*)(ws + OV_AS5), (const bf16_t*)(ws + OV_BTC), S5_KC, S5_KC, S5_KC}; GroupOrder S; S.init(S5G, 2, 4, G, cblk);
        EpiS5c E{ws, a.in[I_S5D]}; pg8::gemm_phase<EpiS5c, GroupOrder, true, true>(lds, g, S, E);
    } SEAM(5);
    if (IN(6)) {
        pg8::Gemm g{(const bf16_t*)(ws + OV_Z), (const bf16_t*)(ws + WS_WGLUT), 512, 512, 512}; pg8::StaticOrder S; S.init(ROWS, 512, G, cblk);
        EpiGlu E{ws, a.in[I_GLUB]}; pg8::gemm_phase<EpiGlu, pg8::StaticOrder, true, true>(lds, g, S, E);
    } SEAM(6);
    if (IN(7)) {
        pg8::Gemm g{(const bf16_t*)(ws + WS_MIX), (const bf16_t*)(ws + WS_WOUT0T), 1024, 1024, 1024}; pg8::StaticOrder S; S.init(ROWS, 1024, G, cblk);
        EpiResid E{ws, a.in[I_X], a.in[I_CTX], 0}; pg8::gemm_phase<EpiResid, pg8::StaticOrder, true, true>(lds, g, S, E);
    } SEAM(7);
    if (IN(8)) { pnorm_router_phase(a, G, 0, ROWS); } SEAM(8);
    if (IN(9)) { ptopk_phase(a, lds, G, 1, 2304); } SEAM(9);
    if (IN(10)) {
        pg8::Gemm g{(const bf16_t*)(ws + OV_XG), (const bf16_t*)(ws + WS_W1T), 1024, 1024, 1024}; GroupOrder S; S.init(NE, 9, 16, G, cblk);
        EpiSwiglu E{ws, 9}; pg8::gemm_phase<EpiSwiglu, GroupOrder, true, true>(lds, g, S, E);
    } SEAM(10);
    if (IN(11)) {
        pg8::Gemm g{(const bf16_t*)(ws + OV_HID), (const bf16_t*)(ws + WS_W2T), 2048, 2048, 2048}; GroupOrder S; S.init(NE, 9, 4, G, cblk);
        EpiMoeOut E{ws}; pg8::gemm_phase<EpiMoeOut, GroupOrder, true, true>(lds, g, S, E);
    } SEAM(11);
    if (IN(12)) { pcombine_phase(a, G, 0, ROWS, 2304); } SEAM(12);
    if (IN(13)) {
        pg8::Gemm g{(const bf16_t*)(ws + WS_HX), (const bf16_t*)(ws + WS_WIN1T), 1024, 1024, 1024}; Win1Order S; S.init(G, cblk);
        EpiWin1 E{ws}; pg8::gemm_phase<EpiWin1, Win1Order, true, true>(lds, g, S, E);
    } SEAM(13);
    if (IN(14)) { pdiff_attn_phase(a, lds, G); } SEAM(14);
    if (IN(15)) {
        pg8::Gemm g{(const bf16_t*)(ws + WS_MIX), (const bf16_t*)(ws + WS_WOUT1T), 1024, 1024, 1024}; pg8::StaticOrder S; S.init(ROWS_L, 1024, G, cblk);
        EpiResid E{ws, a.in[I_X], a.in[I_CTX], 1}; pg8::gemm_phase<EpiResid, pg8::StaticOrder, true, true>(lds, g, S, E);
    } SEAM(15);
    if (IN(16)) { pnorm_router_phase(a, G, 1, ROWS_L); } SEAM(16);
    if (IN(17)) { ptopk_phase(a, lds, G, 0, 2048); } SEAM(17);
    if (IN(18)) {
        pg8::Gemm g{(const bf16_t*)(ws + OV_XG), (const bf16_t*)(ws + WS_W1T) + (size_t)16 * 4096 * 1024, 1024, 1024, 1024}; GroupOrder S; S.init(NE, 8, 16, G, cblk);
        EpiSwiglu E{ws, 8}; pg8::gemm_phase<EpiSwiglu, GroupOrder, true, true>(lds, g, S, E);
    } SEAM(18);
    if (IN(19)) {
        pg8::Gemm g{(const bf16_t*)(ws + OV_HID), (const bf16_t*)(ws + WS_W2T) + (size_t)16 * 1024 * 2048, 2048, 2048, 2048}; GroupOrder S; S.init(NE, 8, 4, G, cblk);
        EpiMoeOut E{ws}; pg8::gemm_phase<EpiMoeOut, GroupOrder, true, true>(lds, g, S, E);
    } SEAM(19);
    if (IN(20)) { pcombine_phase(a, G, 1, ROWS_L, 2048); }
#undef IN
#undef SEAM
}

extern "C" void kernel_launch(void* const* d_in, const int* in_sizes, int n_in, void* d_out, int out_size, void* d_ws, size_t ws_size, hipStream_t stream) {
    static int grid = 0;
    if (grid == 0) {
        if (n_in != 33 || out_size != ROWS_L * DM || ws_size < WS_END) { fprintf(stderr, "kernel_launch: unexpected shapes (n_in %d, out %d, ws %zu; need ws >= %zu)\n", n_in, out_size, ws_size, (size_t)WS_END); grid = -1; return; }
        int dev = 0, cus = 0, per_cu = 0;
        if (hipGetDevice(&dev) != hipSuccess || hipDeviceGetAttribute(&cus, hipDeviceAttributeMultiprocessorCount, dev) != hipSuccess) { grid = -1; return; }
        if (hipFuncSetAttribute((const void*)fwd_megakernel, hipFuncAttributeMaxDynamicSharedMemorySize, LDS_BYTES) != hipSuccess) { fprintf(stderr, "kernel_launch: hipFuncSetAttribute failed\n"); grid = -1; return; }
        if (hipOccupancyMaxActiveBlocksPerMultiprocessor(&per_cu, (const void*)fwd_megakernel, NTHREADS, LDS_BYTES) != hipSuccess || per_cu < 1) { fprintf(stderr, "kernel_launch: occupancy query reports %d\n", per_cu); }
        (void)hipGetLastError();
        grid = cus;
    }
    if (grid < 0) return;
    (void)hipMemsetAsync((char*)d_ws + WS_CTL, 0, CTL_BYTES, stream);
    Args a{};
    for (int i = 0; i < 33; ++i) a.in[i] = (const float*)d_in[i];
    a.out = (float*)d_out; a.ws = (unsigned char*)d_ws; a.ph_lo = 0; a.ph_hi = 21;
    hipLaunchKernelGGL(fwd_megakernel, dim3(grid), dim3(NTHREADS), LDS_BYTES, stream, a);
}
```

```cpp
#include <hip/hip_runtime.h>
#include <cstdio>
#include <cstdint>
#include <cmath>

#define LAS __attribute__((address_space(3)))
#define GAS __attribute__((address_space(1)))
#define DI __device__ __forceinline__
typedef unsigned short bf16_t;
typedef short bf16x8 __attribute__((ext_vector_type(8)));
typedef short s16x4 __attribute__((ext_vector_type(4)));
typedef float f32x4 __attribute__((ext_vector_type(4)));
typedef float f32x2 __attribute__((ext_vector_type(2)));
typedef float f32x16 __attribute__((ext_vector_type(16)));
typedef unsigned u32x4 __attribute__((ext_vector_type(4)));
typedef unsigned u32x2 __attribute__((ext_vector_type(2)));
typedef __bf16 bf16x2_t __attribute__((ext_vector_type(2)));

constexpr int DM = 1024, NB = 8, NL = 2048, NC = 256;
constexpr int ROWS_L = NB * NL, ROWS_C = NB * NC, ROWS = ROWS_L + ROWS_C;
constexpr int NPOS = NC + NL;
constexpr int NE = 16, DE = 2048, CAP_L = 256, CAP_C = 32;
constexpr int S5G = 32, S5P = 64, S5T = 32;
constexpr int S5_MROWS = 768, S5_VALID = 576, S5_KC = 768;
constexpr float NORM_EPS = 1e-6f;
constexpr float LAM_INIT1 = 0.35550906759f;

constexpr size_t MiB = 1u << 20;
constexpr size_t WS_CTL = 0, CTL_BYTES = 64 * 1024;
constexpr size_t WS_MOD = 1 * MiB;
constexpr size_t WS_ROPE = 2 * MiB;
constexpr size_t WS_APOW = 2 * MiB + 65536;
constexpr size_t WS_DBG = 2 * MiB + 262144;
constexpr size_t WS_KTAB = 3 * MiB;
constexpr size_t WS_WIN0T = 8 * MiB;
constexpr size_t WS_WGLUT = 11 * MiB;
constexpr size_t WS_WOUT0T = 12 * MiB;
constexpr size_t WS_WIN1T = 14 * MiB;
constexpr size_t WS_WOUT1T = 20 * MiB;
constexpr size_t WS_AFFL = 22 * MiB;
constexpr size_t WS_AFFC = 23 * MiB;
constexpr size_t WS_TOKSLOT = 24 * MiB;
constexpr size_t WS_GATE = 26 * MiB;
constexpr size_t WS_SELROW = 27 * MiB;
constexpr size_t WS_XS = 32 * MiB;
constexpr size_t WS_HX = 104 * MiB;
constexpr size_t WS_MIX = 140 * MiB;
constexpr size_t WS_W1T = 176 * MiB;
constexpr size_t WS_W2T = 432 * MiB;
constexpr size_t WS_OV = 560 * MiB;
constexpr size_t OV_BTA = WS_OV + 0 * MiB;
constexpr size_t OV_BTC = WS_OV + 16 * MiB;
constexpr size_t OV_AS5 = WS_OV + 96 * MiB;
constexpr size_t OV_S = WS_OV + 40 * MiB;
constexpr size_t OV_Z = WS_OV + 152 * MiB;
constexpr size_t OV_Q0 = WS_OV + 170 * MiB;
constexpr size_t OV_K0 = WS_OV + 188 * MiB;
constexpr size_t OV_VT0 = WS_OV + 193 * MiB;
constexpr size_t OV_XG = WS_OV + 0 * MiB;
constexpr size_t OV_HID = WS_OV + 72 * MiB;
constexpr size_t OV_YB = WS_OV + 216 * MiB;
constexpr size_t OV_Q1 = WS_OV + 0 * MiB;
constexpr size_t OV_K1 = WS_OV + 32 * MiB;
constexpr size_t OV_VT1 = WS_OV + 68 * MiB;
constexpr size_t OV_YBS = WS_OV + 288 * MiB;
constexpr size_t WS_END = WS_OV + 320 * MiB;

constexpr int NTHREADS = 512, NWAVES = 8;
constexpr int RING_BYTES = 131072, MISC_OFF = RING_BYTES + 320, LDS_BYTES = 147456;

DI unsigned f2bf(float f) { unsigned u = __builtin_bit_cast(unsigned, f); return (u + 0x7fffu + ((u >> 16) & 1u)) >> 16; }
DI unsigned pk2(float lo, float hi) { f32x2 v = {lo, hi}; bf16x2_t b = __builtin_convertvector(v, bf16x2_t); return __builtin_bit_cast(unsigned, b); }
DI float bf2f(unsigned short h) { return __builtin_bit_cast(float, (unsigned)h << 16); }
DI float bflo(unsigned w) { return __builtin_bit_cast(float, w << 16); }
DI float bfhi(unsigned w) { return __builtin_bit_cast(float, w & 0xffff0000u); }
DI float wave_sum(float v) {
#pragma unroll
    for (int o = 1; o < 64; o <<= 1) v += __shfl_xor(v, o);
    return v;
}
namespace pg8 {
#define PG8_LAS __attribute__((address_space(3)))
typedef unsigned short bf16_t;
typedef short bf16x8 __attribute__((ext_vector_type(8)));
typedef float f32x4 __attribute__((ext_vector_type(4)));
typedef unsigned u32x4 __attribute__((ext_vector_type(4)));
constexpr int BM = 256, BK = 64, HALF = 128, HTB = HALF * BK * 2  , STAGE_BYTES = 8 * HTB, NXCD = 8, WGM = 8;

__host__ __device__ __forceinline__ int lds_byte(int r, int c) { const int st = (r >> 4) * 2 + (c >> 5), rr = r & 15, cc = c & 31, ob = rr * 64 + cc * 2; return st * 1024 + (ob ^ (((ob >> 9) & 1) << 5)); }
__host__ __device__ __forceinline__ void stage_rc(int b, int& R, int& C) { const int st = b / 1024, sb = b % 1024, swz = sb ^ (((sb >> 9) & 1) << 5); R = (st >> 1) * 16 + swz / 64; C = (st & 1) * 32 + (swz % 64) / 2; }
__host__ __device__ __forceinline__ int perm32(int rho) { const int n = rho >> 4, i = rho & 15; return 8 * (i >> 2) + 4 * n + (i & 3); }

struct Unit { int pm, pn; };
struct Gemm { const bf16_t* A; const bf16_t* Bt; int K, lda, ldb; };

struct StaticOrder {
    int nM, nN, nwg, G, c;
    __host__ __device__ void init(int M, int N, int G_, int c_) { nM = M / BM; nN = N / BM; nwg = nM * nN; G = G_; c = c_; }
    __host__ __device__ bool next(int i, Unit& u) const {
        const long L = (long)i * G + c; if (L >= nwg) return false;
        int wgid = (int)L; { const int q = nwg / NXCD, r = nwg % NXCD, xcd = wgid % NXCD, off = wgid / NXCD; wgid = (xcd < r ? xcd * (q + 1) : r * (q + 1) + (xcd - r) * q) + off; }
        const int nig = WGM * nN, gid = wgid / nig, fm = gid * WGM, gsz = (nM - fm) < WGM ? (nM - fm) : WGM;
        u.pm = fm + ((wgid % nig) % gsz); u.pn = (wgid % nig) / gsz; return true;
    }
    __device__ __forceinline__ void a_ready(const Unit&) const {}
    __device__ __forceinline__ void done(const Unit&) const {}
};


template <class Epi, class Sched, bool ALIGN_EPI = false, bool SP2 = false, bool GATHER = false>
__device__ __forceinline__ void gemm_phase(PG8_LAS unsigned char* lds, const Gemm g, const Sched& S, const Epi& E, const PG8_LAS int* gidx = nullptr) {
    const int tid = threadIdx.x, wid = __builtin_amdgcn_readfirstlane(tid >> 6), lane = tid & 63, wr = wid >> 2, wc = wid & 3, fr = lane & 15, fq = lane >> 4;
    const int K = g.K, nt = K / BK, lda = g.lda, ldb = g.ldb;
    unsigned voffA[2], voffB[2];
#pragma unroll
    for (int i = 0; i < 2; ++i) { int R, C; stage_rc(tid * 16 + i * 8192, R, C); const int Rb = Epi::PERM ? ((R & ~31) + perm32(R & 31)) : R;
        voffA[i] = (unsigned)(R * lda + C) * 2u; voffB[i] = (unsigned)(Rb * ldb + C) * 2u; }
    const size_t kstep = (size_t)(BK * 2);
    const size_t hstepA = (size_t)HALF * lda * 2, hstepB = (size_t)HALF * ldb * 2;
    const size_t tstepA = 2 * hstepA, tstepB = 2 * hstepB;
    unsigned gc0[2] = {0u, 0u}, gc1[2] = {0u, 0u}, gn0[2] = {0u, 0u}, gn1[2] = {0u, 0u};
#define PG8_GOFF(ui_, o0, o1) do { _Pragma("unroll") for (int i_ = 0; i_ < 2; ++i_) { int R_, C_; stage_rc(tid * 16 + i_ * 8192, R_, C_); \
        o0[i_] = (unsigned)gidx[(ui_) * 256 + R_] * (unsigned)(lda * 2) + (unsigned)(C_ * 2); o1[i_] = (unsigned)gidx[(ui_) * 256 + 128 + R_] * (unsigned)(lda * 2) + (unsigned)(C_ * 2); } \
        asm volatile("s_waitcnt lgkmcnt(0)" ::: "memory"); } while (0)
#define PG8_STA(bufoff, ptr, h, sel) do { if constexpr (GATHER) { PG8_STAGE(bufoff, ptr, g##sel##h); } else { PG8_STAGE(bufoff, (ptr) + (h) * hstepA, voffA); } } while (0)
    const unsigned ldsw = (unsigned)wid * 1024u;
    const int aoff = lds_byte(wr * 64 + fr, fq * 8), boff = lds_byte(wc * 32 + fr, fq * 8);
#define PG8_SA(b, h) (((b) * 2 + (h)) * HTB)
#define PG8_SB(b, h) ((4 + (b) * 2 + (h)) * HTB)
#define PG8_STAGE(bufoff, gbase, voff) do { _Pragma("unroll") for (int _i = 0; _i < 2; ++_i) \
        __builtin_amdgcn_global_load_lds((const unsigned*)((const char*)(gbase) + (voff)[_i]), (PG8_LAS unsigned*)(lds + (bufoff) + ldsw + _i * 8192), 16, 0, 0); } while (0)
#define PG8_LDA(dst, b, h) do { _Pragma("unroll") for (int m = 0; m < 4; ++m) _Pragma("unroll") for (int k = 0; k < 2; ++k) dst[m][k] = *(const PG8_LAS bf16x8*)(lds + PG8_SA(b, h) + aoff + m * 2048 + k * 1024); } while (0)
#define PG8_LDB(dst, b, h) do { _Pragma("unroll") for (int n = 0; n < 2; ++n) _Pragma("unroll") for (int k = 0; k < 2; ++k) dst[n][k] = *(const PG8_LAS bf16x8*)(lds + PG8_SB(b, h) + boff + n * 2048 + k * 1024); } while (0)
#define PG8_MMA(ai, bj, At, Bt) do { __builtin_amdgcn_s_setprio(1); _Pragma("unroll") for (int m = 0; m < 4; ++m) _Pragma("unroll") for (int n = 0; n < 2; ++n) _Pragma("unroll") for (int k = 0; k < 2; ++k) \
        acc[ai][bj][m][n] = __builtin_amdgcn_mfma_f32_16x16x32_bf16(Bt[n][k], At[m][k], acc[ai][bj][m][n], 0, 0, 0); __builtin_amdgcn_s_setprio(0); } while (0)
#define PG8_WAIT_V(n) asm volatile("s_waitcnt vmcnt(" #n ")" ::: "memory")
#define PG8_WAIT_L(n) asm volatile("s_waitcnt lgkmcnt(" #n ")" ::: "memory")
#define PG8_BAR __builtin_amdgcn_s_barrier()
#define PG8_SCHED __builtin_amdgcn_sched_barrier(0)
    Unit cur, nxt; int ui = 0;
    if (!S.next(0, cur)) return;
    f32x4 acc[2][2][4][2];
#pragma unroll
    for (int a = 0; a < 2; ++a)
#pragma unroll
        for (int b = 0; b < 2; ++b)
#pragma unroll
            for (int m = 0; m < 4; ++m)
#pragma unroll
                for (int n = 0; n < 2; ++n) acc[a][b][m][n] = (f32x4){0.f, 0.f, 0.f, 0.f};
    bf16x8 At[4][2], B0[2][2], B1[2][2];
    const char* cA = GATHER ? (const char*)g.A : (const char*)g.A + (size_t)cur.pm * tstepA;
    if constexpr (GATHER) PG8_GOFF(0, gc0, gc1);
    const char* cB = (const char*)g.Bt + (size_t)cur.pn * tstepB;
    S.a_ready(cur);
    if constexpr (SP2) {
        PG8_STAGE(PG8_SB(0, 0), cB, voffB); PG8_STAGE(PG8_SB(0, 1), cB + hstepB, voffB); PG8_STA(PG8_SA(0, 0), cA, 0, c); PG8_STA(PG8_SA(0, 1), cA, 1, c);
        if (wr == 1) PG8_BAR;
        PG8_WAIT_V(2); PG8_BAR;
        PG8_STAGE(PG8_SB(1, 0), cB + kstep, voffB); PG8_STA(PG8_SA(1, 0), cA + kstep, 0, c); PG8_STAGE(PG8_SB(1, 1), cB + hstepB + kstep, voffB);
        PG8_WAIT_V(6); PG8_BAR;
    } else {
        PG8_STAGE(PG8_SB(0, 0), cB, voffB); PG8_STA(PG8_SA(0, 0), cA, 0, c); PG8_STAGE(PG8_SB(0, 1), cB + hstepB, voffB); PG8_STA(PG8_SA(0, 1), cA, 1, c);
        if (wr == 1) PG8_BAR;
        PG8_WAIT_V(4); PG8_BAR;
        PG8_STAGE(PG8_SB(1, 0), cB + kstep, voffB); PG8_STA(PG8_SA(1, 0), cA + kstep, 0, c); PG8_STAGE(PG8_SB(1, 1), cB + hstepB + kstep, voffB);
        PG8_WAIT_V(6); PG8_BAR;
    }
    for (;;) {
        const bool has_next = S.next(ui + 1, nxt);
        const char* nA = GATHER ? cA : (has_next ? (const char*)g.A + (size_t)nxt.pm * tstepA : cA);
        if constexpr (GATHER) { if (has_next) PG8_GOFF(ui + 1, gn0, gn1); else { gn0[0] = gc0[0]; gn0[1] = gc0[1]; gn1[0] = gc1[0]; gn1[1] = gc1[1]; } }
        const char* nB = has_next ? (const char*)g.Bt + (size_t)nxt.pn * tstepB : cB;
        for (int t = 0; t < nt; t += 2) {
            const bool last = (t == nt - 2);
            const char* a1 = cA + (size_t)(t + 1) * kstep;
            const char* a2 = last ? nA : cA + (size_t)(t + 2) * kstep; const char* b2 = last ? nB : cB + (size_t)(t + 2) * kstep;
            const char* a3 = a2 + kstep; const char* b3 = b2 + kstep;
            unsigned gx0[2] = {0u, 0u}, gx1[2] = {0u, 0u};
            if constexpr (GATHER) { gx0[0] = last ? gn0[0] : gc0[0]; gx0[1] = last ? gn0[1] : gc0[1]; gx1[0] = last ? gn1[0] : gc1[0]; gx1[1] = last ? gn1[1] : gc1[1]; }
            if (last && has_next) S.a_ready(nxt);
            if constexpr (SP2) {
            PG8_LDB(B0, 0, 0); PG8_LDB(B1, 0, 1); PG8_SCHED; PG8_LDA(At, 0, 0); PG8_STA(PG8_SA(1, 1), a1, 1, c);
            PG8_WAIT_V(8); PG8_WAIT_L(0); PG8_BAR; PG8_MMA(0, 0, At, B0); PG8_MMA(0, 1, At, B1); PG8_BAR; PG8_SCHED;
            PG8_LDA(At, 0, 1); PG8_STAGE(PG8_SB(0, 0), b2, voffB); PG8_STAGE(PG8_SB(0, 1), b2 + hstepB, voffB); PG8_STA(PG8_SA(0, 0), a2, 0, x);
            PG8_WAIT_V(8); PG8_WAIT_L(0); PG8_BAR; PG8_MMA(1, 0, At, B0); PG8_MMA(1, 1, At, B1); PG8_BAR; PG8_SCHED;
            PG8_LDB(B0, 1, 0); PG8_LDB(B1, 1, 1); PG8_SCHED; PG8_LDA(At, 1, 0); PG8_STA(PG8_SA(0, 1), a2, 1, x);
            PG8_WAIT_V(8); PG8_WAIT_L(0); PG8_BAR; PG8_MMA(0, 0, At, B0); PG8_MMA(0, 1, At, B1); PG8_BAR; PG8_SCHED;
            PG8_LDA(At, 1, 1); PG8_STAGE(PG8_SB(1, 0), b3, voffB); PG8_STAGE(PG8_SB(1, 1), b3 + hstepB, voffB); PG8_STA(PG8_SA(1, 0), a3, 0, x);
            PG8_WAIT_V(8); PG8_WAIT_L(0); PG8_BAR; PG8_MMA(1, 0, At, B0); PG8_MMA(1, 1, At, B1); PG8_BAR; PG8_SCHED;
            } else {
            PG8_LDB(B0, 0, 0); PG8_SCHED; PG8_LDA(At, 0, 0); PG8_STA(PG8_SA(1, 1), a1, 1, c);
            PG8_WAIT_L(8); PG8_BAR; PG8_WAIT_L(0); PG8_MMA(0, 0, At, B0); PG8_BAR; PG8_SCHED;
            PG8_LDB(B1, 0, 1); PG8_STAGE(PG8_SB(0, 0), b2, voffB);
            PG8_BAR; PG8_WAIT_L(0); PG8_MMA(0, 1, At, B1); PG8_BAR;
            PG8_LDA(At, 0, 1); PG8_STA(PG8_SA(0, 0), a2, 0, x);
            PG8_BAR; PG8_WAIT_L(0); PG8_MMA(1, 0, At, B0); PG8_BAR; PG8_SCHED;
            PG8_STAGE(PG8_SB(0, 1), b2 + hstepB, voffB);
            PG8_WAIT_V(6); PG8_BAR; PG8_MMA(1, 1, At, B1); PG8_BAR;
            PG8_LDB(B0, 1, 0); PG8_SCHED; PG8_LDA(At, 1, 0); PG8_STA(PG8_SA(0, 1), a2, 1, x);
            PG8_WAIT_L(8); PG8_BAR; PG8_WAIT_L(0); PG8_MMA(0, 0, At, B0); PG8_BAR; PG8_SCHED;
            PG8_LDB(B1, 1, 1); PG8_STAGE(PG8_SB(1, 0), b3, voffB);
            PG8_BAR; PG8_WAIT_L(0); PG8_MMA(0, 1, At, B1); PG8_BAR;
            PG8_LDA(At, 1, 1); PG8_STA(PG8_SA(1, 0), a3, 0, x);
            PG8_BAR; PG8_WAIT_L(0); PG8_MMA(1, 0, At, B0); PG8_BAR; PG8_SCHED;
            PG8_STAGE(PG8_SB(1, 1), b3 + hstepB, voffB);
            PG8_WAIT_V(6); PG8_BAR; PG8_MMA(1, 1, At, B1); PG8_BAR;
            }
        }
        if constexpr (ALIGN_EPI) { if (wr == 0) PG8_BAR; }
        if constexpr (!Epi::AFTER_DRAIN) { E(acc, cur, wr, wc, fr, fq); S.done(cur); }
        if (!has_next) break;
#pragma unroll
        for (int a = 0; a < 2; ++a)
#pragma unroll
            for (int b = 0; b < 2; ++b)
#pragma unroll
                for (int m = 0; m < 4; ++m)
#pragma unroll
                    for (int n = 0; n < 2; ++n) acc[a][b][m][n] = (f32x4){0.f, 0.f, 0.f, 0.f};
        cur = nxt; cA = nA; cB = nB; ++ui;
        if constexpr (GATHER) { gc0[0] = gn0[0]; gc0[1] = gn0[1]; gc1[0] = gn1[0]; gc1[1] = gn1[1]; }
        if constexpr (ALIGN_EPI) { if (wr == 1) PG8_BAR; }
    }
    PG8_WAIT_V(0);
    if constexpr (!ALIGN_EPI) { if (wr == 0) PG8_BAR; }
    PG8_BAR;
    if constexpr (Epi::AFTER_DRAIN) { E.fused(acc, cur, wr, wc, fr, fq, lds, wid, lane); S.done(cur); }
#undef PG8_SA
#undef PG8_SB
#undef PG8_STAGE
#undef PG8_STA
#undef PG8_GOFF
#undef PG8_LDA
#undef PG8_LDB
#undef PG8_MMA
#undef PG8_WAIT_V
#undef PG8_WAIT_L
#undef PG8_BAR
#undef PG8_SCHED
}
}

#define XB_TMO      128
#define XB_XCNT(j)  (256  + 64 * (j))
#define XB_XSUB(j)  (1280 + 64 * (j))
#define XB_XGEN(j)  (2304 + 64 * (j))
#define XB_TOP      3328
#define XB_TOPGEN   3392
#define XCD_BAR_WORDS 3456
#define XB_SPIN_CAP (1u << 24)

__device__ __forceinline__ unsigned xb_ld(unsigned* p)              { return __hip_atomic_load(p, __ATOMIC_RELAXED, __HIP_MEMORY_SCOPE_AGENT); }
__device__ __forceinline__ unsigned xb_add(unsigned* p, unsigned v) { return __hip_atomic_fetch_add(p, v, __ATOMIC_RELAXED, __HIP_MEMORY_SCOPE_AGENT); }
__device__ __forceinline__ unsigned xb_xcc_id() { return (unsigned)__builtin_amdgcn_s_getreg((3 << 11) | 20) & 0xFu; }
#define XB_SPIN(cond, bar) do { unsigned _sp = 0; while (cond) { __builtin_amdgcn_s_sleep(1); \
    if ((++_sp & 255u) == 0u) { if (xb_ld(&(bar)[XB_TMO])) break; if (_sp > XB_SPIN_CAP) { atomicAdd(&(bar)[XB_TMO], 1u); break; } } } } while (0)

struct XcdBarrier {
    unsigned* bar; unsigned x;
    volatile LAS unsigned* st;
};

__device__ __forceinline__ XcdBarrier xcd_barrier_post(unsigned* bar, volatile LAS unsigned* st) {
    XcdBarrier b; b.bar = bar; b.x = xb_xcc_id(); b.st = st;
    if (threadIdx.x == 0) (void)xb_add(&bar[XB_XCNT(b.x)], 1u);
    return b;
}
__device__ __forceinline__ void xcd_barrier_complete(unsigned* bar, unsigned x, unsigned& nloc, unsigned& nx) {
    const unsigned G = gridDim.x * gridDim.y * gridDim.z;
    unsigned sum, cnt, mine, sp = 0u;
    for (;;) {
        sum = 0u; cnt = 0u; mine = 0u;
#pragma unroll
        for (unsigned j = 0; j < 16; ++j) { const unsigned c = xb_ld(&bar[XB_XCNT(j)]); sum += c; cnt += (c > 0u) ? 1u : 0u; mine = (j == x) ? c : mine; }
        if (sum == G) break;
        __builtin_amdgcn_s_sleep(1);
        if ((++sp & 255u) == 0u) { if (xb_ld(&bar[XB_TMO])) break; if (sp > XB_SPIN_CAP) { atomicAdd(&bar[XB_TMO], 1u); break; } }
    }
    nloc = mine > 0u ? mine : 1u; nx = cnt > 0u ? cnt : 1u;
}

__device__ __forceinline__ void xcd_barrier(const XcdBarrier& b) {
    asm volatile("s_waitcnt vmcnt(0)" ::: "memory");
    __syncthreads();
    if (threadIdx.x == 0) {
        unsigned* bar = b.bar;
        __builtin_amdgcn_s_waitcnt(0);
        unsigned nloc = b.st[0], nx = b.st[1];
        if (nloc == 0u) { xcd_barrier_complete(bar, b.x, nloc, nx); b.st[0] = nloc; b.st[1] = nx; }
        const unsigned old = xb_add(&bar[XB_XSUB(b.x)], 1u);
        const unsigned gen = old / nloc;
        if (old + 1u == (gen + 1u) * nloc) {
            __builtin_amdgcn_fence(__ATOMIC_RELEASE, "agent");
            asm volatile("s_waitcnt vmcnt(0)" ::: "memory");
            const unsigned og = xb_add(&bar[XB_TOP], 1u);
            const unsigned tg = og / nx;
            if (og + 1u == (tg + 1u) * nx) xb_add(&bar[XB_TOPGEN], 1u);
            else XB_SPIN(xb_ld(&bar[XB_TOPGEN]) == tg, bar);
            __builtin_amdgcn_fence(__ATOMIC_ACQUIRE, "agent");
            xb_add(&bar[XB_XGEN(b.x)], 1u);
            asm volatile("s_waitcnt vmcnt(0)" ::: "memory");
        } else {
            XB_SPIN(xb_ld(&bar[XB_XGEN(b.x)]) == gen, bar);
            __builtin_amdgcn_fence(__ATOMIC_ACQUIRE, "agent");
            asm volatile("s_waitcnt vmcnt(0)" ::: "memory");
        }
    }
    __syncthreads();
}
struct Args { const float* in[33]; float* out; unsigned char* ws; int ph_lo, ph_hi; };
enum { I_X = 0, I_C, I_CTX, I_CCTX, I_ADAW, I_ADAB, I_NMIXG, I_NFFNG, I_EVWIN, I_EVWOUT, I_LAMRE, I_LAMIM, I_LOGSTEP, I_BRE, I_BIM, I_CRE, I_CIM, I_S5D, I_GLUW, I_GLUB,
       I_SINK, I_ODWIN, I_ODWOUT, I_LQ1, I_LK1, I_LQ2, I_LK2, I_SUBLN, I_ROUTER, I_WGATE, I_WUP, I_WDOWN, I_FINALG };

DI void p0_ada_item(const Args& a, LAS unsigned char* lds, int item) {
    const int tid = threadIdx.x, lane = tid & 63, wave = tid >> 6;
    const int l = item / 96, j0 = (item % 96) * 64;
    LAS float* sc = (LAS float*)lds;
    LAS float* red = (LAS float*)(lds + 9 * 1024 * 4);
    for (int i = tid; i < 9 * 1024; i += NTHREADS) {
        const int r = i >> 10, k = i & 1023;
        const float v = (r < 8) ? a.in[I_C][r * 1024 + k] : a.in[I_CCTX][k];
        sc[i] = v / (1.0f + __expf(-v));
    }
    __syncthreads();
    float acc[9];
#pragma unroll
    for (int r = 0; r < 9; ++r) acc[r] = 0.f;
    const float* W = a.in[I_ADAW] + (size_t)l * 1024 * 6144 + j0 + lane;
    const int k0 = wave * 128;
#pragma unroll 1
    for (int kb = 0; kb < 128; kb += 32) {
        float w[32];
#pragma unroll
        for (int i = 0; i < 32; ++i) w[i] = __builtin_nontemporal_load(W + (size_t)(k0 + kb + i) * 6144);
#pragma unroll
        for (int i = 0; i < 32; ++i)
#pragma unroll
            for (int r = 0; r < 9; ++r) acc[r] += sc[r * 1024 + k0 + kb + i] * w[i];
    }
#pragma unroll
    for (int r = 0; r < 9; ++r) red[(wave * 9 + r) * 64 + lane] = acc[r];
    __syncthreads();
    for (int i = tid; i < 9 * 64; i += NTHREADS) {
        const int r = i >> 6, jj = i & 63; float s = 0.f;
#pragma unroll
        for (int w = 0; w < 8; ++w) s += red[(w * 9 + r) * 64 + jj];
        ((float*)(a.ws + WS_MOD))[(size_t)(l * 9 + r) * 6144 + j0 + jj] = s + a.in[I_ADAB][l * 6144 + j0 + jj];
    }
    __syncthreads();
}
DI void p0_rope(const Args& a) {
    for (int i = threadIdx.x; i < 1024; i += NTHREADS) {
        const int pos = i >> 4, fi = i & 15;
        const float inv = powf(10000.0f, -(float)fi / 16.0f);
        const float ang = (float)pos * inv;
        ((float*)(a.ws + WS_ROPE))[2 * i] = cosf(ang); ((float*)(a.ws + WS_ROPE))[2 * i + 1] = sinf(ang);
    }
}
DI void p0_s5_item(const Args& a, LAS unsigned char* lds, int item) {
    const int tid = threadIdx.x, g = item >> 1, dir = item & 1;
    LAS float* apr = (LAS float*)lds;
    LAS float* api = apr + 33 * 64;
    LAS float* bbr = api + 33 * 64;
    LAS float* bbi = bbr + 1024;
    LAS float* ccr = bbi + 1024;
    LAS float* cci = ccr + 1024;
    const int gp = (dir * S5G + g) * S5P;
    const float dt = __expf(a.in[I_LOGSTEP][dir * S5G + g]);
    for (int i = tid; i < 33 * 64; i += NTHREADS) {
        const int j = i >> 6, p = i & 63;
        const float lr = a.in[I_LAMRE][gp + p], li = a.in[I_LAMIM][gp + p];
        const float mag = expf((float)j * lr * dt), ang = (float)j * li * dt;
        apr[i] = mag * cosf(ang); api[i] = mag * sinf(ang);
    }
    for (int i = tid; i < 1024; i += NTHREADS) {
        const int p = i >> 4;
        const float lr = a.in[I_LAMRE][gp + p], li = a.in[I_LAMIM][gp + p];
        const float mag = expf(lr * dt), are = mag * cosf(li * dt), aim = mag * sinf(li * dt);
        const float den = lr * lr + li * li;
        const float fre = ((are - 1.0f) * lr + aim * li) / den, fim = (aim * lr - (are - 1.0f) * li) / den;
        const float br = a.in[I_BRE][(size_t)gp * 16 + i], bi = a.in[I_BIM][(size_t)gp * 16 + i];
        bbr[i] = fre * br - fim * bi; bbi[i] = fre * bi + fim * br;
        ccr[i] = a.in[I_CRE][(size_t)(dir * S5G + g) * 1024 + i]; cci[i] = a.in[I_CIM][(size_t)(dir * S5G + g) * 1024 + i];
    }
    __syncthreads();
    if (tid < 64) { float* ap = (float*)(a.ws + WS_APOW) + ((g * 2 + dir) * 64 + tid) * 2; ap[0] = apr[32 * 64 + tid]; ap[1] = api[32 * 64 + tid]; }
    {
        const int c = (tid >> 4) & 15, h = tid & 15, jh = tid >> 8;
        float cbr[64], cbi[64];
#pragma unroll
        for (int p = 0; p < 64; ++p) { const float cr = ccr[c * 64 + p], ci = cci[c * 64 + p], br = bbr[p * 16 + h], bi = bbi[p * 16 + h]; cbr[p] = cr * br - ci * bi; cbi[p] = cr * bi + ci * br; }
        float* kt = (float*)(a.ws + WS_KTAB) + (size_t)(g * 2 + dir) * 32 * 256;
        for (int j = jh * 16; j < jh * 16 + 16; ++j) {
            float s = 0.f;
#pragma unroll
            for (int p = 0; p < 64; p += 4) {
                const f32x4 ar = *(const LAS f32x4*)(apr + j * 64 + p), ai = *(const LAS f32x4*)(api + j * 64 + p);
#pragma unroll
                for (int q = 0; q < 4; ++q) s += cbr[p + q] * ar[q] - cbi[p + q] * ai[q];
            }
            kt[j * 256 + c * 16 + h] = s;
        }
    }
    bf16_t* bta = (bf16_t*)(a.ws + OV_BTA) + (size_t)g * 256 * 512;
    for (int i = tid; i < 128 * 256; i += NTHREADS) {
        const int row = i >> 8, cp = i & 255, ri = row >> 6, p = row & 63, s = cp >> 3, h = (cp & 7) * 2;
        const int e = dir ? s : 31 - s;
        const float pr = apr[e * 64 + p], pi = api[e * 64 + p];
        float v0, v1;
        if (ri == 0) { v0 = pr * bbr[p * 16 + h] - pi * bbi[p * 16 + h]; v1 = pr * bbr[p * 16 + h + 1] - pi * bbi[p * 16 + h + 1]; }
        else         { v0 = pr * bbi[p * 16 + h] + pi * bbr[p * 16 + h]; v1 = pr * bbi[p * 16 + h + 1] + pi * bbr[p * 16 + h + 1]; }
        *(unsigned*)(bta + (size_t)(dir * 128 + row) * 512 + s * 16 + h) = pk2(v0, v1);
    }
    bf16_t* btc = (bf16_t*)(a.ws + OV_BTC) + (size_t)g * 512 * S5_KC;
    for (int i = tid; i < 512 * 64; i += NTHREADS) {
        const int row = i >> 6, cp = i & 63, ri = cp >> 5, p = (cp & 31) * 2, t = row >> 4, c = row & 15;
        const int f = dir ? 32 - t : t + 1;
        float v[2];
#pragma unroll
        for (int q = 0; q < 2; ++q) {
            const float cr = ccr[c * 64 + p + q], ci = cci[c * 64 + p + q], pr = apr[f * 64 + p + q], pi = api[f * 64 + p + q];
            v[q] = ri == 0 ? (cr * pr - ci * pi) : -(cr * pi + ci * pr);
        }
        *(unsigned*)(btc + (size_t)row * S5_KC + 512 + dir * 128 + ri * 64 + p) = pk2(v[0], v[1]);
    }
    __syncthreads();
}
DI void p0_conv_item(const float* W, int K, int N, bf16_t* WT, int mode, int sel, int kb, int nb, int lane, LAS unsigned* scr) {
    const int nq = lane & 15, kq = lane >> 4;
    const float* src = W + (size_t)(kb * 64 + kq * 2) * N + nb * 64 + nq * 4;
    f32x4 v[16];
#pragma unroll
    for (int i = 0; i < 8; ++i) { v[2 * i] = *(const f32x4*)(src + (size_t)(i * 8) * N); v[2 * i + 1] = *(const f32x4*)(src + (size_t)(i * 8 + 1) * N); }
#pragma unroll
    for (int i = 0; i < 8; ++i)
#pragma unroll
        for (int j = 0; j < 4; ++j) scr[(nq * 4 + j) * 32 + ((i ^ (nq & 7)) << 2) + kq] = pk2(v[2 * i][j], v[2 * i + 1][j]);
#pragma unroll
    for (int r = 0; r < 8; ++r) {
        const int n = (lane >> 3) + 8 * r, c = lane & 7;
        const u32x4 d = *(const LAS u32x4*)(scr + n * 32 + ((c ^ ((n >> 2) & 7)) << 2));
        const int ng = nb * 64 + n;
        const int row = mode == 1 ? ((ng >> 7) * 256 + sel * 128 + (ng & 127)) : ng;
        *(u32x4*)(WT + (size_t)row * K + kb * 64 + c * 8) = d;
    }
}
constexpr int POOL_ITEMS = 16 * 1536;
constexpr int CW_PHDONE = 8704;
struct ConvItem { const float* W; bf16_t* WT; int K, N, mode, sel, kb, nb; };
DI ConvItem conv_decode(const Args& a, int pool, int item) {
    ConvItem c; const int le = pool * 16 + item / 1536; int r = item % 1536;
    if (r < 512) { c.W = a.in[I_WGATE] + (size_t)le * 1024 * 2048; c.WT = (bf16_t*)(a.ws + WS_W1T) + (size_t)le * 4096 * 1024; c.K = 1024; c.N = 2048; c.mode = 1; c.sel = 0; c.kb = r / 32; c.nb = r % 32; }
    else if (r < 1024) { r -= 512; c.W = a.in[I_WUP] + (size_t)le * 1024 * 2048; c.WT = (bf16_t*)(a.ws + WS_W1T) + (size_t)le * 4096 * 1024; c.K = 1024; c.N = 2048; c.mode = 1; c.sel = 1; c.kb = r / 32; c.nb = r % 32; }
    else { r -= 1024; c.W = a.in[I_WDOWN] + (size_t)le * 2048 * 1024; c.WT = (bf16_t*)(a.ws + WS_W2T) + (size_t)le * 1024 * 2048; c.K = 2048; c.N = 1024; c.mode = 0; c.sel = 0; c.kb = r / 16; c.nb = r % 16; }
    return c;
}
DI void conv_load(const ConvItem& c, int lane, f32x4 (&v)[16]) {
    const int nq = lane & 15, kq = lane >> 4;
    const float* src = c.W + (size_t)(c.kb * 64 + kq * 2) * c.N + c.nb * 64 + nq * 4;
#pragma unroll
    for (int i = 0; i < 8; ++i) { v[2 * i] = __builtin_nontemporal_load((const f32x4*)(src + (size_t)(i * 8) * c.N)); v[2 * i + 1] = __builtin_nontemporal_load((const f32x4*)(src + (size_t)(i * 8 + 1) * c.N)); }
}
DI void conv_store(const ConvItem& c, int lane, const f32x4 (&v)[16], LAS unsigned* scr) {
    const int nq = lane & 15, kq = lane >> 4;
#pragma unroll
    for (int i = 0; i < 8; ++i)
#pragma unroll
        for (int j = 0; j < 4; ++j) scr[(nq * 4 + j) * 32 + ((i ^ (nq & 7)) << 2) + kq] = pk2(v[2 * i][j], v[2 * i + 1][j]);
#pragma unroll
    for (int r = 0; r < 8; ++r) {
        const int n = (lane >> 3) + 8 * r, cc = lane & 7;
        const u32x4 d = *(const LAS u32x4*)(scr + n * 32 + ((cc ^ ((n >> 2) & 7)) << 2));
        const int ng = c.nb * 64 + n;
        const int row = c.mode == 1 ? ((ng >> 7) * 256 + c.sel * 128 + (ng & 127)) : ng;
        __builtin_nontemporal_store(d, (u32x4*)(c.WT + (size_t)row * c.K + c.kb * 64 + cc * 8));
    }
}
DI void steal_conv(const Args& a, LAS unsigned char* lds, int G, int phase, int last_pool, bool opportunistic, int& pos) {
    const int tid = threadIdx.x, lane = tid & 63, wave = __builtin_amdgcn_readfirstlane(tid >> 6);
    unsigned* ctl = (unsigned*)(a.ws + WS_CTL);
    LAS unsigned* scr = (LAS unsigned*)(lds + wave * 8192);
    const int NGW = G * NWAVES, ppw = (POOL_ITEMS + NGW - 1) / NGW;
    const int gw = blockIdx.x * NWAVES + wave, end = (last_pool + 1) * ppw;
    __syncthreads();
    if (tid == 0 && opportunistic) __hip_atomic_fetch_add(ctl + CW_PHDONE + 64 * phase, 1u, __ATOMIC_RELAXED, __HIP_MEMORY_SCOPE_AGENT);
#define CONV_MORE() (pos < end && (!opportunistic || (unsigned)__builtin_amdgcn_readfirstlane((int)__hip_atomic_load(ctl + CW_PHDONE + 64 * phase, __ATOMIC_RELAXED, __HIP_MEMORY_SCOPE_AGENT)) < (unsigned)G))
#define CONV_NEXT(c, ok) do { const int it_ = ((int)blockIdx.x * ppw + (pos % ppw)) * NWAVES + wave; ok = it_ < POOL_ITEMS; c = conv_decode(a, pos / ppw, ok ? it_ : 0); ++pos; } while (0)
    if (CONV_MORE()) {
        ConvItem ca, cb; f32x4 va[16], vb[16]; bool oka, okb;
        CONV_NEXT(ca, oka); if (oka) conv_load(ca, lane, va);
        for (;;) {
            okb = false; const bool moreb = CONV_MORE();
            if (moreb) { CONV_NEXT(cb, okb); if (okb) conv_load(cb, lane, vb); }
            if (oka) conv_store(ca, lane, va, scr);
            if (!moreb) break;
            oka = false; const bool morea = CONV_MORE();
            if (morea) { CONV_NEXT(ca, oka); if (oka) conv_load(ca, lane, va); }
            if (okb) conv_store(cb, lane, vb, scr);
            if (!morea) break;
        }
    }
#undef CONV_MORE
#undef CONV_NEXT
    __syncthreads();
}
DI void p0_phase(const Args& a, LAS unsigned char* lds, int G) {
    const int tid = threadIdx.x, lane = tid & 63, wave = __builtin_amdgcn_readfirstlane(tid >> 6);
    for (int it = blockIdx.x; it < 193; it += G) {
        if (it < 192) p0_ada_item(a, lds, it);
        else p0_rope(a);
    }
    __syncthreads();
    const int gw = blockIdx.x * NWAVES + wave, NGW = G * NWAVES;
    LAS unsigned* scr = (LAS unsigned*)(lds + wave * 8192);
    constexpr int I_IN0 = 16 * 20, I_GLU = 8 * 8, I_OUT0 = 16 * 16, I_IN1 = 16 * 48, I_OUT1 = 16 * 16, NITEMS = I_IN0 + I_GLU + I_OUT0 + I_IN1 + I_OUT1;
    for (int it = gw; it < NITEMS; it += NGW) {
        int r = it;
        if (r < I_IN0) { p0_conv_item(a.in[I_EVWIN], 1024, 1280, (bf16_t*)(a.ws + WS_WIN0T), 0, 0, r / 20, r % 20, lane, scr); continue; } r -= I_IN0;
        if (r < I_GLU) { p0_conv_item(a.in[I_GLUW], 512, 512, (bf16_t*)(a.ws + WS_WGLUT), 0, 0, r / 8, r % 8, lane, scr); continue; } r -= I_GLU;
        if (r < I_OUT0) { p0_conv_item(a.in[I_EVWOUT], 1024, 1024, (bf16_t*)(a.ws + WS_WOUT0T), 0, 0, r / 16, r % 16, lane, scr); continue; } r -= I_OUT0;
        if (r < I_IN1) { p0_conv_item(a.in[I_ODWIN], 1024, 3072, (bf16_t*)(a.ws + WS_WIN1T), 0, 0, r / 48, r % 48, lane, scr); continue; } r -= I_IN1;
        p0_conv_item(a.in[I_ODWOUT], 1024, 1024, (bf16_t*)(a.ws + WS_WOUT1T), 0, 0, r / 16, r % 16, lane, scr);
    }
}
DI const float* mod_ptr(const Args& a, int layer, int row) {
    const int r = row < ROWS_L ? (row >> 11) : 8;
    return (const float*)(a.ws + WS_MOD) + (size_t)(layer * 9 + r) * 6144;
}
DI f32x4 ld_bf16x4(const bf16_t* p);
DI void load_row_bf16(const bf16_t* p, int lane, f32x4 (&v)[4]) {
#pragma unroll
    for (int j = 0; j < 4; ++j) v[j] = ld_bf16x4(p + lane * 4 + 256 * j);
}
DI void load_row(const float* p, int lane, f32x4 (&v)[4]) {
#pragma unroll
    for (int j = 0; j < 4; ++j) v[j] = *(const f32x4*)(p + lane * 4 + 256 * j);
}
DI float row_rstd(const f32x4 (&v)[4]) {
    float s = 0.f;
#pragma unroll
    for (int j = 0; j < 4; ++j) s += (v[j].x * v[j].x + v[j].y * v[j].y) + (v[j].z * v[j].z + v[j].w * v[j].w);
    return 1.0f / sqrtf(wave_sum(s) * (1.0f / 1024.0f) + NORM_EPS);
}
DI void norm_mod(f32x4 (&v)[4], const float* g, const float* shift, const float* scale, int lane) {
    const float rs = row_rstd(v);
#pragma unroll
    for (int j = 0; j < 4; ++j) {
        const f32x4 gg = *(const f32x4*)(g + lane * 4 + 256 * j), sh = *(const f32x4*)(shift + lane * 4 + 256 * j), sc = *(const f32x4*)(scale + lane * 4 + 256 * j);
        v[j] = (v[j] * rs) * gg * (sc + 1.0f) + sh;
    }
}
DI void store_row_bf16(bf16_t* p, int lane, const f32x4 (&v)[4]) {
#pragma unroll
    for (int j = 0; j < 4; ++j) { u32x2 w; w.x = pk2(v[j].x, v[j].y); w.y = pk2(v[j].z, v[j].w); *(u32x2*)(p + lane * 4 + 256 * j) = w; }
}
DI float rt_xhalf(float v) {
    const unsigned u = __builtin_bit_cast(unsigned, v);
    auto r = __builtin_amdgcn_permlane32_swap(u, u, false, false);
    return __builtin_bit_cast(float, (threadIdx.x & 32) ? r[0] : r[1]);
}
template <int X> DI float rt_xswz(float v) {
    return __builtin_bit_cast(float, __builtin_amdgcn_ds_swizzle(__builtin_bit_cast(int, v), (X << 10) | 0x1f));
}
DI void router_fill(const Args& a, LAS float* ldsw, int layer) {
    const float* wr = a.in[I_ROUTER] + (size_t)layer * 1024 * 16;
    for (int i = threadIdx.x; i < 16384; i += NTHREADS) ldsw[(i & 15) * 1024 + (i >> 4)] = wr[i];
    __syncthreads();
}
DI void router_row(const Args& a, const LAS float* ldsw, int row, const f32x4 (&v)[4], int lane) {
    float lg[16];
    {
        f32x2 acc2[16];
#pragma unroll
        for (int e = 0; e < 16; ++e) acc2[e] = (f32x2){0.f, 0.f};
#pragma unroll
        for (int j = 0; j < 4; ++j) {
            const f32x2 vlo = {v[j].x, v[j].y}, vhi = {v[j].z, v[j].w};
            f32x4 w[16];
#pragma unroll
            for (int e = 0; e < 16; ++e) w[e] = *(const LAS f32x4*)(ldsw + e * 1024 + lane * 4 + 256 * j);
#pragma unroll
            for (int e = 0; e < 16; ++e) { acc2[e] += vlo * (f32x2){w[e].x, w[e].y}; acc2[e] += vhi * (f32x2){w[e].z, w[e].w}; }
            __builtin_amdgcn_sched_barrier(0);
        }
#pragma unroll
        for (int e = 0; e < 16; ++e) lg[e] = acc2[e].x + acc2[e].y;
    }
    const bool b5 = lane & 32, b4 = lane & 16, b3 = lane & 8, b2 = lane & 4;
    float k8[8], k4[4], k2[2];
#pragma unroll
    for (int i = 0; i < 8; ++i) { const float snd = b5 ? lg[i] : lg[i + 8]; k8[i] = (b5 ? lg[i + 8] : lg[i]) + rt_xhalf(snd); }
#pragma unroll
    for (int i = 0; i < 4; ++i) { const float snd = b4 ? k8[i] : k8[i + 4]; k4[i] = (b4 ? k8[i + 4] : k8[i]) + rt_xswz<16>(snd); }
#pragma unroll
    for (int i = 0; i < 2; ++i) { const float snd = b3 ? k4[i] : k4[i + 2]; k2[i] = (b3 ? k4[i + 2] : k4[i]) + rt_xswz<8>(snd); }
    float tot = (b2 ? k2[1] : k2[0]) + rt_xswz<4>(b2 ? k2[0] : k2[1]);
    tot += rt_xswz<1>(tot); tot += rt_xswz<2>(tot);
    float mx = fmaxf(tot, rt_xswz<4>(tot)); mx = fmaxf(mx, rt_xswz<8>(mx)); mx = fmaxf(mx, rt_xswz<16>(mx)); mx = fmaxf(mx, rt_xhalf(mx));
    const float ex = expf(tot - mx);
    float den = ex + rt_xswz<4>(ex); den += rt_xswz<8>(den); den += rt_xswz<16>(den); den += rt_xhalf(den);
    const float mine = ex / den;
    const int e = (lane >> 2) & 15;
    if ((lane & 3) == 0) {
        if (row < ROWS_L) ((float*)(a.ws + WS_AFFL))[((size_t)(row >> 11) * 16 + e) * NL + (row & 2047)] = mine;
        else { const int rc = row - ROWS_L; ((float*)(a.ws + WS_AFFC))[((size_t)(rc >> 8) * 16 + e) * NC + (rc & 255)] = mine; }
    }
}
DI void toeplitz_fill(const Args& a, int wv, int nwv, int lane) {
    for (int it = wv; it < S5G * 32; it += nwv) {
        const int g = it >> 5, t = it & 31;
        const float* kf = (const float*)(a.ws + WS_KTAB) + (size_t)(g * 2 + 0) * 32 * 256;
        const float* kr = kf + 32 * 256;
        bf16_t* base = (bf16_t*)(a.ws + OV_BTC) + ((size_t)g * 512 + t * 16) * S5_KC;
#pragma unroll
        for (int q = 0; q < 2; ++q) {
            const int col = q * 256 + lane * 4, s = col >> 4, h0 = col & 15;
            const float mf = s <= t ? 1.f : 0.f, mr = s >= t ? 1.f : 0.f;
            const float* pf = kf + (s <= t ? t - s : 0) * 256 + h0; const float* pr = kr + (s >= t ? s - t : 0) * 256 + h0;
#pragma unroll 8
            for (int c = 0; c < 16; ++c) {
                const f32x4 v = *(const f32x4*)(pf + c * 16) * mf + *(const f32x4*)(pr + c * 16) * mr;
                u32x2 w; w.x = pk2(v.x, v.y); w.y = pk2(v.z, v.w);
                *(u32x2*)(base + (size_t)c * S5_KC + col) = w;
            }
        }
    }
}
DI void p1_phase(const Args& a, LAS unsigned char* lds, int G) {
    const int tid = threadIdx.x, lane = tid & 63, wave = __builtin_amdgcn_readfirstlane(tid >> 6);
    const int ntab = G > 128 ? 64 : 0;
    for (int it = blockIdx.x; it < 64; it += (ntab ? 64 : G)) { if (ntab && (int)blockIdx.x >= ntab) break; p0_s5_item(a, lds, it); }
    if ((int)blockIdx.x < ntab) return;
    const int gw = ((int)blockIdx.x - ntab) * NWAVES + wave, NGW = (G - ntab) * NWAVES;
    f32x4 vn[4];
    if (gw < ROWS) load_row(gw < ROWS_L ? a.in[I_X] + (size_t)gw * DM : a.in[I_CTX] + (size_t)(gw - ROWS_L) * DM, lane, vn);
    for (int row = gw; row < ROWS; row += NGW) {
        f32x4 v[4];
#pragma unroll
        for (int j = 0; j < 4; ++j) v[j] = vn[j];
        const int nr = row + NGW;
        if (nr < ROWS) load_row(nr < ROWS_L ? a.in[I_X] + (size_t)nr * DM : a.in[I_CTX] + (size_t)(nr - ROWS_L) * DM, lane, vn);
        const float* md = mod_ptr(a, 0, row);
        norm_mod(v, a.in[I_NMIXG], md, md + 1024, lane);
        store_row_bf16((bf16_t*)(a.ws + WS_HX) + (size_t)row * DM, lane, v);
    }
}
DI void pnorm_router_phase(const Args& a, LAS unsigned char* lds, int G, int layer, int nrows) {
    const int tid = threadIdx.x, lane = tid & 63, wave = __builtin_amdgcn_readfirstlane(tid >> 6);
    const int gw = blockIdx.x * NWAVES + wave, NGW = G * NWAVES;
    LAS float* ldsw = (LAS float*)lds; router_fill(a, ldsw, layer);
    for (int row = gw; row < nrows; row += NGW) {
        f32x4 v[4]; load_row_bf16((const bf16_t*)(a.ws + WS_XS) + (size_t)row * DM, lane, v);
        const float* md = mod_ptr(a, layer, row);
        norm_mod(v, a.in[I_NFFNG] + layer * 1024, md + 3 * 1024, md + 4 * 1024, lane);
        store_row_bf16((bf16_t*)(a.ws + WS_HX) + (size_t)row * DM, lane, v);
        router_row(a, ldsw, row, v, lane);
    }
}
DI f32x4 ld_bf16x4(const bf16_t* p);
DI void pcombine_phase(const Args& a, int G, int layer, int nrows, int mrows) {
    const bool tails = false;
    const int tid = threadIdx.x, lane = tid & 63, wave = __builtin_amdgcn_readfirstlane(tid >> 6);
    const int gw = blockIdx.x * NWAVES + wave, NGW = G * NWAVES;
    const bf16_t* yb = (const bf16_t*)(a.ws + OV_YB);
    for (int row = gw; row < nrows; row += NGW) {
        bf16_t* xr = (bf16_t*)(a.ws + WS_XS) + (size_t)row * DM;
        f32x4 v[4]; load_row_bf16(xr, lane, v);
        f32x4 acc[4];
#pragma unroll
        for (int j = 0; j < 4; ++j) acc[j] = (f32x4){0.f, 0.f, 0.f, 0.f};
        const int* ts = (const int*)(a.ws + WS_TOKSLOT) + (size_t)row * 16;
        const int myslot = lane < 16 ? ts[lane] : -1;
        unsigned msk = (unsigned)__ballot(myslot >= 0);
        while (msk) {
            const int e0 = __builtin_ctz(msk); msk &= msk - 1;
            const int e1 = msk ? __builtin_ctz(msk) : e0; const bool two = msk != 0; msk &= msk - 1;
            const int s0 = __builtin_amdgcn_readlane(myslot, e0), s1 = __builtin_amdgcn_readlane(myslot, e1);
            const bf16_t* y0 = yb + ((size_t)e0 * mrows + s0) * DM; const bf16_t* y1 = yb + ((size_t)e1 * mrows + s1) * DM;
            u32x2 w0[4], w1[4];
#pragma unroll
            for (int j = 0; j < 3; ++j) { w0[j] = *(const u32x2*)(y0 + lane * 4 + 256 * j); w1[j] = *(const u32x2*)(y1 + lane * 4 + 256 * j); }
            const bool t0 = tails && (e0 & 1) && s0 >= 256, t1 = tails && (e1 & 1) && s1 >= 256;
            const float f1 = two ? 1.f : 0.f;
            if (!t0) w0[3] = *(const u32x2*)(y0 + lane * 4 + 768);
            if (!t1) w1[3] = *(const u32x2*)(y1 + lane * 4 + 768);
            if (t0 || t1) {
                const bf16_t* ybs = (const bf16_t*)(a.ws + OV_YBS);
                f32x4 ex = {0.f, 0.f, 0.f, 0.f};
                if (t0) { const int ss = (e0 >> 1) * 8 + (s0 >> 8) - 1;
#pragma unroll
                    for (int q = 0; q < 4; ++q) ex += ld_bf16x4(ybs + ((size_t)(q * 64 + ss) * 256 + (s0 & 255)) * 256 + lane * 4); w0[3] = (u32x2){0u, 0u}; }
                if (t1) { const int ss = (e1 >> 1) * 8 + (s1 >> 8) - 1;
#pragma unroll
                    for (int q = 0; q < 4; ++q) ex += ld_bf16x4(ybs + ((size_t)(q * 64 + ss) * 256 + (s1 & 255)) * 256 + lane * 4) * f1; w1[3] = (u32x2){0u, 0u}; }
                acc[3] += ex;
            }
#pragma unroll
            for (int j = 0; j < 4; ++j) {
                acc[j].x += bflo(w0[j].x) + f1 * bflo(w1[j].x); acc[j].y += bfhi(w0[j].x) + f1 * bfhi(w1[j].x);
                acc[j].z += bflo(w0[j].y) + f1 * bflo(w1[j].y); acc[j].w += bfhi(w0[j].y) + f1 * bfhi(w1[j].y);
            }
        }
        const float* md = mod_ptr(a, layer, row);
#pragma unroll
        for (int j = 0; j < 4; ++j) v[j] += *(const f32x4*)(md + 5 * 1024 + lane * 4 + 256 * j) * acc[j];
        if (layer == 0) {
            store_row_bf16(xr, lane, v);
            const float* m1 = mod_ptr(a, 1, row);
            norm_mod(v, a.in[I_NMIXG] + 1024, m1, m1 + 1024, lane);
            store_row_bf16((bf16_t*)(a.ws + WS_HX) + (size_t)row * DM, lane, v);
        } else {
            const float rs = row_rstd(v);
#pragma unroll
            for (int j = 0; j < 4; ++j) *(f32x4*)(a.out + (size_t)row * DM + lane * 4 + 256 * j) = (v[j] * rs) * *(const f32x4*)(a.in[I_FINALG] + lane * 4 + 256 * j);
        }
    }
}
DI void ptopk_phase(const Args& a, LAS unsigned char* lds, int G, int with_ctx, int mrows) {
    const int tid = threadIdx.x, lane = tid & 63, wave = __builtin_amdgcn_readfirstlane(tid >> 6);
    LAS int* hist = (LAS int*)lds;
    LAS int* st = (LAS int*)(lds + 1024);
    LAS int* wsum = (LAS int*)(lds + 1024 + 32);
    LAS unsigned* wtot = (LAS unsigned*)(lds + 1024 + 64);
    LAS int* list = (LAS int*)(lds + 2048);
    const int nitems = with_ctx ? 256 : 128;
    for (int it = blockIdx.x; it < nitems; it += G) {
        const bool lat = it < 128;
        const int r = lat ? it : it - 128, b = r >> 4, e = r & 15, n = lat ? NL : NC, cap = lat ? CAP_L : CAP_C;
        const float* src = lat ? (const float*)(a.ws + WS_AFFL) + ((size_t)b * 16 + e) * NL : (const float*)(a.ws + WS_AFFC) + ((size_t)b * 16 + e) * NC;
        const bool valid = tid * 4 < n;
        u32x4 key = {0u, 0u, 0u, 0u};
        if (valid) key = *(const u32x4*)(src + tid * 4);
        unsigned prefix = 0u; int remaining = cap;
#pragma unroll
        for (int pass = 0; pass < 4; ++pass) {
            const int shift = 24 - 8 * pass;
            if (tid < 256) hist[tid] = 0;
            __syncthreads();
            if (valid) {
#pragma unroll
                for (int i = 0; i < 4; ++i)
                    if (pass == 0 || (key[i] >> (shift + 8)) == prefix) __hip_atomic_fetch_add(&hist[(key[i] >> shift) & 255u], 1, __ATOMIC_RELAXED, __HIP_MEMORY_SCOPE_WORKGROUP);
            }
            __syncthreads();
            {
                const int mine = tid < 256 ? hist[tid] : 0;
                int sfx = mine;
#pragma unroll
                for (int o = 1; o < 64; o <<= 1) { const int y = __shfl_down(sfx, o); if (lane + o < 64) sfx += y; }
                if (tid < 256 && lane == 0) wsum[wave] = sfx;
                __syncthreads();
                if (tid < 256) {
                    int above = sfx - mine;
                    for (int w = wave + 1; w < 4; ++w) above += wsum[w];
                    if (above < remaining && remaining <= above + mine) { st[0] = tid; st[1] = remaining - above; }
                }
            }
            __syncthreads();
            prefix = (prefix << 8) | (unsigned)st[0]; remaining = st[1];
        }
        const unsigned T = prefix; const int req = remaining;
        unsigned cnt = 0u;
#pragma unroll
        for (int i = 0; i < 4; ++i) cnt += (valid && key[i] > T ? 1u : 0u) + (valid && key[i] == T ? 0x10000u : 0u);
        unsigned inc = cnt;
#pragma unroll
        for (int o = 1; o < 64; o <<= 1) { const unsigned y = __shfl_up(inc, o); if (lane >= o) inc += y; }
        if (lane == 63) wtot[wave] = inc;
        __syncthreads();
        unsigned off = inc - cnt;
        for (int w = 0; w < wave; ++w) off += wtot[w];
        int gtp = (int)(off & 0xffffu), eqp = (int)(off >> 16);
        if (valid) {
#pragma unroll
            for (int i = 0; i < 4; ++i) {
                const unsigned kv = key[i];
                const bool gt = kv > T, eq = kv == T;
                const bool sel = gt || (eq && eqp < req);
                const int t = tid * 4 + i, trow = lat ? b * NL + t : ROWS_L + b * NC + t;
                int erow = -1;
                if (sel) {
                    const int slot = gtp + (eqp < req ? eqp : req);
                    erow = lat ? b * CAP_L + slot : NB * CAP_L + b * CAP_C + slot;
                    ((float*)(a.ws + WS_GATE))[(size_t)e * mrows + erow] = __uint_as_float(kv);
                    list[slot] = trow;
                }
                ((int*)(a.ws + WS_TOKSLOT))[(size_t)trow * 16 + e] = erow;
                gtp += gt ? 1 : 0; eqp += eq ? 1 : 0;
            }
        }
        __syncthreads();
        const int ebase = lat ? b * CAP_L : NB * CAP_L + b * CAP_C;
        if (tid < cap) ((int*)(a.ws + WS_SELROW))[(size_t)e * mrows + ebase + tid] = list[tid];
        __syncthreads();
    }
}
DI void ps5_rec_phase(const Args& a, int G) {
    if (threadIdx.x >= 128) return;
    for (int it = blockIdx.x; it < 256; it += G) {
        const int gid = it * 128 + threadIdx.x;
        const int p = gid & 63, dir = (gid >> 6) & 1, b = (gid >> 7) & 7, g = gid >> 10;
        const float* ap = (const float*)(a.ws + WS_APOW) + ((g * 2 + dir) * 64 + p) * 2;
        const float ar = ap[0], ai = ap[1];
        const float* S = (const float*)(a.ws + OV_S) + (size_t)g * S5_MROWS * 256 + dir * 128 + p;
        bf16_t* H = (bf16_t*)(a.ws + OV_AS5) + (size_t)g * S5_MROWS * S5_KC + 512 + dir * 128 + p;
        float sr = 0.f, si = 0.f;
#pragma unroll 1
        for (int kh = 0; kh < 72; kh += 24) {
            float cr[24], ci[24];
#pragma unroll
            for (int kk = 0; kk < 24; ++kk) {
                const int k = kh + kk;
                const int row = dir == 0 ? (k < 8 ? 512 + b * 8 + k : b * 64 + (k - 8)) : (k < 8 ? 512 + b * 8 + (7 - k) : b * 64 + (63 - (k - 8)));
                cr[kk] = S[(size_t)row * 256]; ci[kk] = S[(size_t)row * 256 + 64];
            }
#pragma unroll
            for (int kk = 0; kk < 24; ++kk) {
                const int k = kh + kk;
                const int row = dir == 0 ? (k < 8 ? 512 + b * 8 + k : b * 64 + (k - 8)) : (k < 8 ? 512 + b * 8 + (7 - k) : b * 64 + (63 - (k - 8)));
                H[(size_t)row * S5_KC] = (bf16_t)f2bf(sr); H[(size_t)row * S5_KC + 64] = (bf16_t)f2bf(si);
                const float nr = ar * sr - ai * si + cr[kk], ni = ar * si + ai * sr + ci[kk];
                sr = nr; si = ni;
            }
        }
    }
}
struct ListOrder {
    int n, G, c;
    DI int idx(int i) const {
        const long L = (long)i * G + c; if (L >= n) return -1;
        const int w = (int)L, q = n / 8, r = n % 8, x = w % 8, off = w / 8;
        return (x < r ? x * (q + 1) : r * (q + 1) + (x - r) * q) + off;
    }
};
struct GroupOrder {
    ListOrder lo; int MT, NT, max_rounds;
    DI void init(int groups, int MT_, int NT_, int G, int c) { MT = MT_; NT = NT_; lo.n = groups * MT_ * NT_; lo.G = G; lo.c = c; max_rounds = 1 << 30; }
    DI bool next(int i, pg8::Unit& u) const {
        if (i >= max_rounds) return false;
        const int w = lo.idx(i); if (w < 0) return false;
        const int g = w / (MT * NT), rem = w % (MT * NT), j = rem / MT, mi = rem % MT;
        u.pm = g * MT + mi; u.pn = g * NT + j; return true;
    }
    DI void a_ready(const pg8::Unit&) const {}
    DI void done(const pg8::Unit&) const {}
};
struct OneUnit {
    int pm, pn;
    DI bool next(int i, pg8::Unit& u) const { if (i > 0) return false; u.pm = pm; u.pn = pn; return true; }
    DI void a_ready(const pg8::Unit&) const {}
    DI void done(const pg8::Unit&) const {}
};
constexpr int W1_SWAP = (int)((WS_HX - WS_WIN1T) / (512 * 1024));
static_assert((WS_HX - WS_WIN1T) % (512 * 1024) == 0, "tile-aligned operand bases");
struct Win1Order {
    ListOrder lo;
    DI void init(int G, int c) { lo.n = 64 * 12 + 8 * 8; lo.G = G; lo.c = c; }
    DI bool next(int i, pg8::Unit& u) const {
        const int w = lo.idx(i); if (w < 0) return false;
        if (w < 768) { const int mg = w / 96, rem = w % 96; u.pn = rem / 8; u.pm = mg * 8 + rem % 8; }
        else { const int r = w - 768; u.pn = 4 + r / 8; u.pm = 64 + r % 8; }
        if (u.pn >= 8) { const int ht = u.pm; u.pm = u.pn - W1_SWAP; u.pn = ht + W1_SWAP; }
        return true;
    }
    DI void a_ready(const pg8::Unit&) const {}
    DI void done(const pg8::Unit&) const {}
};

typedef pg8::f32x4 (ACC_T)[2][2][4][2];
constexpr float QSCALE = 0.125f * 1.4426950408889634f;
DI void st_bf16x4(bf16_t* p, f32x4 v) { u32x2 w; w.x = pk2(v.x, v.y); w.y = pk2(v.z, v.w); *(u32x2*)p = w; }
DI f32x4 ld_bf16x4(const bf16_t* p) { const u32x2 w = *(const u32x2*)p; return (f32x4){bflo(w.x), bfhi(w.x), bflo(w.y), bfhi(w.y)}; }
DI void st_bf16_pair(bf16_t* p, int fq, f32x4 v0, f32x4 v1) {
    const unsigned a0 = pk2(v0.x, v0.y), a1 = pk2(v0.z, v0.w), b0 = pk2(v1.x, v1.y), b1 = pk2(v1.z, v1.w);
    const auto r0 = __builtin_amdgcn_permlane16_swap(a0, b0, false, false);
    const auto r1 = __builtin_amdgcn_permlane16_swap(a1, b1, false, false);
    const u32x4 w = {r0[0], r1[0], r0[1], r1[1]};
    *(u32x4*)(p + 4 * (fq & 2) + 16 * (fq & 1)) = w;
}
DI void rope_pair(f32x4& x0, f32x4& x1, const float* tab, int pos, int fq) {
    const float* t = tab + (size_t)(pos * 16 + 4 * fq) * 2;
    const f32x4 cs0 = *(const f32x4*)t, cs1 = *(const f32x4*)(t + 4);
    const f32x4 c = {cs0.x, cs0.z, cs1.x, cs1.z}, s = {cs0.y, cs0.w, cs1.y, cs1.w};
    const f32x4 a = x0, b = x1;
    x0 = a * c - b * s; x1 = b * c + a * s;
}
struct EpiWin0 {
    static constexpr bool PERM = false, AFTER_DRAIN = false;
    unsigned char* ws;
    DI void operator()(const ACC_T& acc, const pg8::Unit& u, int wr, int wc, int fr, int fq) const {
        const float* tab = (const float*)(ws + WS_ROPE);
#pragma unroll
        for (int ai = 0; ai < 2; ++ai)
#pragma unroll
            for (int m = 0; m < 4; ++m) {
                const int row = u.pm * 256 + ai * 128 + wr * 64 + m * 16 + fr;
                const bool lat = row < ROWS_L;
                const int b = lat ? row >> 11 : (row - ROWS_L) >> 8, tok = lat ? row & 2047 : (row - ROWS_L) & 255;
                if (u.pn < 2) {
                    const int mrow = lat ? b * 64 + (tok >> 5) : 512 + b * 8 + (tok >> 5), s = tok & 31;
#pragma unroll
                    for (int bj = 0; bj < 2; ++bj) {
                        const unsigned a0 = pk2(acc[ai][bj][m][0].x, acc[ai][bj][m][0].y), a1 = pk2(acc[ai][bj][m][0].z, acc[ai][bj][m][0].w);
                        const unsigned b0 = pk2(acc[ai][bj][m][1].x, acc[ai][bj][m][1].y), b1 = pk2(acc[ai][bj][m][1].z, acc[ai][bj][m][1].w);
                        const auto r0 = __builtin_amdgcn_permlane16_swap(a0, b0, false, false); const auto r1 = __builtin_amdgcn_permlane16_swap(a1, b1, false, false);
                        const int g = (u.pn * 256 + bj * 128 + wc * 32) / 16 + (fq & 1);
                        *(u32x4*)((bf16_t*)(ws + OV_AS5) + ((size_t)g * S5_MROWS + mrow) * S5_KC + s * 16 + 4 * (fq & 2)) = (u32x4){r0[0], r1[0], r0[1], r1[1]};
                    }
                } else if (u.pn < 4) {
                    const int pos = (wc & 1) ? (tok & 63) : (tok >> 6);
#pragma unroll
                    for (int bj = 0; bj < 2; ++bj) {
                        f32x4 x0 = acc[ai][bj][m][0] * QSCALE, x1 = acc[ai][bj][m][1] * QSCALE;
                        if (lat) rope_pair(x0, x1, tab, pos, fq);
                        st_bf16_pair((bf16_t*)(ws + OV_Q0) + (size_t)row * 512 + (u.pn - 2) * 256 + bj * 128 + wc * 32, fq, x0, x1);
                    }
                } else {
                    const int kp = lat ? NC + tok : tok;
                    {
                        const int pos = (wc & 1) ? (tok & 63) : (tok >> 6);
                        f32x4 x0 = acc[ai][0][m][0], x1 = acc[ai][0][m][1];
                        if (lat) rope_pair(x0, x1, tab, pos, fq);
                        st_bf16_pair((bf16_t*)(ws + OV_K0) + ((size_t)b * NPOS + kp) * 128 + wc * 32, fq, x0, x1);
                    }
#pragma unroll
                    for (int n = 0; n < 2; ++n)
#pragma unroll
                        for (int j = 0; j < 4; ++j) {
                            const int cv = wc * 32 + n * 16 + fq * 4 + j;
                            ((bf16_t*)(ws + OV_VT0))[((size_t)b * 128 + cv) * NPOS + kp] = (bf16_t)f2bf(acc[ai][1][m][n][j]);
                        }
                }
            }
    }
};
struct EpiS5a {
    static constexpr bool PERM = false, AFTER_DRAIN = false;
    unsigned char* ws;
    DI void operator()(const ACC_T& acc, const pg8::Unit& u, int wr, int wc, int fr, int fq) const {
        const int g = u.pn, mt = u.pm % 3;
#pragma unroll
        for (int ai = 0; ai < 2; ++ai)
#pragma unroll
            for (int m = 0; m < 4; ++m) {
                const int n = mt * 256 + ai * 128 + wr * 64 + m * 16 + fr;
                if (n < S5_VALID) {
                    float* dst = (float*)(ws + OV_S) + ((size_t)g * S5_MROWS + n) * 256 + wc * 32 + fq * 4;
#pragma unroll
                    for (int bj = 0; bj < 2; ++bj)
#pragma unroll
                        for (int nn = 0; nn < 2; ++nn) *(f32x4*)(dst + bj * 128 + nn * 16) = acc[ai][bj][m][nn];
                }
            }
    }
};
DI float gelu_tanh(float x) {
    const float u = 0.7978845608028654f * (x + 0.044715f * x * x * x);
    const float e = __expf(2.0f * u);
    const float th = 1.0f - 2.0f * __builtin_amdgcn_rcpf(e + 1.0f);
    return 0.5f * x * (1.0f + th);
}
struct EpiS5c {
    static constexpr bool PERM = false, AFTER_DRAIN = false;
    unsigned char* ws; const float* dskip;
    DI void operator()(const ACC_T& acc, const pg8::Unit& u, int wr, int wc, int fr, int fq) const {
        const int g = u.pm / 3, mt = u.pm % 3, nt = u.pn & 1;
#pragma unroll
        for (int ai = 0; ai < 2; ++ai)
#pragma unroll
            for (int m = 0; m < 4; ++m) {
                const int n = mt * 256 + ai * 128 + wr * 64 + m * 16 + fr;
                if (n < S5_VALID) {
                    const int tokrow0 = n < 512 ? (n >> 6) * NL + (n & 63) * 32 : ROWS_L + ((n - 512) >> 3) * NC + ((n - 512) & 7) * 32;
                    const bf16_t* ur = (const bf16_t*)(ws + OV_AS5) + ((size_t)g * S5_MROWS + n) * S5_KC;
#pragma unroll
                    for (int bj = 0; bj < 2; ++bj) {
                        f32x4 y[2];
#pragma unroll
                        for (int nn = 0; nn < 2; ++nn) {
                            const int oc = nt * 256 + bj * 128 + wc * 32 + nn * 16 + fq * 4, c0 = oc & 15;
                            const f32x4 uu = ld_bf16x4(ur + oc), dd = *(const f32x4*)(dskip + g * 16 + c0);
                            y[nn] = acc[ai][bj][m][nn] + dd * uu;
                            y[nn].x = gelu_tanh(y[nn].x); y[nn].y = gelu_tanh(y[nn].y); y[nn].z = gelu_tanh(y[nn].z); y[nn].w = gelu_tanh(y[nn].w);
                        }
                        const unsigned a0 = pk2(y[0].x, y[0].y), a1 = pk2(y[0].z, y[0].w), b0 = pk2(y[1].x, y[1].y), b1 = pk2(y[1].z, y[1].w);
                        const auto r0 = __builtin_amdgcn_permlane16_swap(a0, b0, false, false); const auto r1 = __builtin_amdgcn_permlane16_swap(a1, b1, false, false);
                        const int t = (nt * 256 + bj * 128 + wc * 32) / 16 + (fq & 1);
                        *(u32x4*)((bf16_t*)(ws + OV_Z) + (size_t)(tokrow0 + t) * 512 + g * 16 + 4 * (fq & 2)) = (u32x4){r0[0], r1[0], r0[1], r1[1]};
                    }
                }
            }
    }
};
struct EpiGlu {
    static constexpr bool PERM = false, AFTER_DRAIN = false;
    unsigned char* ws; const float* bias;
    DI void operator()(const ACC_T& acc, const pg8::Unit& u, int wr, int wc, int fr, int fq) const {
#pragma unroll
        for (int ai = 0; ai < 2; ++ai)
#pragma unroll
            for (int m = 0; m < 4; ++m) {
                const int row = u.pm * 256 + ai * 128 + wr * 64 + m * 16 + fr;
#pragma unroll
                for (int bj = 0; bj < 2; ++bj) {
                    f32x4 o[2];
#pragma unroll
                    for (int n = 0; n < 2; ++n) {
                        const int col = u.pn * 256 + bj * 128 + wc * 32 + n * 16 + fq * 4;
                        const f32x4 z = ld_bf16x4((const bf16_t*)(ws + OV_Z) + (size_t)row * 512 + col), t = acc[ai][bj][m][n] + *(const f32x4*)(bias + col);
                        o[n].x = z.x * __builtin_amdgcn_rcpf(1.0f + __expf(-t.x)); o[n].y = z.y * __builtin_amdgcn_rcpf(1.0f + __expf(-t.y)); o[n].z = z.z * __builtin_amdgcn_rcpf(1.0f + __expf(-t.z)); o[n].w = z.w * __builtin_amdgcn_rcpf(1.0f + __expf(-t.w));
                    }
                    st_bf16_pair((bf16_t*)(ws + WS_MIX) + (size_t)row * DM + u.pn * 256 + bj * 128 + wc * 32, fq, o[0], o[1]);
                }
            }
    }
};
struct EpiResid {
    static constexpr bool PERM = false, AFTER_DRAIN = false;
    unsigned char* ws; const float* x; const float* ctx; int layer;
    DI void operator()(const ACC_T& acc, const pg8::Unit& u, int wr, int wc, int fr, int fq) const {
#pragma unroll
        for (int ai = 0; ai < 2; ++ai)
#pragma unroll
            for (int m = 0; m < 4; ++m) {
                const int row = u.pm * 256 + ai * 128 + wr * 64 + m * 16 + fr;
                const int r = row < ROWS_L ? (row >> 11) : 8;
                const float* md = (const float*)(ws + WS_MOD) + (size_t)(layer * 9 + r) * 6144 + 2 * 1024;
                bf16_t* xs = (bf16_t*)(ws + WS_XS) + (size_t)row * DM;
                const float* base = row < ROWS_L ? x + (size_t)row * DM : ctx + (size_t)(row - ROWS_L) * DM;
#pragma unroll
                for (int bj = 0; bj < 2; ++bj) {
                    f32x4 o[2];
#pragma unroll
                    for (int n = 0; n < 2; ++n) {
                        const int col = u.pn * 256 + bj * 128 + wc * 32 + n * 16 + fq * 4;
                        const f32x4 bv = layer == 0 ? *(const f32x4*)(base + col) : ld_bf16x4(xs + col);
                        o[n] = bv + *(const f32x4*)(md + col) * acc[ai][bj][m][n];
                    }
                    st_bf16_pair(xs + u.pn * 256 + bj * 128 + wc * 32, fq, o[0], o[1]);
                }
            }
    }
};
struct EpiSwiglu {
    static constexpr bool PERM = false, AFTER_DRAIN = false;
    unsigned char* ws; int MT;
    DI void operator()(const ACC_T& acc, const pg8::Unit& u, int wr, int wc, int fr, int fq) const {
        const int j = u.pn & 15;
#pragma unroll
        for (int ai = 0; ai < 2; ++ai)
#pragma unroll
            for (int m = 0; m < 4; ++m) {
                const size_t row = (size_t)u.pm * 256 + ai * 128 + wr * 64 + m * 16 + fr;
                f32x4 o[2];
#pragma unroll
                for (int n = 0; n < 2; ++n) {
                    const f32x4 gt = acc[ai][0][m][n], up = acc[ai][1][m][n];
                    o[n].x = gt.x * __builtin_amdgcn_rcpf(1.0f + __expf(-gt.x)) * up.x; o[n].y = gt.y * __builtin_amdgcn_rcpf(1.0f + __expf(-gt.y)) * up.y; o[n].z = gt.z * __builtin_amdgcn_rcpf(1.0f + __expf(-gt.z)) * up.z; o[n].w = gt.w * __builtin_amdgcn_rcpf(1.0f + __expf(-gt.w)) * up.w;
                }
                st_bf16_pair((bf16_t*)(ws + OV_HID) + row * DE + j * 128 + wc * 32, fq, o[0], o[1]);
            }
    }
};
struct EpiMoeOut {
    static constexpr bool PERM = false, AFTER_DRAIN = false;
    unsigned char* ws;
    DI void operator()(const ACC_T& acc, const pg8::Unit& u, int wr, int wc, int fr, int fq) const {
        const int j = u.pn & 3;
#pragma unroll
        for (int ai = 0; ai < 2; ++ai)
#pragma unroll
            for (int m = 0; m < 4; ++m) {
                const size_t row = (size_t)u.pm * 256 + ai * 128 + wr * 64 + m * 16 + fr;
                const float gt = ((const float*)(ws + WS_GATE))[row];
#pragma unroll
                for (int bj = 0; bj < 2; ++bj)
                    st_bf16_pair((bf16_t*)(ws + OV_YB) + row * DM + j * 256 + bj * 128 + wc * 32, fq, acc[ai][bj][m][0] * gt, acc[ai][bj][m][1] * gt);
            }
    }
};
struct EpiMoeTail {
    static constexpr bool PERM = false, AFTER_DRAIN = false;
    unsigned char* ws; int q, s;
    DI void operator()(const ACC_T& acc, const pg8::Unit& u, int wr, int wc, int fr, int fq) const {
        bf16_t* dst = (bf16_t*)(ws + OV_YBS) + ((size_t)(q * 64 + s) * 256) * 256;
#pragma unroll
        for (int ai = 0; ai < 2; ++ai)
#pragma unroll
            for (int m = 0; m < 4; ++m) {
                const int r = ai * 128 + wr * 64 + m * 16 + fr;
                const float gt = ((const float*)(ws + WS_GATE))[(size_t)u.pm * 256 + r];
#pragma unroll
                for (int bj = 0; bj < 2; ++bj)
#pragma unroll
                    for (int n = 0; n < 2; ++n)
                        st_bf16x4(dst + (size_t)r * 256 + bj * 128 + wc * 32 + n * 16 + fq * 4, acc[ai][bj][m][n] * gt);
            }
    }
};
struct EpiWin1 {
    static constexpr bool PERM = false, AFTER_DRAIN = false;
    unsigned char* ws;
    DI void operator()(const ACC_T& acc, const pg8::Unit& u, int wr, int wc, int fr, int fq) const {
        if (u.pm < 0) {
            const int vt = u.pm + W1_SWAP - 8, ht = u.pn - W1_SWAP;
            const int b = ht < 64 ? ht >> 3 : ht - 64, kp0 = ht < 64 ? NC + (ht & 7) * 256 : 0;
#pragma unroll
            for (int ai = 0; ai < 2; ++ai)
#pragma unroll
                for (int m = 0; m < 4; ++m) {
                    const int cv = vt * 256 + ai * 128 + wr * 64 + m * 16 + fr;
                    bf16_t* dst = (bf16_t*)(ws + OV_VT1) + ((size_t)b * 1024 + cv) * NPOS + kp0 + wc * 32;
#pragma unroll
                    for (int bj = 0; bj < 2; ++bj) st_bf16_pair(dst + bj * 128, fq, acc[ai][bj][m][0], acc[ai][bj][m][1]);
                }
            return;
        }
        const float* tab = (const float*)(ws + WS_ROPE);
        const int sec = u.pn >> 2, pq = u.pn & 3;
#pragma unroll
        for (int ai = 0; ai < 2; ++ai)
#pragma unroll
            for (int m = 0; m < 4; ++m) {
                const int row = u.pm * 256 + ai * 128 + wr * 64 + m * 16 + fr;
                const bool lat = row < ROWS_L;
                const int b = lat ? row >> 11 : (row - ROWS_L) >> 8, tok = lat ? row & 2047 : (row - ROWS_L) & 255;
                const int kp = lat ? NC + tok : tok;
                {
                    const int pos = (wc & 1) ? (tok & 63) : (tok >> 6);
                    bf16_t* dst = sec == 0 ? (bf16_t*)(ws + OV_Q1) + (size_t)row * DM : (bf16_t*)(ws + OV_K1) + ((size_t)b * NPOS + kp) * DM;
#pragma unroll
                    for (int bj = 0; bj < 2; ++bj) {
                        const float qs = sec == 0 ? QSCALE : 1.0f;
                        f32x4 x0 = acc[ai][bj][m][0] * qs, x1 = acc[ai][bj][m][1] * qs;
                        if (lat) rope_pair(x0, x1, tab, pos, fq);
                        st_bf16_pair(dst + pq * 256 + bj * 128 + wc * 32, fq, x0, x1);
                    }
                }
            }
    }
};
DI int crow(int r, int hi) { return (r & 3) + 8 * (r >> 2) + 4 * hi; }
constexpr float ATT_C2 = 0.125f * 1.4426950408889634f;
constexpr int VPITCH = 144;
constexpr int ATT_BUF = 16384 + 128 * VPITCH;
constexpr int ATT_K_OFF = 0, ATT_V_OFF = 16384, ATT_WS_OFF = 3 * ATT_BUF, ATT_X_OFF = 0;
constexpr float ATT_THR = 8.0f;
struct AttnJob {
    const bf16_t* q; int qld;
    const bf16_t* k; int kld;
    const bf16_t* vt; int vld;
    int kchunk0;
    int nt;
    int nfree;
    int wpos0;
    int qpos0;
};
DI float xhalf(float v) {
    const unsigned u = __builtin_bit_cast(unsigned, v);
    auto r = __builtin_amdgcn_permlane32_swap(u, u, false, false);
    return __builtin_bit_cast(float, (threadIdx.x & 32) ? r[0] : r[1]);
}
template <int X> DI float xswz(float v) {
    return __builtin_bit_cast(float, __builtin_amdgcn_ds_swizzle(__builtin_bit_cast(int, v), (X << 10) | 0x1f));
}
DI int opaque(int x) { asm volatile("" : "+v"(x)); return x; }
DI float fmax3(float a, float b, float c) { return __builtin_fmaxf(__builtin_fmaxf(a, b), c); }
template <int DV, int KW, bool WINDOW>
DI void attn_core(LAS unsigned char* lds, const AttnJob& J, f32x16 (&o)[DV / 32], float& m_out, float& l_out) {
    constexpr int NDB = DV / 32, ROWB = KW * 2, NKC = KW / 8;
    const int tid = opaque(threadIdx.x), lane = tid & 63, r32 = lane & 31, hi = lane >> 5;
    bf16x8 qf[4];
#pragma unroll
    for (int ks = 0; ks < 4; ++ks) qf[ks] = *(const bf16x8*)(J.q + (size_t)r32 * J.qld + ks * 16 + hi * 8);
#pragma unroll
    for (int d = 0; d < NDB; ++d)
#pragma unroll
        for (int r = 0; r < 16; ++r) o[d][r] = 0.f;
    float mref = 0.f, l = 0.f;
    float negm = 0.f;
    u32x4 kreg[KW / 64], vreg[DV / 64];
#define ATT_LOAD(t) do { const int k0_ = (t) < J.nfree ? (t) * 64 : NC + J.wpos0 + ((t) - J.nfree) * 64; \
        _Pragma("unroll") for (int i = 0; i < KW / 64; ++i) { const int c = tid + 512 * i, row = c / NKC, ch = c % NKC; kreg[i] = *(const u32x4*)(J.k + (size_t)(k0_ + row) * J.kld + ch * 8); } \
        _Pragma("unroll") for (int i = 0; i < DV / 64; ++i) { const int c = tid + 512 * i, row = c >> 3, ch = c & 7; vreg[i] = *(const u32x4*)(J.vt + (size_t)row * J.vld + k0_ + ch * 8); } } while (0)
#define ATT_STORE(buf) do { LAS unsigned char* Kw_ = lds + (buf) * ATT_BUF + ATT_K_OFF; LAS unsigned char* Vw_ = lds + (buf) * ATT_BUF + ATT_V_OFF; \
        _Pragma("unroll") for (int i = 0; i < KW / 64; ++i) { const int c = tid + 512 * i, row = c / NKC, ch = c % NKC; const int sw = KW == 128 ? (row & 15) : ((row >> 1) & 7); \
            *(LAS u32x4*)(Kw_ + row * ROWB + ((ch ^ sw) << 4)) = kreg[i]; } \
        _Pragma("unroll") for (int i = 0; i < DV / 64; ++i) { const int c = tid + 512 * i, row = c >> 3, ch = c & 7; LAS unsigned char* p_ = Vw_ + row * VPITCH + ((ch >> 1) * 16 + (ch & 1) * 4) * 2; \
            *(LAS u32x2*)p_ = (u32x2){vreg[i].x, vreg[i].y}; *(LAS u32x2*)(p_ + 16) = (u32x2){vreg[i].z, vreg[i].w}; } } while (0)
#define ATT_SOFTMAX(s, t_, hh_, pa0, pa1) do { \
        if (WINDOW && (t_) >= J.nfree) { const int qp_ = J.qpos0 + r32, kp0_ = J.wpos0 + ((t_) - J.nfree) * 64 + (hh_) * 32; \
            _Pragma("unroll") for (int r = 0; r < 16; ++r) { const int d0_ = kp0_ + crow(r, hi) - qp_; if (d0_ > 128 || d0_ < -128) s[r] = -1e30f; } } \
        float mx_ = fmax3(s[0], s[1], s[2]); \
        _Pragma("unroll") for (int r = 3; r < 15; r += 2) mx_ = fmax3(mx_, s[r], s[r + 1]); \
        mx_ = __builtin_fmaxf(mx_, s[15]); mx_ = __builtin_fmaxf(mx_, xhalf(mx_)); \
        if (__any(mx_ > ATT_THR)) { const float dl_ = __builtin_fmaxf(mx_, 0.f), f_ = __builtin_amdgcn_exp2f(-dl_); mref += dl_; l *= f_; \
            negm = -mref; _Pragma("unroll") for (int r = 0; r < 16; ++r) s[r] -= dl_; \
            ATT_RESC_OTHER(dl_); \
            LAS float* wsf_ = (LAS float*)(lds + ATT_WS_OFF) + (tid >> 6) * 32; if (hi == 0) wsf_[r32] = f_; \
            _Pragma("unroll") for (int r = 0; r < 16; ++r) { const float g_ = wsf_[crow(r, hi)]; _Pragma("unroll") for (int d = 0; d < NDB; ++d) o[d][r] *= g_; } } \
        float ls_ = 0.f; \
        _Pragma("unroll") for (int r = 0; r < 16; ++r) { s[r] = __builtin_amdgcn_exp2f(s[r]); ls_ += s[r]; } \
        l += ls_; \
        { u32x4 w0_, w1_; w0_.x = pk2(s[0], s[1]); w0_.y = pk2(s[2], s[3]); w0_.z = pk2(s[4], s[5]); w0_.w = pk2(s[6], s[7]); \
          w1_.x = pk2(s[8], s[9]); w1_.y = pk2(s[10], s[11]); w1_.z = pk2(s[12], s[13]); w1_.w = pk2(s[14], s[15]); \
          pa0 = __builtin_bit_cast(bf16x8, w0_); pa1 = __builtin_bit_cast(bf16x8, w1_); } } while (0)
#define ATT_QK(s, Kb_, hh_) do { _Pragma("unroll") for (int r = 0; r < 16; ++r) s[r] = negm; \
        _Pragma("unroll") for (int ks = 0; ks < 4; ++ks) { const int ch_ = J.kchunk0 + ks * 2 + hi; const int sw_ = KW == 128 ? (r32 & 15) : ((r32 >> 1) & 7); \
            const bf16x8 kf_ = *(const LAS bf16x8*)((Kb_) + ((hh_) * 32 + r32) * ROWB + ((ch_ ^ sw_) << 4)); \
            s = __builtin_amdgcn_mfma_f32_32x32x16_bf16(kf_, qf[ks], s, 0, 0, 0); } } while (0)
    const unsigned lds0 = (unsigned)(size_t)lds, vx = (unsigned)(r32 * VPITCH + hi * 16);
    bf16x8 vf[2 * NDB];
#define ATT_VREADS(buf_, hh_) do { const unsigned va_ = lds0 + (unsigned)((buf_) * ATT_BUF + ATT_V_OFF) + vx; \
        if constexpr (NDB == 4) asm volatile("ds_read_b128 %0, %8 offset:%9\n\tds_read_b128 %1, %8 offset:%10\n\tds_read_b128 %2, %8 offset:%11\n\tds_read_b128 %3, %8 offset:%12\n\t" \
                                             "ds_read_b128 %4, %8 offset:%13\n\tds_read_b128 %5, %8 offset:%14\n\tds_read_b128 %6, %8 offset:%15\n\tds_read_b128 %7, %8 offset:%16" \
            : "=&v"(vf[0]), "=&v"(vf[1]), "=&v"(vf[2]), "=&v"(vf[3]), "=&v"(vf[4 % (2 * NDB)]), "=&v"(vf[5 % (2 * NDB)]), "=&v"(vf[6 % (2 * NDB)]), "=&v"(vf[7 % (2 * NDB)]) \
            : "v"(va_), "i"(0 * 32 * VPITCH + (2 * (hh_)) * 32), "i"(0 * 32 * VPITCH + (2 * (hh_) + 1) * 32), "i"(1 * 32 * VPITCH + (2 * (hh_)) * 32), "i"(1 * 32 * VPITCH + (2 * (hh_) + 1) * 32), \
              "i"(2 * 32 * VPITCH + (2 * (hh_)) * 32), "i"(2 * 32 * VPITCH + (2 * (hh_) + 1) * 32), "i"(3 * 32 * VPITCH + (2 * (hh_)) * 32), "i"(3 * 32 * VPITCH + (2 * (hh_) + 1) * 32) : "memory"); \
        else asm volatile("ds_read_b128 %0, %4 offset:%5\n\tds_read_b128 %1, %4 offset:%6\n\tds_read_b128 %2, %4 offset:%7\n\tds_read_b128 %3, %4 offset:%8" \
            : "=&v"(vf[0]), "=&v"(vf[1]), "=&v"(vf[2]), "=&v"(vf[3]) \
            : "v"(va_), "i"(0 * 32 * VPITCH + (2 * (hh_)) * 32), "i"(0 * 32 * VPITCH + (2 * (hh_) + 1) * 32), "i"(1 * 32 * VPITCH + (2 * (hh_)) * 32), "i"(1 * 32 * VPITCH + (2 * (hh_) + 1) * 32) : "memory"); } while (0)
#define ATT_PV(pa0, pa1) do { \
        if constexpr (NDB == 4) asm volatile("s_waitcnt lgkmcnt(0)" : "+v"(vf[0]), "+v"(vf[1]), "+v"(vf[2]), "+v"(vf[3]), "+v"(vf[4 % (2 * NDB)]), "+v"(vf[5 % (2 * NDB)]), "+v"(vf[6 % (2 * NDB)]), "+v"(vf[7 % (2 * NDB)]) :: "memory"); \
        else asm volatile("s_waitcnt lgkmcnt(0)" : "+v"(vf[0]), "+v"(vf[1]), "+v"(vf[2]), "+v"(vf[3]) :: "memory"); \
        _Pragma("unroll") for (int d = 0; d < NDB; ++d) { \
            o[d] = __builtin_amdgcn_mfma_f32_32x32x16_bf16(pa0, vf[2 * d], o[d], 0, 0, 0); \
            o[d] = __builtin_amdgcn_mfma_f32_32x32x16_bf16(pa1, vf[2 * d + 1], o[d], 0, 0, 0); } } while (0)
    __syncthreads();
    ATT_LOAD(0); ATT_STORE(0);
    if (J.nt > 1) ATT_LOAD(1);
    __syncthreads();
    f32x16 sa, sb;
    ATT_QK(sa, lds + ATT_K_OFF, 0);
    int cur = 0;
    for (int t = 0; t < J.nt; ++t) {
        const int nxt = cur == 2 ? 0 : cur + 1;
        if (t + 1 < J.nt) ATT_STORE(nxt);
        if (t + 2 < J.nt) ATT_LOAD(t + 2);
        __syncthreads();
        LAS unsigned char* Kb = lds + cur * ATT_BUF + ATT_K_OFF;
        bf16x8 p0, p1;
#define ATT_RESC_OTHER(dl) do { _Pragma("unroll") for (int r = 0; r < 16; ++r) sb[r] -= (dl); } while (0)
        ATT_QK(sb, Kb, 1);
        ATT_VREADS(cur, 0);
        ATT_SOFTMAX(sa, t, 0, p0, p1);
        ATT_PV(p0, p1);
#undef ATT_RESC_OTHER
#define ATT_RESC_OTHER(dl) do { _Pragma("unroll") for (int r = 0; r < 16; ++r) sa[r] -= (dl); } while (0)
        if (t + 1 < J.nt) ATT_QK(sa, lds + nxt * ATT_BUF + ATT_K_OFF, 0);
        ATT_VREADS(cur, 1);
        ATT_SOFTMAX(sb, t, 1, p0, p1);
        ATT_PV(p0, p1);
#undef ATT_RESC_OTHER
        cur = nxt;
    }
    __syncthreads();
#undef ATT_SOFTMAX
#undef ATT_QK
#undef ATT_PV
#undef ATT_VREADS
#undef ATT_LOAD
#undef ATT_STORE
    m_out = mref; l_out = l + xhalf(l);
}
template <int NDB> DI void attn_scale_rows(LAS unsigned char* lds, f32x16 (&o)[NDB], float f) {
    const int tid = opaque(threadIdx.x), lane = tid & 63, r32 = lane & 31, hi = lane >> 5;
    LAS float* wsf = (LAS float*)(lds + ATT_WS_OFF) + (tid >> 6) * 32;
    if (hi == 0) wsf[r32] = f;
#pragma unroll
    for (int r = 0; r < 16; ++r) { const float g = wsf[crow(r, hi)];
#pragma unroll
        for (int d = 0; d < NDB; ++d) o[d][r] *= g; }
}
DI void pwin_attn_phase(const Args& a, LAS unsigned char* lds, int G, int stage, int& conv_pos) {
    const int tid = threadIdx.x, wave = __builtin_amdgcn_readfirstlane(tid >> 6);
    const bf16_t* Q0 = (const bf16_t*)(a.ws + OV_Q0); const bf16_t* K0 = (const bf16_t*)(a.ws + OV_K0); const bf16_t* VT0 = (const bf16_t*)(a.ws + OV_VT0);
    bf16_t* MIX = (bf16_t*)(a.ws + WS_MIX);
    const int bx = (int)blockIdx.x;
    int first, step, count;
    if (G != 256) { first = (bx - 160 % G + G) % G; step = G; count = stage == 0 ? (576 - first + G - 1) / G : 0; }
    else if (stage == 0) { first = (bx + 96) & 255; step = 256; count = first < 144 ? 2 : 1; }
    else if (stage == 1) { first = 400 + (bx - 192); step = 1; count = bx >= 192 ? 1 : 0; }
    else { const int c = (bx + 64) & 255; first = 464 + (c - 144); step = 1; count = c >= 144 ? 1 : 0; }
    const int conv_at = stage == 0 ? ((bx & 1) < count ? (bx & 1) : count) : -1;
    for (int ku = 0; ku <= count; ++ku) {
        if (ku == conv_at) steal_conv(a, lds, G, 3, 0, false, conv_pos);
        if (ku == count) break;
        const int it = first + step * ku;
        AttnJob J; int qh, row0;
        int b, kvh;
        if (it < 512) {
            b = it >> 6; kvh = (it >> 5) & 1; const int nb = (it >> 1) & 15, pr = it & 1;
            qh = kvh * 4 + pr * 2 + (wave >> 2); const int ql = nb * 128 + (wave & 3) * 32; row0 = b * NL + ql;
            const int first = nb == 0 ? 0 : (nb - 1) * 128, last = nb == 15 ? NL : (nb + 2) * 128;
            J.nfree = 4; J.nt = 4 + (last - first) / 64; J.wpos0 = first; J.qpos0 = ql;
        } else {
            const int r = it - 512; b = r >> 3; kvh = (r >> 2) & 1; const int idx = (r & 3) * 8 + wave;
            qh = kvh * 4 + (idx >> 3); row0 = ROWS_L + b * NC + (idx & 7) * 32;
            J.nfree = 4; J.nt = 4; J.wpos0 = 0; J.qpos0 = 0;
        }
        J.q = Q0 + (size_t)row0 * 512 + qh * 64; J.qld = 512;
        J.k = K0 + (size_t)b * NPOS * 128 + kvh * 64; J.kld = 128;
        J.vt = VT0 + (size_t)(b * 2 + kvh) * 64 * NPOS; J.vld = NPOS;
        J.kchunk0 = 0;
        f32x16 o[2]; float m, l;
        attn_core<64, 64, true>(lds, J, o, m, l);
        l += exp2f(a.in[I_SINK][qh] * 1.4426950408889634f - m);
        attn_scale_rows<2>(lds, o, 1.0f / l);
        const int tid2 = opaque(threadIdx.x), r32 = tid2 & 31, hi = (tid2 >> 5) & 1;
#pragma unroll
        for (int d = 0; d < 2; ++d)
#pragma unroll
            for (int r = 0; r < 16; ++r)
                MIX[(size_t)(row0 + crow(r, hi)) * DM + 512 + qh * 64 + d * 32 + r32] = (bf16_t)f2bf(o[d][r]);
    }
}
DI void pdiff_attn_phase(const Args& a, LAS unsigned char* lds, int G, int& conv_pos) {
    const int tid = threadIdx.x, lane = tid & 63, wave = __builtin_amdgcn_readfirstlane(tid >> 6);
    const bf16_t* Q1 = (const bf16_t*)(a.ws + OV_Q1); const bf16_t* K1 = (const bf16_t*)(a.ws + OV_K1); const bf16_t* VT1 = (const bf16_t*)(a.ws + OV_VT1);
    bf16_t* MIX = (bf16_t*)(a.ws + WS_MIX);
    float d1 = a.in[I_LQ1][lane] * a.in[I_LK1][lane], d2 = a.in[I_LQ2][lane] * a.in[I_LK2][lane];
    d1 = wave_sum(d1); d2 = wave_sum(d2);
    const float lam = expf(d1) - expf(d2) + LAM_INIT1;
    int ku = 0;
    const int vcu = (G % 8 == 0) ? (int)(blockIdx.x % 8) * (G / 8) + (int)(blockIdx.x / 8) : (int)blockIdx.x;
    for (int it = vcu; it < 1024; it += G, ++ku) {
        if (ku == (int)(blockIdx.x & 3)) steal_conv(a, lds, G, 14, 1, false, conv_pos);
        const int b = it >> 7, h = (it >> 4) & 7, qb = it & 15, mp = wave >> 2;
        const int row0 = b * NL + qb * 128 + (wave & 3) * 32;
        AttnJob J;
        J.q = Q1 + (size_t)row0 * DM + h * 128 + mp * 64; J.qld = DM;
        J.k = K1 + (size_t)b * NPOS * DM + h * 128; J.kld = DM;
        J.vt = VT1 + (size_t)(b * 8 + h) * 128 * NPOS; J.vld = NPOS;
        J.kchunk0 = mp * 8; J.nt = NPOS / 64; J.nfree = NPOS / 64; J.wpos0 = 0; J.qpos0 = 0;
        f32x16 o[4]; float m, l;
        attn_core<128, 128, false>(lds, J, o, m, l);
        attn_scale_rows<4>(lds, o, 1.0f / l);
        const int tid2 = opaque(threadIdx.x), r32 = tid2 & 31, hi = (tid2 >> 5) & 1;
        __syncthreads();
        LAS float* xb = (LAS float*)(lds + ATT_X_OFF) + (wave & 3) * 32 * 128;
        if (mp == 1) {
#pragma unroll
            for (int d = 0; d < 4; ++d)
#pragma unroll
                for (int r = 0; r < 16; ++r) xb[crow(r, hi) * 128 + d * 32 + r32] = o[d][r];
        }
        __syncthreads();
        if (mp == 0) {
            float ss[16];
#pragma unroll
            for (int r = 0; r < 16; ++r) {
                float s = 0.f;
#pragma unroll
                for (int d = 0; d < 4; ++d) { const float v = o[d][r] - lam * xb[crow(r, hi) * 128 + d * 32 + r32]; o[d][r] = v; s += v * v; }
                ss[r] = s;
            }
#pragma unroll
            for (int r = 0; r < 16; ++r) {
                ss[r] += xswz<1>(ss[r]); ss[r] += xswz<2>(ss[r]); ss[r] += xswz<4>(ss[r]); ss[r] += xswz<8>(ss[r]); ss[r] += xswz<16>(ss[r]);
                ss[r] = (1.0f - LAM_INIT1) / sqrtf(ss[r] * (1.0f / 128.0f) + NORM_EPS);
            }
#pragma unroll
            for (int d = 0; d < 4; ++d) {
                const float gsub = a.in[I_SUBLN][d * 32 + r32];
#pragma unroll
                for (int r = 0; r < 16; ++r)
                    MIX[(size_t)(row0 + crow(r, hi)) * DM + h * 128 + d * 32 + r32] = (bf16_t)f2bf(o[d][r] * ss[r] * gsub);
            }
        }
        __syncthreads();
    }
}
__global__ void __launch_bounds__(NTHREADS, 2) fwd_megakernel(Args a) {
    extern __shared__ __attribute__((aligned(16))) unsigned char lds_raw[];
    LAS unsigned char* lds = (LAS unsigned char*)lds_raw;
    volatile LAS unsigned* MISC = (volatile LAS unsigned*)(lds + MISC_OFF);
    const int tid = threadIdx.x, G = gridDim.x;
    for (int u = tid; u < (LDS_BYTES - RING_BYTES) / 4; u += NTHREADS) ((LAS unsigned*)(lds + RING_BYTES))[u] = 0u;
    __syncthreads();
    unsigned char* ws = a.ws;
    XcdBarrier bar = xcd_barrier_post((unsigned*)(ws + WS_CTL) + 4096, MISC + 8);
    const int lo = a.ph_lo, hi = a.ph_hi;
#ifndef DUP_MASK
#define DUP_MASK 0u
#endif
#define IN(k) (lo <= (k) && (k) < hi)
#define REP(k) for (int rep_ = 0; rep_ < 1 + (int)((DUP_MASK >> (k)) & 1u); ++rep_)
#ifdef PROBE_A
    unsigned long long* ts = (unsigned long long*)(ws + WS_DBG);
    if (blockIdx.x == 0 && tid == 0) ts[0] = __builtin_amdgcn_s_memrealtime();
#define SEAM(k) do { xcd_barrier(bar); if (blockIdx.x == 0 && tid == 0) ts[(k) + 1] = __builtin_amdgcn_s_memrealtime(); } while (0)
#else
#define SEAM(k) do { if (IN(k) && IN((k) + 1)) xcd_barrier(bar); } while (0)
#endif
    const int cblk = (int)blockIdx.x;
    int conv_pos = 0;
#define ROT(r) ((cblk + (r)) % G)
    if (IN(0)) REP(0) { p0_phase(a, lds, G); } SEAM(0);
    if (IN(1)) REP(1) { p1_phase(a, lds, G); } SEAM(1);
    if (IN(2)) REP(2) {
        pg8::Gemm g{(const bf16_t*)(ws + WS_HX), (const bf16_t*)(ws + WS_WIN0T), 1024, 1024, 1024}; pg8::StaticOrder S; S.init(ROWS, 1280, G, cblk);
        EpiWin0 E{ws}; pg8::gemm_phase<EpiWin0, pg8::StaticOrder, true, true>(lds, g, S, E);
        {
            const int first_idle = (G < 360 && G >= 180) ? 360 - G : 0;
            if (cblk >= first_idle) toeplitz_fill(a, (cblk - first_idle) * NWAVES + __builtin_amdgcn_readfirstlane(tid >> 6), (G - first_idle) * NWAVES, tid & 63);
        }
    } SEAM(2);
    if (IN(3)) REP(3) {
        pg8::Gemm g{(const bf16_t*)(ws + OV_AS5), (const bf16_t*)(ws + OV_BTA), 512, S5_KC, 512}; GroupOrder S; S.init(S5G, 3, 1, G, ROT(G - 64));
        EpiS5a E{ws}; pg8::gemm_phase<EpiS5a, GroupOrder, true, true>(lds, g, S, E);
        pwin_attn_phase(a, lds, G, 0, conv_pos);
    } SEAM(3);
    if (IN(4)) REP(4) { ps5_rec_phase(a, G); } SEAM(4);
    if (IN(5)) REP(5) {
        pg8::Gemm g{(const bf16_t*)(ws + OV_AS5), (const bf16_t*)(ws + OV_BTC), S5_KC, S5_KC, S5_KC}; GroupOrder S; S.init(S5G, 3, 2, G, cblk);
        EpiS5c E{ws, a.in[I_S5D]}; pg8::gemm_phase<EpiS5c, GroupOrder, true, true>(lds, g, S, E);
        pwin_attn_phase(a, lds, G, 1, conv_pos);
    } SEAM(5);
    if (IN(6)) REP(6) {
        pg8::Gemm g{(const bf16_t*)(ws + OV_Z), (const bf16_t*)(ws + WS_WGLUT), 512, 512, 512}; pg8::StaticOrder S; S.init(ROWS, 512, G, ROT(G - 192));
        EpiGlu E{ws, a.in[I_GLUB]}; pg8::gemm_phase<EpiGlu, pg8::StaticOrder, true, true>(lds, g, S, E);
        pwin_attn_phase(a, lds, G, 2, conv_pos);
    } SEAM(6);
    if (IN(7)) REP(7) {
        pg8::Gemm g{(const bf16_t*)(ws + WS_MIX), (const bf16_t*)(ws + WS_WOUT0T), 1024, 1024, 1024}; pg8::StaticOrder S; S.init(ROWS, 1024, G, ROT(G - 80));
        EpiResid E{ws, a.in[I_X], a.in[I_CTX], 0}; pg8::gemm_phase<EpiResid, pg8::StaticOrder, true, true>(lds, g, S, E);
    } SEAM(7);
    if (IN(8)) REP(8) { pnorm_router_phase(a, lds, G, 0, ROWS); } SEAM(8);
    if (IN(9)) REP(9) { ptopk_phase(a, lds, G, 1, 2304); } if (IN(9)) steal_conv(a, lds, G, 9, 0, false, conv_pos); SEAM(9);
    if (IN(10)) REP(10) {
        GroupOrder S; S.init(NE, 9, 16, G, cblk);
        LAS int* gidx = (LAS int*)(lds + RING_BYTES + 1024);
        for (int i = 0;; ++i) { pg8::Unit u; if (!S.next(i, u)) break; if (tid < 256) gidx[i * 256 + tid] = ((const int*)(ws + WS_SELROW))[(size_t)u.pm * 256 + tid]; }
        __syncthreads();
        pg8::Gemm g{(const bf16_t*)(ws + WS_HX), (const bf16_t*)(ws + WS_W1T), 1024, 1024, 1024};
        EpiSwiglu E{ws, 9}; pg8::gemm_phase<EpiSwiglu, GroupOrder, true, true, true>(lds, g, S, E, gidx);
    } SEAM(10);
    if (IN(11)) REP(11) {
        pg8::Gemm g{(const bf16_t*)(ws + OV_HID), (const bf16_t*)(ws + WS_W2T), 2048, 2048, 2048}; GroupOrder S; S.init(NE, 9, 4, G, ROT(G - 112));
        EpiMoeOut E{ws}; pg8::gemm_phase<EpiMoeOut, GroupOrder, true, true>(lds, g, S, E);
    } SEAM(11);
    if (IN(12)) REP(12) { pcombine_phase(a, G, 0, ROWS, 2304); } SEAM(12);
    if (IN(13)) REP(13) {
        pg8::Gemm g{(const bf16_t*)(ws + WS_HX), (const bf16_t*)(ws + WS_WIN1T), 1024, 1024, 1024}; Win1Order S; S.init(G, ROT(G - 176));
        EpiWin1 E{ws}; pg8::gemm_phase<EpiWin1, Win1Order, true, true>(lds, g, S, E);
    } SEAM(13);
    if (IN(14)) REP(14) { pdiff_attn_phase(a, lds, G, conv_pos); } SEAM(14);
    if (IN(15)) REP(15) {
        pg8::Gemm g{(const bf16_t*)(ws + WS_MIX), (const bf16_t*)(ws + WS_WOUT1T), 1024, 1024, 1024}; pg8::StaticOrder S; S.init(ROWS_L, 1024, G, cblk);
        EpiResid E{ws, a.in[I_X], a.in[I_CTX], 1}; pg8::gemm_phase<EpiResid, pg8::StaticOrder, true, true>(lds, g, S, E);
    } SEAM(15);
    if (IN(16)) REP(16) { pnorm_router_phase(a, lds, G, 1, ROWS_L); } SEAM(16);
    if (IN(17)) REP(17) { ptopk_phase(a, lds, G, 0, 2048); } if (IN(17)) steal_conv(a, lds, G, 17, 1, false, conv_pos); SEAM(17);
    if (IN(18)) REP(18) {
        GroupOrder S; S.init(NE, 8, 16, G, cblk);
        LAS int* gidx = (LAS int*)(lds + RING_BYTES + 1024);
        for (int i = 0;; ++i) { pg8::Unit u; if (!S.next(i, u)) break; if (tid < 256) gidx[i * 256 + tid] = ((const int*)(ws + WS_SELROW))[(size_t)u.pm * 256 + tid]; }
        __syncthreads();
        pg8::Gemm g{(const bf16_t*)(ws + WS_HX), (const bf16_t*)(ws + WS_W1T) + (size_t)16 * 4096 * 1024, 1024, 1024, 1024};
        EpiSwiglu E{ws, 8}; pg8::gemm_phase<EpiSwiglu, GroupOrder, true, true, true>(lds, g, S, E, gidx);
    } SEAM(18);
    if (IN(19)) REP(19) {
        pg8::Gemm g{(const bf16_t*)(ws + OV_HID), (const bf16_t*)(ws + WS_W2T) + (size_t)16 * 1024 * 2048, 2048, 2048, 2048}; GroupOrder S; S.init(NE, 8, 4, G, cblk);
        EpiMoeOut E{ws}; pg8::gemm_phase<EpiMoeOut, GroupOrder, true, true>(lds, g, S, E);
    } SEAM(19);
    if (IN(20)) REP(20) { pcombine_phase(a, G, 1, ROWS_L, 2048); }
#ifdef PROBE_A
    SEAM(20);
    xcd_barrier(bar);
    {
        const float da = (float)(ts[PROBE_A + 1] - ts[PROBE_A]) * 0.01f, db = (float)(ts[PROBE_B + 1] - ts[PROBE_B]) * 0.01f;
        const float c = 2.0f * logf(fmaxf(da, 1.0f));
        for (size_t i = (size_t)blockIdx.x * NTHREADS + tid; i < (size_t)ROWS_L * DM; i += (size_t)G * NTHREADS) a.out[i] = (i == 0) ? db : c;
    }
#endif
#undef IN
#undef SEAM
}

extern "C" void kernel_launch(void* const* d_in, const int* in_sizes, int n_in, void* d_out, int out_size, void* d_ws, size_t ws_size, hipStream_t stream) {
    static int grid = 0;
    if (grid == 0) {
        if (n_in != 33 || out_size != ROWS_L * DM || ws_size < WS_END) { fprintf(stderr, "kernel_launch: unexpected shapes (n_in %d, out %d, ws %zu; need ws >= %zu)\n", n_in, out_size, ws_size, (size_t)WS_END); grid = -1; return; }
        int dev = 0, cus = 0, per_cu = 0;
        if (hipGetDevice(&dev) != hipSuccess || hipDeviceGetAttribute(&cus, hipDeviceAttributeMultiprocessorCount, dev) != hipSuccess) { grid = -1; return; }
        if (hipFuncSetAttribute((const void*)fwd_megakernel, hipFuncAttributeMaxDynamicSharedMemorySize, LDS_BYTES) != hipSuccess) { fprintf(stderr, "kernel_launch: hipFuncSetAttribute failed\n"); grid = -1; return; }
        if (hipOccupancyMaxActiveBlocksPerMultiprocessor(&per_cu, (const void*)fwd_megakernel, NTHREADS, LDS_BYTES) != hipSuccess || per_cu < 1) { fprintf(stderr, "kernel_launch: occupancy query reports %d\n", per_cu); }
        (void)hipGetLastError();
        grid = cus;
    }
    if (grid < 0) return;
    (void)hipMemsetAsync((char*)d_ws + WS_CTL, 0, CTL_BYTES, stream);
    Args a{};
    for (int i = 0; i < 33; ++i) a.in[i] = (const float*)d_in[i];
    a.out = (float*)d_out; a.ws = (unsigned char*)d_ws; a.ph_lo = 0; a.ph_hi = 21;
    hipLaunchKernelGGL(fwd_megakernel, dim3(grid), dim3(NTHREADS), LDS_BYTES, stream, a);
}
```

```cpp
#include <hip/hip_runtime.h>
#include <cstdio>
#include <cstdint>
#include <cmath>

#define LAS __attribute__((address_space(3)))
#define GAS __attribute__((address_space(1)))
#define DI __device__ __forceinline__
typedef unsigned short bf16_t;
typedef short bf16x8 __attribute__((ext_vector_type(8)));
typedef short s16x4 __attribute__((ext_vector_type(4)));
typedef float f32x4 __attribute__((ext_vector_type(4)));
typedef float f32x2 __attribute__((ext_vector_type(2)));
typedef float f32x16 __attribute__((ext_vector_type(16)));
typedef unsigned u32x4 __attribute__((ext_vector_type(4)));
typedef unsigned u32x2 __attribute__((ext_vector_type(2)));
typedef __bf16 bf16x2_t __attribute__((ext_vector_type(2)));

constexpr int DM = 1024, NB = 8, NL = 2048, NC = 256;
constexpr int ROWS_L = NB * NL, ROWS_C = NB * NC, ROWS = ROWS_L + ROWS_C;
constexpr int NPOS = NC + NL;
constexpr int NE = 16, DE = 2048, CAP_L = 256, CAP_C = 32;
constexpr int S5G = 32, S5P = 64, S5T = 32;
constexpr int S5_MROWS = 768, S5_VALID = 576, S5_KC = 768;
constexpr float NORM_EPS = 1e-6f;
constexpr float LAM_INIT1 = 0.35550906759f;

constexpr size_t MiB = 1u << 20;
constexpr size_t WS_CTL = 0, CTL_BYTES = 64 * 1024;
constexpr size_t WS_MOD = 1 * MiB;
constexpr size_t WS_ROPE = 2 * MiB;
constexpr size_t WS_APOW = 2 * MiB + 65536;
constexpr size_t WS_DBG = 2 * MiB + 262144;
constexpr size_t WS_KTAB = 3 * MiB;
constexpr size_t WS_WIN0T = 8 * MiB;
constexpr size_t WS_WGLUT = 11 * MiB;
constexpr size_t WS_WOUT0T = 12 * MiB;
constexpr size_t WS_WIN1T = 14 * MiB;
constexpr size_t WS_WOUT1T = 20 * MiB;
constexpr size_t WS_AFFL = 22 * MiB;
constexpr size_t WS_AFFC = 23 * MiB;
constexpr size_t WS_TOKSLOT = 24 * MiB;
constexpr size_t WS_GATE = 26 * MiB;
constexpr size_t WS_SELROW = 27 * MiB;
constexpr size_t WS_XS = 32 * MiB;
constexpr size_t WS_HX = 104 * MiB;
constexpr size_t WS_MIX = 140 * MiB;
constexpr size_t WS_W1T = 176 * MiB;
constexpr size_t WS_W2T = 432 * MiB;
constexpr size_t WS_OV = 560 * MiB;
constexpr size_t OV_BTA = WS_OV + 0 * MiB;
constexpr size_t OV_BTC = WS_OV + 16 * MiB;
constexpr size_t OV_AS5 = WS_OV + 96 * MiB;
constexpr size_t OV_S = WS_OV + 40 * MiB;
constexpr size_t OV_Z = WS_OV + 152 * MiB;
constexpr size_t OV_Q0 = WS_OV + 170 * MiB;
constexpr size_t OV_K0 = WS_OV + 188 * MiB;
constexpr size_t OV_VT0 = WS_OV + 193 * MiB;
constexpr size_t OV_XG = WS_OV + 0 * MiB;
constexpr size_t OV_HID = WS_OV + 72 * MiB;
constexpr size_t OV_YB = WS_OV + 216 * MiB;
constexpr size_t OV_Q1 = WS_OV + 0 * MiB;
constexpr size_t OV_K1 = WS_OV + 32 * MiB;
constexpr size_t OV_VT1 = WS_OV + 68 * MiB;
constexpr size_t OV_YBS = WS_OV + 288 * MiB;
constexpr size_t WS_END = WS_OV + 320 * MiB;

constexpr int NTHREADS = 512, NWAVES = 8;
constexpr int RING_BYTES = 131072, MISC_OFF = RING_BYTES + 320, LDS_BYTES = 147456;

DI unsigned f2bf(float f) { unsigned u = __builtin_bit_cast(unsigned, f); return (u + 0x7fffu + ((u >> 16) & 1u)) >> 16; }
DI unsigned pk2(float lo, float hi) { f32x2 v = {lo, hi}; bf16x2_t b = __builtin_convertvector(v, bf16x2_t); return __builtin_bit_cast(unsigned, b); }
DI float bf2f(unsigned short h) { return __builtin_bit_cast(float, (unsigned)h << 16); }
DI float bflo(unsigned w) { return __builtin_bit_cast(float, w << 16); }
DI float bfhi(unsigned w) { return __builtin_bit_cast(float, w & 0xffff0000u); }
DI float wave_sum(float v) {
#pragma unroll
    for (int o = 1; o < 64; o <<= 1) v += __shfl_xor(v, o);
    return v;
}
namespace pg8 {
#define PG8_LAS __attribute__((address_space(3)))
typedef unsigned short bf16_t;
typedef short bf16x8 __attribute__((ext_vector_type(8)));
typedef float f32x4 __attribute__((ext_vector_type(4)));
typedef unsigned u32x4 __attribute__((ext_vector_type(4)));
constexpr int BM = 256, BK = 64, HALF = 128, HTB = HALF * BK * 2  , STAGE_BYTES = 8 * HTB, NXCD = 8, WGM = 8;

__host__ __device__ __forceinline__ int lds_byte(int r, int c) { const int st = (r >> 4) * 2 + (c >> 5), rr = r & 15, cc = c & 31, ob = rr * 64 + cc * 2; return st * 1024 + (ob ^ (((ob >> 9) & 1) << 5)); }
__host__ __device__ __forceinline__ void stage_rc(int b, int& R, int& C) { const int st = b / 1024, sb = b % 1024, swz = sb ^ (((sb >> 9) & 1) << 5); R = (st >> 1) * 16 + swz / 64; C = (st & 1) * 32 + (swz % 64) / 2; }
__host__ __device__ __forceinline__ int perm32(int rho) { const int n = rho >> 4, i = rho & 15; return 8 * (i >> 2) + 4 * n + (i & 3); }

struct Unit { int pm, pn; };
struct Gemm { const bf16_t* A; const bf16_t* Bt; int K, lda, ldb; };

struct StaticOrder {
    int nM, nN, nwg, G, c;
    __host__ __device__ void init(int M, int N, int G_, int c_) { nM = M / BM; nN = N / BM; nwg = nM * nN; G = G_; c = c_; }
    __host__ __device__ bool next(int i, Unit& u) const {
        const long L = (long)i * G + c; if (L >= nwg) return false;
        int wgid = (int)L; { const int q = nwg / NXCD, r = nwg % NXCD, xcd = wgid % NXCD, off = wgid / NXCD; wgid = (xcd < r ? xcd * (q + 1) : r * (q + 1) + (xcd - r) * q) + off; }
        const int nig = WGM * nN, gid = wgid / nig, fm = gid * WGM, gsz = (nM - fm) < WGM ? (nM - fm) : WGM;
        u.pm = fm + ((wgid % nig) % gsz); u.pn = (wgid % nig) / gsz; return true;
    }
    __device__ __forceinline__ void a_ready(const Unit&) const {}
    __device__ __forceinline__ void done(const Unit&) const {}
};


template <class Epi, class Sched, bool ALIGN_EPI = false, bool SP2 = false, bool GATHER = false>
__device__ __forceinline__ void gemm_phase(PG8_LAS unsigned char* lds, const Gemm g, const Sched& S, const Epi& E, const PG8_LAS int* gidx = nullptr) {
    const int tid = threadIdx.x, wid = __builtin_amdgcn_readfirstlane(tid >> 6), lane = tid & 63, wr = wid >> 2, wc = wid & 3, fr = lane & 15, fq = lane >> 4;
    const int K = g.K, nt = K / BK, lda = g.lda, ldb = g.ldb;
    unsigned voffA[2], voffB[2];
#pragma unroll
    for (int i = 0; i < 2; ++i) { int R, C; stage_rc(tid * 16 + i * 8192, R, C); const int Rb = Epi::PERM ? ((R & ~31) + perm32(R & 31)) : R;
        voffA[i] = (unsigned)(R * lda + C) * 2u; voffB[i] = (unsigned)(Rb * ldb + C) * 2u; }
    const size_t kstep = (size_t)(BK * 2);
    const size_t hstepA = (size_t)HALF * lda * 2, hstepB = (size_t)HALF * ldb * 2;
    const size_t tstepA = 2 * hstepA, tstepB = 2 * hstepB;
    unsigned gc0[2] = {0u, 0u}, gc1[2] = {0u, 0u}, gn0[2] = {0u, 0u}, gn1[2] = {0u, 0u};
#define PG8_GOFF(ui_, o0, o1) do { _Pragma("unroll") for (int i_ = 0; i_ < 2; ++i_) { int R_, C_; stage_rc(tid * 16 + i_ * 8192, R_, C_); \
        o0[i_] = (unsigned)gidx[(ui_) * 256 + R_] * (unsigned)(lda * 2) + (unsigned)(C_ * 2); o1[i_] = (unsigned)gidx[(ui_) * 256 + 128 + R_] * (unsigned)(lda * 2) + (unsigned)(C_ * 2); } \
        asm volatile("s_waitcnt lgkmcnt(0)" ::: "memory"); } while (0)
#define PG8_STA(bufoff, ptr, h, sel) do { if constexpr (GATHER) { PG8_STAGE(bufoff, ptr, g##sel##h); } else { PG8_STAGE(bufoff, (ptr) + (h) * hstepA, voffA); } } while (0)
    const unsigned ldsw = (unsigned)wid * 1024u;
    const int aoff = lds_byte(wr * 64 + fr, fq * 8), boff = lds_byte(wc * 32 + fr, fq * 8);
#define PG8_SA(b, h) (((b) * 2 + (h)) * HTB)
#define PG8_SB(b, h) ((4 + (b) * 2 + (h)) * HTB)
#define PG8_STAGE(bufoff, gbase, voff) do { _Pragma("unroll") for (int _i = 0; _i < 2; ++_i) \
        __builtin_amdgcn_global_load_lds((const unsigned*)((const char*)(gbase) + (voff)[_i]), (PG8_LAS unsigned*)(lds + (bufoff) + ldsw + _i * 8192), 16, 0, 0); } while (0)
#define PG8_LDA(dst, b, h) do { _Pragma("unroll") for (int m = 0; m < 4; ++m) _Pragma("unroll") for (int k = 0; k < 2; ++k) dst[m][k] = *(const PG8_LAS bf16x8*)(lds + PG8_SA(b, h) + aoff + m * 2048 + k * 1024); } while (0)
#define PG8_LDB(dst, b, h) do { _Pragma("unroll") for (int n = 0; n < 2; ++n) _Pragma("unroll") for (int k = 0; k < 2; ++k) dst[n][k] = *(const PG8_LAS bf16x8*)(lds + PG8_SB(b, h) + boff + n * 2048 + k * 1024); } while (0)
#define PG8_MMA(ai, bj, At, Bt) do { __builtin_amdgcn_s_setprio(1); _Pragma("unroll") for (int m = 0; m < 4; ++m) _Pragma("unroll") for (int n = 0; n < 2; ++n) _Pragma("unroll") for (int k = 0; k < 2; ++k) \
        acc[ai][bj][m][n] = __builtin_amdgcn_mfma_f32_16x16x32_bf16(Bt[n][k], At[m][k], acc[ai][bj][m][n], 0, 0, 0); __builtin_amdgcn_s_setprio(0); } while (0)
#define PG8_WAIT_V(n) asm volatile("s_waitcnt vmcnt(" #n ")" ::: "memory")
#define PG8_WAIT_L(n) asm volatile("s_waitcnt lgkmcnt(" #n ")" ::: "memory")
#define PG8_BAR __builtin_amdgcn_s_barrier()
#define PG8_SCHED __builtin_amdgcn_sched_barrier(0)
    Unit cur, nxt; int ui = 0;
    if (!S.next(0, cur)) return;
    f32x4 acc[2][2][4][2];
#pragma unroll
    for (int a = 0; a < 2; ++a)
#pragma unroll
        for (int b = 0; b < 2; ++b)
#pragma unroll
            for (int m = 0; m < 4; ++m)
#pragma unroll
                for (int n = 0; n < 2; ++n) acc[a][b][m][n] = (f32x4){0.f, 0.f, 0.f, 0.f};
    bf16x8 At[4][2], B0[2][2], B1[2][2];
    const char* cA = GATHER ? (const char*)g.A : (const char*)g.A + (size_t)cur.pm * tstepA;
    if constexpr (GATHER) PG8_GOFF(0, gc0, gc1);
    const char* cB = (const char*)g.Bt + (size_t)cur.pn * tstepB;
    S.a_ready(cur);
    if constexpr (SP2) {
        PG8_STAGE(PG8_SB(0, 0), cB, voffB); PG8_STAGE(PG8_SB(0, 1), cB + hstepB, voffB); PG8_STA(PG8_SA(0, 0), cA, 0, c); PG8_STA(PG8_SA(0, 1), cA, 1, c);
        if (wr == 1) PG8_BAR;
        PG8_WAIT_V(2); PG8_BAR;
        PG8_STAGE(PG8_SB(1, 0), cB + kstep, voffB); PG8_STA(PG8_SA(1, 0), cA + kstep, 0, c); PG8_STAGE(PG8_SB(1, 1), cB + hstepB + kstep, voffB);
        PG8_WAIT_V(6); PG8_BAR;
    } else {
        PG8_STAGE(PG8_SB(0, 0), cB, voffB); PG8_STA(PG8_SA(0, 0), cA, 0, c); PG8_STAGE(PG8_SB(0, 1), cB + hstepB, voffB); PG8_STA(PG8_SA(0, 1), cA, 1, c);
        if (wr == 1) PG8_BAR;
        PG8_WAIT_V(4); PG8_BAR;
        PG8_STAGE(PG8_SB(1, 0), cB + kstep, voffB); PG8_STA(PG8_SA(1, 0), cA + kstep, 0, c); PG8_STAGE(PG8_SB(1, 1), cB + hstepB + kstep, voffB);
        PG8_WAIT_V(6); PG8_BAR;
    }
    for (;;) {
        const bool has_next = S.next(ui + 1, nxt);
        const char* nA = GATHER ? cA : (has_next ? (const char*)g.A + (size_t)nxt.pm * tstepA : cA);
        if constexpr (GATHER) { if (has_next) PG8_GOFF(ui + 1, gn0, gn1); else { gn0[0] = gc0[0]; gn0[1] = gc0[1]; gn1[0] = gc1[0]; gn1[1] = gc1[1]; } }
        const char* nB = has_next ? (const char*)g.Bt + (size_t)nxt.pn * tstepB : cB;
        for (int t = 0; t < nt; t += 2) {
            const bool last = (t == nt - 2);
            const char* a1 = cA + (size_t)(t + 1) * kstep;
            const char* a2 = last ? nA : cA + (size_t)(t + 2) * kstep; const char* b2 = last ? nB : cB + (size_t)(t + 2) * kstep;
            const char* a3 = a2 + kstep; const char* b3 = b2 + kstep;
            unsigned gx0[2] = {0u, 0u}, gx1[2] = {0u, 0u};
            if constexpr (GATHER) { gx0[0] = last ? gn0[0] : gc0[0]; gx0[1] = last ? gn0[1] : gc0[1]; gx1[0] = last ? gn1[0] : gc1[0]; gx1[1] = last ? gn1[1] : gc1[1]; }
            if (last && has_next) S.a_ready(nxt);
            if constexpr (SP2) {
            PG8_LDB(B0, 0, 0); PG8_LDB(B1, 0, 1); PG8_SCHED; PG8_LDA(At, 0, 0); PG8_STA(PG8_SA(1, 1), a1, 1, c);
            PG8_WAIT_V(8); PG8_WAIT_L(0); PG8_BAR; PG8_MMA(0, 0, At, B0); PG8_MMA(0, 1, At, B1); PG8_BAR; PG8_SCHED;
            PG8_LDA(At, 0, 1); PG8_STAGE(PG8_SB(0, 0), b2, voffB); PG8_STAGE(PG8_SB(0, 1), b2 + hstepB, voffB); PG8_STA(PG8_SA(0, 0), a2, 0, x);
            PG8_WAIT_V(8); PG8_WAIT_L(0); PG8_BAR; PG8_MMA(1, 0, At, B0); PG8_MMA(1, 1, At, B1); PG8_BAR; PG8_SCHED;
            PG8_LDB(B0, 1, 0); PG8_LDB(B1, 1, 1); PG8_SCHED; PG8_LDA(At, 1, 0); PG8_STA(PG8_SA(0, 1), a2, 1, x);
            PG8_WAIT_V(8); PG8_WAIT_L(0); PG8_BAR; PG8_MMA(0, 0, At, B0); PG8_MMA(0, 1, At, B1); PG8_BAR; PG8_SCHED;
            PG8_LDA(At, 1, 1); PG8_STAGE(PG8_SB(1, 0), b3, voffB); PG8_STAGE(PG8_SB(1, 1), b3 + hstepB, voffB); PG8_STA(PG8_SA(1, 0), a3, 0, x);
            PG8_WAIT_V(8); PG8_WAIT_L(0); PG8_BAR; PG8_MMA(1, 0, At, B0); PG8_MMA(1, 1, At, B1); PG8_BAR; PG8_SCHED;
            } else {
            PG8_LDB(B0, 0, 0); PG8_SCHED; PG8_LDA(At, 0, 0); PG8_STA(PG8_SA(1, 1), a1, 1, c);
            PG8_WAIT_L(8); PG8_BAR; PG8_WAIT_L(0); PG8_MMA(0, 0, At, B0); PG8_BAR; PG8_SCHED;
            PG8_LDB(B1, 0, 1); PG8_STAGE(PG8_SB(0, 0), b2, voffB);
            PG8_BAR; PG8_WAIT_L(0); PG8_MMA(0, 1, At, B1); PG8_BAR;
            PG8_LDA(At, 0, 1); PG8_STA(PG8_SA(0, 0), a2, 0, x);
            PG8_BAR; PG8_WAIT_L(0); PG8_MMA(1, 0, At, B0); PG8_BAR; PG8_SCHED;
            PG8_STAGE(PG8_SB(0, 1), b2 + hstepB, voffB);
            PG8_WAIT_V(6); PG8_BAR; PG8_MMA(1, 1, At, B1); PG8_BAR;
            PG8_LDB(B0, 1, 0); PG8_SCHED; PG8_LDA(At, 1, 0); PG8_STA(PG8_SA(0, 1), a2, 1, x);
            PG8_WAIT_L(8); PG8_BAR; PG8_WAIT_L(0); PG8_MMA(0, 0, At, B0); PG8_BAR; PG8_SCHED;
            PG8_LDB(B1, 1, 1); PG8_STAGE(PG8_SB(1, 0), b3, voffB);
            PG8_BAR; PG8_WAIT_L(0); PG8_MMA(0, 1, At, B1); PG8_BAR;
            PG8_LDA(At, 1, 1); PG8_STA(PG8_SA(1, 0), a3, 0, x);
            PG8_BAR; PG8_WAIT_L(0); PG8_MMA(1, 0, At, B0); PG8_BAR; PG8_SCHED;
            PG8_STAGE(PG8_SB(1, 1), b3 + hstepB, voffB);
            PG8_WAIT_V(6); PG8_BAR; PG8_MMA(1, 1, At, B1); PG8_BAR;
            }
        }
        if constexpr (ALIGN_EPI) { if (wr == 0) PG8_BAR; }
        if constexpr (!Epi::AFTER_DRAIN) { E(acc, cur, wr, wc, fr, fq); S.done(cur); }
        if (!has_next) break;
#pragma unroll
        for (int a = 0; a < 2; ++a)
#pragma unroll
            for (int b = 0; b < 2; ++b)
#pragma unroll
                for (int m = 0; m < 4; ++m)
#pragma unroll
                    for (int n = 0; n < 2; ++n) acc[a][b][m][n] = (f32x4){0.f, 0.f, 0.f, 0.f};
        cur = nxt; cA = nA; cB = nB; ++ui;
        if constexpr (GATHER) { gc0[0] = gn0[0]; gc0[1] = gn0[1]; gc1[0] = gn1[0]; gc1[1] = gn1[1]; }
        if constexpr (ALIGN_EPI) { if (wr == 1) PG8_BAR; }
    }
    PG8_WAIT_V(0);
    if constexpr (!ALIGN_EPI) { if (wr == 0) PG8_BAR; }
    PG8_BAR;
    if constexpr (Epi::AFTER_DRAIN) { E.fused(acc, cur, wr, wc, fr, fq, lds, wid, lane); S.done(cur); }
#undef PG8_SA
#undef PG8_SB
#undef PG8_STAGE
#undef PG8_STA
#undef PG8_GOFF
#undef PG8_LDA
#undef PG8_LDB
#undef PG8_MMA
#undef PG8_WAIT_V
#undef PG8_WAIT_L
#undef PG8_BAR
#undef PG8_SCHED
}
}

#define XB_TMO      128
#define XB_XCNT(j)  (256  + 64 * (j))
#define XB_XSUB(j)  (1280 + 64 * (j))
#define XB_XGEN(j)  (2304 + 64 * (j))
#define XB_TOP      3328
#define XB_TOPGEN   3392
#define XCD_BAR_WORDS 3456
#define XB_SPIN_CAP (1u << 24)

__device__ __forceinline__ unsigned xb_ld(unsigned* p)              { return __hip_atomic_load(p, __ATOMIC_RELAXED, __HIP_MEMORY_SCOPE_AGENT); }
__device__ __forceinline__ unsigned xb_add(unsigned* p, unsigned v) { return __hip_atomic_fetch_add(p, v, __ATOMIC_RELAXED, __HIP_MEMORY_SCOPE_AGENT); }
__device__ __forceinline__ unsigned xb_xcc_id() { return (unsigned)__builtin_amdgcn_s_getreg((3 << 11) | 20) & 0xFu; }
#define XB_SPIN(cond, bar) do { unsigned _sp = 0; while (cond) { __builtin_amdgcn_s_sleep(1); \
    if ((++_sp & 255u) == 0u) { if (xb_ld(&(bar)[XB_TMO])) break; if (_sp > XB_SPIN_CAP) { atomicAdd(&(bar)[XB_TMO], 1u); break; } } } } while (0)

struct XcdBarrier {
    unsigned* bar; unsigned x;
    volatile LAS unsigned* st;
};

__device__ __forceinline__ XcdBarrier xcd_barrier_post(unsigned* bar, volatile LAS unsigned* st) {
    XcdBarrier b; b.bar = bar; b.x = xb_xcc_id(); b.st = st;
    if (threadIdx.x == 0) (void)xb_add(&bar[XB_XCNT(b.x)], 1u);
    return b;
}
__device__ __forceinline__ void xcd_barrier_complete(unsigned* bar, unsigned x, unsigned& nloc, unsigned& nx) {
    const unsigned G = gridDim.x * gridDim.y * gridDim.z;
    unsigned sum, cnt, mine, sp = 0u;
    for (;;) {
        sum = 0u; cnt = 0u; mine = 0u;
#pragma unroll
        for (unsigned j = 0; j < 16; ++j) { const unsigned c = xb_ld(&bar[XB_XCNT(j)]); sum += c; cnt += (c > 0u) ? 1u : 0u; mine = (j == x) ? c : mine; }
        if (sum == G) break;
        __builtin_amdgcn_s_sleep(1);
        if ((++sp & 255u) == 0u) { if (xb_ld(&bar[XB_TMO])) break; if (sp > XB_SPIN_CAP) { atomicAdd(&bar[XB_TMO], 1u); break; } }
    }
    nloc = mine > 0u ? mine : 1u; nx = cnt > 0u ? cnt : 1u;
}

__device__ __forceinline__ void xcd_barrier(const XcdBarrier& b) {
    asm volatile("s_waitcnt vmcnt(0)" ::: "memory");
    __syncthreads();
    if (threadIdx.x == 0) {
        unsigned* bar = b.bar;
        __builtin_amdgcn_s_waitcnt(0);
        unsigned nloc = b.st[0], nx = b.st[1];
        if (nloc == 0u) { xcd_barrier_complete(bar, b.x, nloc, nx); b.st[0] = nloc; b.st[1] = nx; }
        const unsigned old = xb_add(&bar[XB_XSUB(b.x)], 1u);
        const unsigned gen = old / nloc;
        if (old + 1u == (gen + 1u) * nloc) {
            __builtin_amdgcn_fence(__ATOMIC_RELEASE, "agent");
            asm volatile("s_waitcnt vmcnt(0)" ::: "memory");
            const unsigned og = xb_add(&bar[XB_TOP], 1u);
            const unsigned tg = og / nx;
            if (og + 1u == (tg + 1u) * nx) xb_add(&bar[XB_TOPGEN], 1u);
            else XB_SPIN(xb_ld(&bar[XB_TOPGEN]) == tg, bar);
            __builtin_amdgcn_fence(__ATOMIC_ACQUIRE, "agent");
            xb_add(&bar[XB_XGEN(b.x)], 1u);
            asm volatile("s_waitcnt vmcnt(0)" ::: "memory");
        } else {
            XB_SPIN(xb_ld(&bar[XB_XGEN(b.x)]) == gen, bar);
            __builtin_amdgcn_fence(__ATOMIC_ACQUIRE, "agent");
            asm volatile("s_waitcnt vmcnt(0)" ::: "memory");
        }
    }
    __syncthreads();
}
struct Args { const float* in[33]; float* out; unsigned char* ws; int ph_lo, ph_hi; };
enum { I_X = 0, I_C, I_CTX, I_CCTX, I_ADAW, I_ADAB, I_NMIXG, I_NFFNG, I_EVWIN, I_EVWOUT, I_LAMRE, I_LAMIM, I_LOGSTEP, I_BRE, I_BIM, I_CRE, I_CIM, I_S5D, I_GLUW, I_GLUB,
       I_SINK, I_ODWIN, I_ODWOUT, I_LQ1, I_LK1, I_LQ2, I_LK2, I_SUBLN, I_ROUTER, I_WGATE, I_WUP, I_WDOWN, I_FINALG };

DI void p0_ada_item(const Args& a, LAS unsigned char* lds, int item) {
    const int tid = threadIdx.x, lane = tid & 63, wave = tid >> 6;
    const int l = item / 96, j0 = (item % 96) * 64;
    LAS float* sc = (LAS float*)lds;
    LAS float* red = (LAS float*)(lds + 9 * 1024 * 4);
    for (int i = tid; i < 9 * 1024; i += NTHREADS) {
        const int r = i >> 10, k = i & 1023;
        const float v = (r < 8) ? a.in[I_C][r * 1024 + k] : a.in[I_CCTX][k];
        sc[i] = v / (1.0f + __expf(-v));
    }
    __syncthreads();
    float acc[9];
#pragma unroll
    for (int r = 0; r < 9; ++r) acc[r] = 0.f;
    const float* W = a.in[I_ADAW] + (size_t)l * 1024 * 6144 + j0 + lane;
    const int k0 = wave * 128;
#pragma unroll 1
    for (int kb = 0; kb < 128; kb += 32) {
        float w[32];
#pragma unroll
        for (int i = 0; i < 32; ++i) w[i] = __builtin_nontemporal_load(W + (size_t)(k0 + kb + i) * 6144);
#pragma unroll
        for (int i = 0; i < 32; ++i)
#pragma unroll
            for (int r = 0; r < 9; ++r) acc[r] += sc[r * 1024 + k0 + kb + i] * w[i];
    }
#pragma unroll
    for (int r = 0; r < 9; ++r) red[(wave * 9 + r) * 64 + lane] = acc[r];
    __syncthreads();
    for (int i = tid; i < 9 * 64; i += NTHREADS) {
        const int r = i >> 6, jj = i & 63; float s = 0.f;
#pragma unroll
        for (int w = 0; w < 8; ++w) s += red[(w * 9 + r) * 64 + jj];
        ((float*)(a.ws + WS_MOD))[(size_t)(l * 9 + r) * 6144 + j0 + jj] = s + a.in[I_ADAB][l * 6144 + j0 + jj];
    }
    __syncthreads();
}
DI void p0_rope(const Args& a) {
    for (int i = threadIdx.x; i < 1024; i += NTHREADS) {
        const int pos = i >> 4, fi = i & 15;
        const float inv = powf(10000.0f, -(float)fi / 16.0f);
        const float ang = (float)pos * inv;
        ((float*)(a.ws + WS_ROPE))[2 * i] = cosf(ang); ((float*)(a.ws + WS_ROPE))[2 * i + 1] = sinf(ang);
    }
}
DI void p0_s5_item(const Args& a, LAS unsigned char* lds, int item) {
    const int tid = threadIdx.x, g = item >> 1, dir = item & 1;
    LAS float* apr = (LAS float*)lds;
    LAS float* api = apr + 33 * 64;
    LAS float* bbr = api + 33 * 64;
    LAS float* bbi = bbr + 1024;
    LAS float* ccr = bbi + 1024;
    LAS float* cci = ccr + 1024;
    const int gp = (dir * S5G + g) * S5P;
    const float dt = __expf(a.in[I_LOGSTEP][dir * S5G + g]);
    for (int i = tid; i < 33 * 64; i += NTHREADS) {
        const int j = i >> 6, p = i & 63;
        const float lr = a.in[I_LAMRE][gp + p], li = a.in[I_LAMIM][gp + p];
        const float mag = expf((float)j * lr * dt), ang = (float)j * li * dt;
        apr[i] = mag * cosf(ang); api[i] = mag * sinf(ang);
    }
    for (int i = tid; i < 1024; i += NTHREADS) {
        const int p = i >> 4;
        const float lr = a.in[I_LAMRE][gp + p], li = a.in[I_LAMIM][gp + p];
        const float mag = expf(lr * dt), are = mag * cosf(li * dt), aim = mag * sinf(li * dt);
        const float den = lr * lr + li * li;
        const float fre = ((are - 1.0f) * lr + aim * li) / den, fim = (aim * lr - (are - 1.0f) * li) / den;
        const float br = a.in[I_BRE][(size_t)gp * 16 + i], bi = a.in[I_BIM][(size_t)gp * 16 + i];
        bbr[i] = fre * br - fim * bi; bbi[i] = fre * bi + fim * br;
        ccr[i] = a.in[I_CRE][(size_t)(dir * S5G + g) * 1024 + i]; cci[i] = a.in[I_CIM][(size_t)(dir * S5G + g) * 1024 + i];
    }
    __syncthreads();
    if (tid < 64) { float* ap = (float*)(a.ws + WS_APOW) + ((g * 2 + dir) * 64 + tid) * 2; ap[0] = apr[32 * 64 + tid]; ap[1] = api[32 * 64 + tid]; }
    {
        const int c = (tid >> 4) & 15, h = tid & 15, jh = tid >> 8;
        float cbr[64], cbi[64];
#pragma unroll
        for (int p = 0; p < 64; ++p) { const float cr = ccr[c * 64 + p], ci = cci[c * 64 + p], br = bbr[p * 16 + h], bi = bbi[p * 16 + h]; cbr[p] = cr * br - ci * bi; cbi[p] = cr * bi + ci * br; }
        float* kt = (float*)(a.ws + WS_KTAB) + (size_t)(g * 2 + dir) * 32 * 256;
        for (int j = jh * 16; j < jh * 16 + 16; ++j) {
            float s = 0.f;
#pragma unroll
            for (int p = 0; p < 64; p += 4) {
                const f32x4 ar = *(const LAS f32x4*)(apr + j * 64 + p), ai = *(const LAS f32x4*)(api + j * 64 + p);
#pragma unroll
                for (int q = 0; q < 4; ++q) s += cbr[p + q] * ar[q] - cbi[p + q] * ai[q];
            }
            kt[j * 256 + c * 16 + h] = s;
        }
    }
    bf16_t* bta = (bf16_t*)(a.ws + OV_BTA) + (size_t)g * 256 * 512;
    for (int i = tid; i < 128 * 256; i += NTHREADS) {
        const int row = i >> 8, cp = i & 255, ri = row >> 6, p = row & 63, s = cp >> 3, h = (cp & 7) * 2;
        const int e = dir ? s : 31 - s;
        const float pr = apr[e * 64 + p], pi = api[e * 64 + p];
        float v0, v1;
        if (ri == 0) { v0 = pr * bbr[p * 16 + h] - pi * bbi[p * 16 + h]; v1 = pr * bbr[p * 16 + h + 1] - pi * bbi[p * 16 + h + 1]; }
        else         { v0 = pr * bbi[p * 16 + h] + pi * bbr[p * 16 + h]; v1 = pr * bbi[p * 16 + h + 1] + pi * bbr[p * 16 + h + 1]; }
        *(unsigned*)(bta + (size_t)(dir * 128 + row) * 512 + s * 16 + h) = pk2(v0, v1);
    }
    bf16_t* btc = (bf16_t*)(a.ws + OV_BTC) + (size_t)g * 512 * S5_KC;
    for (int i = tid; i < 512 * 64; i += NTHREADS) {
        const int row = i >> 6, cp = i & 63, ri = cp >> 5, p = (cp & 31) * 2, t = row >> 4, c = row & 15;
        const int f = dir ? 32 - t : t + 1;
        float v[2];
#pragma unroll
        for (int q = 0; q < 2; ++q) {
            const float cr = ccr[c * 64 + p + q], ci = cci[c * 64 + p + q], pr = apr[f * 64 + p + q], pi = api[f * 64 + p + q];
            v[q] = ri == 0 ? (cr * pr - ci * pi) : -(cr * pi + ci * pr);
        }
        *(unsigned*)(btc + (size_t)row * S5_KC + 512 + dir * 128 + ri * 64 + p) = pk2(v[0], v[1]);
    }
    __syncthreads();
}
DI void p0_conv_item(const float* W, int K, int N, bf16_t* WT, int mode, int sel, int kb, int nb, int lane, LAS unsigned* scr) {
    const int nq = lane & 15, kq = lane >> 4;
    const float* src = W + (size_t)(kb * 64 + kq * 2) * N + nb * 64 + nq * 4;
    f32x4 v[16];
#pragma unroll
    for (int i = 0; i < 8; ++i) { v[2 * i] = *(const f32x4*)(src + (size_t)(i * 8) * N); v[2 * i + 1] = *(const f32x4*)(src + (size_t)(i * 8 + 1) * N); }
#pragma unroll
    for (int i = 0; i < 8; ++i)
#pragma unroll
        for (int j = 0; j < 4; ++j) scr[(nq * 4 + j) * 32 + ((i ^ (nq & 7)) << 2) + kq] = pk2(v[2 * i][j], v[2 * i + 1][j]);
#pragma unroll
    for (int r = 0; r < 8; ++r) {
        const int n = (lane >> 3) + 8 * r, c = lane & 7;
        const u32x4 d = *(const LAS u32x4*)(scr + n * 32 + ((c ^ ((n >> 2) & 7)) << 2));
        const int ng = nb * 64 + n;
        const int row = mode == 1 ? ((ng >> 7) * 256 + sel * 128 + (ng & 127)) : ng;
        *(u32x4*)(WT + (size_t)row * K + kb * 64 + c * 8) = d;
    }
}
constexpr int POOL_ITEMS = 16 * 1536;
constexpr int CW_PHDONE = 8704;
struct ConvItem { const float* W; bf16_t* WT; int K, N, mode, sel, kb, nb; };
DI ConvItem conv_decode(const Args& a, int pool, int item) {
    ConvItem c; const int le = pool * 16 + item / 1536; int r = item % 1536;
    if (r < 512) { c.W = a.in[I_WGATE] + (size_t)le * 1024 * 2048; c.WT = (bf16_t*)(a.ws + WS_W1T) + (size_t)le * 4096 * 1024; c.K = 1024; c.N = 2048; c.mode = 1; c.sel = 0; c.kb = r / 32; c.nb = r % 32; }
    else if (r < 1024) { r -= 512; c.W = a.in[I_WUP] + (size_t)le * 1024 * 2048; c.WT = (bf16_t*)(a.ws + WS_W1T) + (size_t)le * 4096 * 1024; c.K = 1024; c.N = 2048; c.mode = 1; c.sel = 1; c.kb = r / 32; c.nb = r % 32; }
    else { r -= 1024; c.W = a.in[I_WDOWN] + (size_t)le * 2048 * 1024; c.WT = (bf16_t*)(a.ws + WS_W2T) + (size_t)le * 1024 * 2048; c.K = 2048; c.N = 1024; c.mode = 0; c.sel = 0; c.kb = r / 16; c.nb = r % 16; }
    return c;
}
DI void conv_load(const ConvItem& c, int lane, f32x4 (&v)[16]) {
    const int nq = lane & 15, kq = lane >> 4;
    const float* src = c.W + (size_t)(c.kb * 64 + kq * 2) * c.N + c.nb * 64 + nq * 4;
#pragma unroll
    for (int i = 0; i < 8; ++i) { v[2 * i] = __builtin_nontemporal_load((const f32x4*)(src + (size_t)(i * 8) * c.N)); v[2 * i + 1] = __builtin_nontemporal_load((const f32x4*)(src + (size_t)(i * 8 + 1) * c.N)); }
}
DI void conv_store(const ConvItem& c, int lane, const f32x4 (&v)[16], LAS unsigned* scr) {
    const int nq = lane & 15, kq = lane >> 4;
#pragma unroll
    for (int i = 0; i < 8; ++i)
#pragma unroll
        for (int j = 0; j < 4; ++j) scr[(nq * 4 + j) * 32 + ((i ^ (nq & 7)) << 2) + kq] = pk2(v[2 * i][j], v[2 * i + 1][j]);
#pragma unroll
    for (int r = 0; r < 8; ++r) {
        const int n = (lane >> 3) + 8 * r, cc = lane & 7;
        const u32x4 d = *(const LAS u32x4*)(scr + n * 32 + ((cc ^ ((n >> 2) & 7)) << 2));
        const int ng = c.nb * 64 + n;
        const int row = c.mode == 1 ? ((ng >> 7) * 256 + c.sel * 128 + (ng & 127)) : ng;
        __builtin_nontemporal_store(d, (u32x4*)(c.WT + (size_t)row * c.K + c.kb * 64 + cc * 8));
    }
}
DI void steal_conv(const Args& a, LAS unsigned char* lds, int G, int phase, int last_pool, bool opportunistic, int& pos) {
    const int tid = threadIdx.x, lane = tid & 63, wave = __builtin_amdgcn_readfirstlane(tid >> 6);
    unsigned* ctl = (unsigned*)(a.ws + WS_CTL);
    LAS unsigned* scr = (LAS unsigned*)(lds + wave * 8192);
    const int NGW = G * NWAVES, ppw = (POOL_ITEMS + NGW - 1) / NGW;
    const int gw = blockIdx.x * NWAVES + wave, end = (last_pool + 1) * ppw;
    __syncthreads();
    if (tid == 0 && opportunistic) __hip_atomic_fetch_add(ctl + CW_PHDONE + 64 * phase, 1u, __ATOMIC_RELAXED, __HIP_MEMORY_SCOPE_AGENT);
#define CONV_MORE() (pos < end && (!opportunistic || (unsigned)__builtin_amdgcn_readfirstlane((int)__hip_atomic_load(ctl + CW_PHDONE + 64 * phase, __ATOMIC_RELAXED, __HIP_MEMORY_SCOPE_AGENT)) < (unsigned)G))
#define CONV_NEXT(c, ok) do { const int it_ = ((int)blockIdx.x * ppw + (pos % ppw)) * NWAVES + wave; ok = it_ < POOL_ITEMS; c = conv_decode(a, pos / ppw, ok ? it_ : 0); ++pos; } while (0)
    if (CONV_MORE()) {
        ConvItem ca, cb; f32x4 va[16], vb[16]; bool oka, okb;
        CONV_NEXT(ca, oka); if (oka) conv_load(ca, lane, va);
        for (;;) {
            okb = false; const bool moreb = CONV_MORE();
            if (moreb) { CONV_NEXT(cb, okb); if (okb) conv_load(cb, lane, vb); }
            if (oka) conv_store(ca, lane, va, scr);
            if (!moreb) break;
            oka = false; const bool morea = CONV_MORE();
            if (morea) { CONV_NEXT(ca, oka); if (oka) conv_load(ca, lane, va); }
            if (okb) conv_store(cb, lane, vb, scr);
            if (!morea) break;
        }
    }
#undef CONV_MORE
#undef CONV_NEXT
    __syncthreads();
}
DI void p0_phase(const Args& a, LAS unsigned char* lds, int G) {
    const int tid = threadIdx.x, lane = tid & 63, wave = __builtin_amdgcn_readfirstlane(tid >> 6);
    for (int it = blockIdx.x; it < 193; it += G) {
        if (it < 192) p0_ada_item(a, lds, it);
        else p0_rope(a);
    }
    __syncthreads();
    const int gw = blockIdx.x * NWAVES + wave, NGW = G * NWAVES;
    LAS unsigned* scr = (LAS unsigned*)(lds + wave * 8192);
    constexpr int I_IN0 = 16 * 20, I_GLU = 8 * 8, I_OUT0 = 16 * 16, I_IN1 = 16 * 48, I_OUT1 = 16 * 16, NITEMS = I_IN0 + I_GLU + I_OUT0 + I_IN1 + I_OUT1;
    for (int it = gw; it < NITEMS; it += NGW) {
        int r = it;
        if (r < I_IN0) { p0_conv_item(a.in[I_EVWIN], 1024, 1280, (bf16_t*)(a.ws + WS_WIN0T), 0, 0, r / 20, r % 20, lane, scr); continue; } r -= I_IN0;
        if (r < I_GLU) { p0_conv_item(a.in[I_GLUW], 512, 512, (bf16_t*)(a.ws + WS_WGLUT), 0, 0, r / 8, r % 8, lane, scr); continue; } r -= I_GLU;
        if (r < I_OUT0) { p0_conv_item(a.in[I_EVWOUT], 1024, 1024, (bf16_t*)(a.ws + WS_WOUT0T), 0, 0, r / 16, r % 16, lane, scr); continue; } r -= I_OUT0;
        if (r < I_IN1) { p0_conv_item(a.in[I_ODWIN], 1024, 3072, (bf16_t*)(a.ws + WS_WIN1T), 0, 0, r / 48, r % 48, lane, scr); continue; } r -= I_IN1;
        p0_conv_item(a.in[I_ODWOUT], 1024, 1024, (bf16_t*)(a.ws + WS_WOUT1T), 0, 0, r / 16, r % 16, lane, scr);
    }
}
DI const float* mod_ptr(const Args& a, int layer, int row) {
    const int r = row < ROWS_L ? (row >> 11) : 8;
    return (const float*)(a.ws + WS_MOD) + (size_t)(layer * 9 + r) * 6144;
}
DI f32x4 ld_bf16x4(const bf16_t* p);
DI void load_row_bf16(const bf16_t* p, int lane, f32x4 (&v)[4]) {
#pragma unroll
    for (int j = 0; j < 4; ++j) v[j] = ld_bf16x4(p + lane * 4 + 256 * j);
}
DI void load_row(const float* p, int lane, f32x4 (&v)[4]) {
#pragma unroll
    for (int j = 0; j < 4; ++j) v[j] = *(const f32x4*)(p + lane * 4 + 256 * j);
}
DI float row_rstd(const f32x4 (&v)[4]) {
    float s = 0.f;
#pragma unroll
    for (int j = 0; j < 4; ++j) s += (v[j].x * v[j].x + v[j].y * v[j].y) + (v[j].z * v[j].z + v[j].w * v[j].w);
    return 1.0f / sqrtf(wave_sum(s) * (1.0f / 1024.0f) + NORM_EPS);
}
DI void norm_mod(f32x4 (&v)[4], const float* g, const float* shift, const float* scale, int lane) {
    const float rs = row_rstd(v);
#pragma unroll
    for (int j = 0; j < 4; ++j) {
        const f32x4 gg = *(const f32x4*)(g + lane * 4 + 256 * j), sh = *(const f32x4*)(shift + lane * 4 + 256 * j), sc = *(const f32x4*)(scale + lane * 4 + 256 * j);
        v[j] = (v[j] * rs) * gg * (sc + 1.0f) + sh;
    }
}
DI void store_row_bf16(bf16_t* p, int lane, const f32x4 (&v)[4]) {
#pragma unroll
    for (int j = 0; j < 4; ++j) { u32x2 w; w.x = pk2(v[j].x, v[j].y); w.y = pk2(v[j].z, v[j].w); *(u32x2*)(p + lane * 4 + 256 * j) = w; }
}
DI float rt_xhalf(float v) {
    const unsigned u = __builtin_bit_cast(unsigned, v);
    auto r = __builtin_amdgcn_permlane32_swap(u, u, false, false);
    return __builtin_bit_cast(float, (threadIdx.x & 32) ? r[0] : r[1]);
}
template <int X> DI float rt_xswz(float v) {
    return __builtin_bit_cast(float, __builtin_amdgcn_ds_swizzle(__builtin_bit_cast(int, v), (X << 10) | 0x1f));
}
DI void router_fill(const Args& a, LAS float* ldsw, int layer) {
    const float* wr = a.in[I_ROUTER] + (size_t)layer * 1024 * 16;
    for (int i = threadIdx.x; i < 16384; i += NTHREADS) ldsw[(i & 15) * 1024 + (i >> 4)] = wr[i];
    __syncthreads();
}
DI void router_row(const Args& a, const LAS float* ldsw, int row, const f32x4 (&v)[4], int lane) {
    float lg[16];
    {
        f32x2 acc2[16];
#pragma unroll
        for (int e = 0; e < 16; ++e) acc2[e] = (f32x2){0.f, 0.f};
#pragma unroll
        for (int j = 0; j < 4; ++j) {
            const f32x2 vlo = {v[j].x, v[j].y}, vhi = {v[j].z, v[j].w};
            f32x4 w[16];
#pragma unroll
            for (int e = 0; e < 16; ++e) w[e] = *(const LAS f32x4*)(ldsw + e * 1024 + lane * 4 + 256 * j);
#pragma unroll
            for (int e = 0; e < 16; ++e) { acc2[e] += vlo * (f32x2){w[e].x, w[e].y}; acc2[e] += vhi * (f32x2){w[e].z, w[e].w}; }
            __builtin_amdgcn_sched_barrier(0);
        }
#pragma unroll
        for (int e = 0; e < 16; ++e) lg[e] = acc2[e].x + acc2[e].y;
    }
    const bool b5 = lane & 32, b4 = lane & 16, b3 = lane & 8, b2 = lane & 4;
    float k8[8], k4[4], k2[2];
#pragma unroll
    for (int i = 0; i < 8; ++i) { const float snd = b5 ? lg[i] : lg[i + 8]; k8[i] = (b5 ? lg[i + 8] : lg[i]) + rt_xhalf(snd); }
#pragma unroll
    for (int i = 0; i < 4; ++i) { const float snd = b4 ? k8[i] : k8[i + 4]; k4[i] = (b4 ? k8[i + 4] : k8[i]) + rt_xswz<16>(snd); }
#pragma unroll
    for (int i = 0; i < 2; ++i) { const float snd = b3 ? k4[i] : k4[i + 2]; k2[i] = (b3 ? k4[i + 2] : k4[i]) + rt_xswz<8>(snd); }
    float tot = (b2 ? k2[1] : k2[0]) + rt_xswz<4>(b2 ? k2[0] : k2[1]);
    tot += rt_xswz<1>(tot); tot += rt_xswz<2>(tot);
    float mx = fmaxf(tot, rt_xswz<4>(tot)); mx = fmaxf(mx, rt_xswz<8>(mx)); mx = fmaxf(mx, rt_xswz<16>(mx)); mx = fmaxf(mx, rt_xhalf(mx));
    const float ex = expf(tot - mx);
    float den = ex + rt_xswz<4>(ex); den += rt_xswz<8>(den); den += rt_xswz<16>(den); den += rt_xhalf(den);
    const float mine = ex / den;
    const int e = (lane >> 2) & 15;
    if ((lane & 3) == 0) {
        if (row < ROWS_L) ((float*)(a.ws + WS_AFFL))[((size_t)(row >> 11) * 16 + e) * NL + (row & 2047)] = mine;
        else { const int rc = row - ROWS_L; ((float*)(a.ws + WS_AFFC))[((size_t)(rc >> 8) * 16 + e) * NC + (rc & 255)] = mine; }
    }
}
DI void toeplitz_fill(const Args& a, int wv, int nwv, int lane) {
    for (int it = wv; it < S5G * 32; it += nwv) {
        const int g = it >> 5, t = it & 31;
        const float* kf = (const float*)(a.ws + WS_KTAB) + (size_t)(g * 2 + 0) * 32 * 256;
        const float* kr = kf + 32 * 256;
        bf16_t* base = (bf16_t*)(a.ws + OV_BTC) + ((size_t)g * 512 + t * 16) * S5_KC;
#pragma unroll
        for (int q = 0; q < 2; ++q) {
            const int col = q * 256 + lane * 4, s = col >> 4, h0 = col & 15;
            const float mf = s <= t ? 1.f : 0.f, mr = s >= t ? 1.f : 0.f;
            const float* pf = kf + (s <= t ? t - s : 0) * 256 + h0; const float* pr = kr + (s >= t ? s - t : 0) * 256 + h0;
#pragma unroll 8
            for (int c = 0; c < 16; ++c) {
                const f32x4 v = *(const f32x4*)(pf + c * 16) * mf + *(const f32x4*)(pr + c * 16) * mr;
                u32x2 w; w.x = pk2(v.x, v.y); w.y = pk2(v.z, v.w);
                *(u32x2*)(base + (size_t)c * S5_KC + col) = w;
            }
        }
    }
}
DI void p1_phase(const Args& a, LAS unsigned char* lds, int G) {
    const int tid = threadIdx.x, lane = tid & 63, wave = __builtin_amdgcn_readfirstlane(tid >> 6);
    const int ntab = G > 128 ? 64 : 0;
    for (int it = blockIdx.x; it < 64; it += (ntab ? 64 : G)) { if (ntab && (int)blockIdx.x >= ntab) break; p0_s5_item(a, lds, it); }
    if ((int)blockIdx.x < ntab) return;
    const int gw = ((int)blockIdx.x - ntab) * NWAVES + wave, NGW = (G - ntab) * NWAVES;
    f32x4 vn[4];
    if (gw < ROWS) load_row(gw < ROWS_L ? a.in[I_X] + (size_t)gw * DM : a.in[I_CTX] + (size_t)(gw - ROWS_L) * DM, lane, vn);
    for (int row = gw; row < ROWS; row += NGW) {
        f32x4 v[4];
#pragma unroll
        for (int j = 0; j < 4; ++j) v[j] = vn[j];
        const int nr = row + NGW;
        if (nr < ROWS) load_row(nr < ROWS_L ? a.in[I_X] + (size_t)nr * DM : a.in[I_CTX] + (size_t)(nr - ROWS_L) * DM, lane, vn);
        const float* md = mod_ptr(a, 0, row);
        norm_mod(v, a.in[I_NMIXG], md, md + 1024, lane);
        store_row_bf16((bf16_t*)(a.ws + WS_HX) + (size_t)row * DM, lane, v);
    }
}
DI void pnorm_router_phase(const Args& a, LAS unsigned char* lds, int G, int layer, int nrows) {
    const int tid = threadIdx.x, lane = tid & 63, wave = __builtin_amdgcn_readfirstlane(tid >> 6);
    const int gw = blockIdx.x * NWAVES + wave, NGW = G * NWAVES;
    LAS float* ldsw = (LAS float*)lds; router_fill(a, ldsw, layer);
    for (int row = gw; row < nrows; row += NGW) {
        f32x4 v[4]; load_row_bf16((const bf16_t*)(a.ws + WS_XS) + (size_t)row * DM, lane, v);
        const float* md = mod_ptr(a, layer, row);
        norm_mod(v, a.in[I_NFFNG] + layer * 1024, md + 3 * 1024, md + 4 * 1024, lane);
        store_row_bf16((bf16_t*)(a.ws + WS_HX) + (size_t)row * DM, lane, v);
        router_row(a, ldsw, row, v, lane);
    }
}
DI f32x4 ld_bf16x4(const bf16_t* p);
DI void pcombine_phase(const Args& a, int G, int layer, int nrows, int mrows) {
    const bool tails = false;
    const int tid = threadIdx.x, lane = tid & 63, wave = __builtin_amdgcn_readfirstlane(tid >> 6);
    const int gw = blockIdx.x * NWAVES + wave, NGW = G * NWAVES;
    const bf16_t* yb = (const bf16_t*)(a.ws + OV_YB);
    for (int row = gw; row < nrows; row += NGW) {
        bf16_t* xr = (bf16_t*)(a.ws + WS_XS) + (size_t)row * DM;
        f32x4 v[4]; load_row_bf16(xr, lane, v);
        f32x4 acc[4];
#pragma unroll
        for (int j = 0; j < 4; ++j) acc[j] = (f32x4){0.f, 0.f, 0.f, 0.f};
        const int* ts = (const int*)(a.ws + WS_TOKSLOT) + (size_t)row * 16;
        const int myslot = lane < 16 ? ts[lane] : -1;
        unsigned msk = (unsigned)__ballot(myslot >= 0);
        while (msk) {
            const int e0 = __builtin_ctz(msk); msk &= msk - 1;
            const int e1 = msk ? __builtin_ctz(msk) : e0; const bool two = msk != 0; msk &= msk - 1;
            const int s0 = __builtin_amdgcn_readlane(myslot, e0), s1 = __builtin_amdgcn_readlane(myslot, e1);
            const bf16_t* y0 = yb + ((size_t)e0 * mrows + s0) * DM; const bf16_t* y1 = yb + ((size_t)e1 * mrows + s1) * DM;
            u32x2 w0[4], w1[4];
#pragma unroll
            for (int j = 0; j < 3; ++j) { w0[j] = *(const u32x2*)(y0 + lane * 4 + 256 * j); w1[j] = *(const u32x2*)(y1 + lane * 4 + 256 * j); }
            const bool t0 = tails && (e0 & 1) && s0 >= 256, t1 = tails && (e1 & 1) && s1 >= 256;
            const float f1 = two ? 1.f : 0.f;
            if (!t0) w0[3] = *(const u32x2*)(y0 + lane * 4 + 768);
            if (!t1) w1[3] = *(const u32x2*)(y1 + lane * 4 + 768);
            if (t0 || t1) {
                const bf16_t* ybs = (const bf16_t*)(a.ws + OV_YBS);
                f32x4 ex = {0.f, 0.f, 0.f, 0.f};
                if (t0) { const int ss = (e0 >> 1) * 8 + (s0 >> 8) - 1;
#pragma unroll
                    for (int q = 0; q < 4; ++q) ex += ld_bf16x4(ybs + ((size_t)(q * 64 + ss) * 256 + (s0 & 255)) * 256 + lane * 4); w0[3] = (u32x2){0u, 0u}; }
                if (t1) { const int ss = (e1 >> 1) * 8 + (s1 >> 8) - 1;
#pragma unroll
                    for (int q = 0; q < 4; ++q) ex += ld_bf16x4(ybs + ((size_t)(q * 64 + ss) * 256 + (s1 & 255)) * 256 + lane * 4) * f1; w1[3] = (u32x2){0u, 0u}; }
                acc[3] += ex;
            }
#pragma unroll
            for (int j = 0; j < 4; ++j) {
                acc[j].x += bflo(w0[j].x) + f1 * bflo(w1[j].x); acc[j].y += bfhi(w0[j].x) + f1 * bfhi(w1[j].x);
                acc[j].z += bflo(w0[j].y) + f1 * bflo(w1[j].y); acc[j].w += bfhi(w0[j].y) + f1 * bfhi(w1[j].y);
            }
        }
        const float* md = mod_ptr(a, layer, row);
#pragma unroll
        for (int j = 0; j < 4; ++j) v[j] += *(const f32x4*)(md + 5 * 1024 + lane * 4 + 256 * j) * acc[j];
        if (layer == 0) {
            store_row_bf16(xr, lane, v);
            const float* m1 = mod_ptr(a, 1, row);
            norm_mod(v, a.in[I_NMIXG] + 1024, m1, m1 + 1024, lane);
            store_row_bf16((bf16_t*)(a.ws + WS_HX) + (size_t)row * DM, lane, v);
        } else {
            const float rs = row_rstd(v);
#pragma unroll
            for (int j = 0; j < 4; ++j) *(f32x4*)(a.out + (size_t)row * DM + lane * 4 + 256 * j) = (v[j] * rs) * *(const f32x4*)(a.in[I_FINALG] + lane * 4 + 256 * j);
        }
    }
}
DI void ptopk_phase(const Args& a, LAS unsigned char* lds, int G, int with_ctx, int mrows) {
    const int tid = threadIdx.x, lane = tid & 63, wave = __builtin_amdgcn_readfirstlane(tid >> 6);
    LAS int* hist = (LAS int*)lds;
    LAS int* st = (LAS int*)(lds + 1024);
    LAS int* wsum = (LAS int*)(lds + 1024 + 32);
    LAS unsigned* wtot = (LAS unsigned*)(lds + 1024 + 64);
    LAS int* list = (LAS int*)(lds + 2048);
    const int nitems = with_ctx ? 256 : 128;
    for (int it = blockIdx.x; it < nitems; it += G) {
        const bool lat = it < 128;
        const int r = lat ? it : it - 128, b = r >> 4, e = r & 15, n = lat ? NL : NC, cap = lat ? CAP_L : CAP_C;
        const float* src = lat ? (const float*)(a.ws + WS_AFFL) + ((size_t)b * 16 + e) * NL : (const float*)(a.ws + WS_AFFC) + ((size_t)b * 16 + e) * NC;
        const bool valid = tid * 4 < n;
        u32x4 key = {0u, 0u, 0u, 0u};
        if (valid) key = *(const u32x4*)(src + tid * 4);
        unsigned prefix = 0u; int remaining = cap;
#pragma unroll
        for (int pass = 0; pass < 4; ++pass) {
            const int shift = 24 - 8 * pass;
            if (tid < 256) hist[tid] = 0;
            __syncthreads();
            if (valid) {
#pragma unroll
                for (int i = 0; i < 4; ++i)
                    if (pass == 0 || (key[i] >> (shift + 8)) == prefix) __hip_atomic_fetch_add(&hist[(key[i] >> shift) & 255u], 1, __ATOMIC_RELAXED, __HIP_MEMORY_SCOPE_WORKGROUP);
            }
            __syncthreads();
            {
                const int mine = tid < 256 ? hist[tid] : 0;
                int sfx = mine;
#pragma unroll
                for (int o = 1; o < 64; o <<= 1) { const int y = __shfl_down(sfx, o); if (lane + o < 64) sfx += y; }
                if (tid < 256 && lane == 0) wsum[wave] = sfx;
                __syncthreads();
                if (tid < 256) {
                    int above = sfx - mine;
                    for (int w = wave + 1; w < 4; ++w) above += wsum[w];
                    if (above < remaining && remaining <= above + mine) { st[0] = tid; st[1] = remaining - above; }
                }
            }
            __syncthreads();
            prefix = (prefix << 8) | (unsigned)st[0]; remaining = st[1];
        }
        const unsigned T = prefix; const int req = remaining;
        unsigned cnt = 0u;
#pragma unroll
        for (int i = 0; i < 4; ++i) cnt += (valid && key[i] > T ? 1u : 0u) + (valid && key[i] == T ? 0x10000u : 0u);
        unsigned inc = cnt;
#pragma unroll
        for (int o = 1; o < 64; o <<= 1) { const unsigned y = __shfl_up(inc, o); if (lane >= o) inc += y; }
        if (lane == 63) wtot[wave] = inc;
        __syncthreads();
        unsigned off = inc - cnt;
        for (int w = 0; w < wave; ++w) off += wtot[w];
        int gtp = (int)(off & 0xffffu), eqp = (int)(off >> 16);
        if (valid) {
#pragma unroll
            for (int i = 0; i < 4; ++i) {
                const unsigned kv = key[i];
                const bool gt = kv > T, eq = kv == T;
                const bool sel = gt || (eq && eqp < req);
                const int t = tid * 4 + i, trow = lat ? b * NL + t : ROWS_L + b * NC + t;
                int erow = -1;
                if (sel) {
                    const int slot = gtp + (eqp < req ? eqp : req);
                    erow = lat ? b * CAP_L + slot : NB * CAP_L + b * CAP_C + slot;
                    ((float*)(a.ws + WS_GATE))[(size_t)e * mrows + erow] = __uint_as_float(kv);
                    list[slot] = trow;
                }
                ((int*)(a.ws + WS_TOKSLOT))[(size_t)trow * 16 + e] = erow;
                gtp += gt ? 1 : 0; eqp += eq ? 1 : 0;
            }
        }
        __syncthreads();
        const int ebase = lat ? b * CAP_L : NB * CAP_L + b * CAP_C;
        if (tid < cap) ((int*)(a.ws + WS_SELROW))[(size_t)e * mrows + ebase + tid] = list[tid];
        __syncthreads();
    }
}
DI void ps5_rec_phase(const Args& a, int G) {
    if (threadIdx.x >= 128) return;
    for (int it = blockIdx.x; it < 256; it += G) {
        const int gid = it * 128 + threadIdx.x;
        const int p = gid & 63, dir = (gid >> 6) & 1, b = (gid >> 7) & 7, g = gid >> 10;
        const float* ap = (const float*)(a.ws + WS_APOW) + ((g * 2 + dir) * 64 + p) * 2;
        const float ar = ap[0], ai = ap[1];
        const float* S = (const float*)(a.ws + OV_S) + (size_t)g * S5_MROWS * 256 + dir * 128 + p;
        bf16_t* H = (bf16_t*)(a.ws + OV_AS5) + (size_t)g * S5_MROWS * S5_KC + 512 + dir * 128 + p;
        float sr = 0.f, si = 0.f;
#pragma unroll 1
        for (int kh = 0; kh < 72; kh += 24) {
            float cr[24], ci[24];
#pragma unroll
            for (int kk = 0; kk < 24; ++kk) {
                const int k = kh + kk;
                const int row = dir == 0 ? (k < 8 ? 512 + b * 8 + k : b * 64 + (k - 8)) : (k < 8 ? 512 + b * 8 + (7 - k) : b * 64 + (63 - (k - 8)));
                cr[kk] = S[(size_t)row * 256]; ci[kk] = S[(size_t)row * 256 + 64];
            }
#pragma unroll
            for (int kk = 0; kk < 24; ++kk) {
                const int k = kh + kk;
                const int row = dir == 0 ? (k < 8 ? 512 + b * 8 + k : b * 64 + (k - 8)) : (k < 8 ? 512 + b * 8 + (7 - k) : b * 64 + (63 - (k - 8)));
                H[(size_t)row * S5_KC] = (bf16_t)f2bf(sr); H[(size_t)row * S5_KC + 64] = (bf16_t)f2bf(si);
                const float nr = ar * sr - ai * si + cr[kk], ni = ar * si + ai * sr + ci[kk];
                sr = nr; si = ni;
            }
        }
    }
}
struct ListOrder {
    int n, G, c;
    DI int idx(int i) const {
        const long L = (long)i * G + c; if (L >= n) return -1;
        const int w = (int)L, q = n / 8, r = n % 8, x = w % 8, off = w / 8;
        return (x < r ? x * (q + 1) : r * (q + 1) + (x - r) * q) + off;
    }
};
struct GroupOrder {
    ListOrder lo; int MT, NT, max_rounds;
    DI void init(int groups, int MT_, int NT_, int G, int c) { MT = MT_; NT = NT_; lo.n = groups * MT_ * NT_; lo.G = G; lo.c = c; max_rounds = 1 << 30; }
    DI bool next(int i, pg8::Unit& u) const {
        if (i >= max_rounds) return false;
        const int w = lo.idx(i); if (w < 0) return false;
        const int g = w / (MT * NT), rem = w % (MT * NT), j = rem / MT, mi = rem % MT;
        u.pm = g * MT + mi; u.pn = g * NT + j; return true;
    }
    DI void a_ready(const pg8::Unit&) const {}
    DI void done(const pg8::Unit&) const {}
};
struct OneUnit {
    int pm, pn;
    DI bool next(int i, pg8::Unit& u) const { if (i > 0) return false; u.pm = pm; u.pn = pn; return true; }
    DI void a_ready(const pg8::Unit&) const {}
    DI void done(const pg8::Unit&) const {}
};
constexpr int W1_SWAP = (int)((WS_HX - WS_WIN1T) / (512 * 1024));
static_assert((WS_HX - WS_WIN1T) % (512 * 1024) == 0, "tile-aligned operand bases");
struct Win1Order {
    ListOrder lo;
    DI void init(int G, int c) { lo.n = 64 * 12 + 8 * 8; lo.G = G; lo.c = c; }
    DI bool next(int i, pg8::Unit& u) const {
        const int w = lo.idx(i); if (w < 0) return false;
        if (w < 768) { const int mg = w / 96, rem = w % 96; u.pn = rem / 8; u.pm = mg * 8 + rem % 8; }
        else { const int r = w - 768; u.pn = 4 + r / 8; u.pm = 64 + r % 8; }
        if (u.pn >= 8) { const int ht = u.pm; u.pm = u.pn - W1_SWAP; u.pn = ht + W1_SWAP; }
        return true;
    }
    DI void a_ready(const pg8::Unit&) const {}
    DI void done(const pg8::Unit&) const {}
};

typedef pg8::f32x4 (ACC_T)[2][2][4][2];
constexpr float QSCALE = 0.125f * 1.4426950408889634f;
DI void st_bf16x4(bf16_t* p, f32x4 v) { u32x2 w; w.x = pk2(v.x, v.y); w.y = pk2(v.z, v.w); *(u32x2*)p = w; }
DI f32x4 ld_bf16x4(const bf16_t* p) { const u32x2 w = *(const u32x2*)p; return (f32x4){bflo(w.x), bfhi(w.x), bflo(w.y), bfhi(w.y)}; }
DI void st_bf16_pair(bf16_t* p, int fq, f32x4 v0, f32x4 v1) {
    const unsigned a0 = pk2(v0.x, v0.y), a1 = pk2(v0.z, v0.w), b0 = pk2(v1.x, v1.y), b1 = pk2(v1.z, v1.w);
    const auto r0 = __builtin_amdgcn_permlane16_swap(a0, b0, false, false);
    const auto r1 = __builtin_amdgcn_permlane16_swap(a1, b1, false, false);
    const u32x4 w = {r0[0], r1[0], r0[1], r1[1]};
    *(u32x4*)(p + 4 * (fq & 2) + 16 * (fq & 1)) = w;
}
DI void rope_pair(f32x4& x0, f32x4& x1, const float* tab, int pos, int fq) {
    const float* t = tab + (size_t)(pos * 16 + 4 * fq) * 2;
    const f32x4 cs0 = *(const f32x4*)t, cs1 = *(const f32x4*)(t + 4);
    const f32x4 c = {cs0.x, cs0.z, cs1.x, cs1.z}, s = {cs0.y, cs0.w, cs1.y, cs1.w};
    const f32x4 a = x0, b = x1;
    x0 = a * c - b * s; x1 = b * c + a * s;
}
struct EpiWin0 {
    static constexpr bool PERM = false, AFTER_DRAIN = false;
    unsigned char* ws;
    DI void operator()(const ACC_T& acc, const pg8::Unit& u, int wr, int wc, int fr, int fq) const {
        const float* tab = (const float*)(ws + WS_ROPE);
#pragma unroll
        for (int ai = 0; ai < 2; ++ai)
#pragma unroll
            for (int m = 0; m < 4; ++m) {
                const int row = u.pm * 256 + ai * 128 + wr * 64 + m * 16 + fr;
                const bool lat = row < ROWS_L;
                const int b = lat ? row >> 11 : (row - ROWS_L) >> 8, tok = lat ? row & 2047 : (row - ROWS_L) & 255;
                if (u.pn < 2) {
                    const int mrow = lat ? b * 64 + (tok >> 5) : 512 + b * 8 + (tok >> 5), s = tok & 31;
#pragma unroll
                    for (int bj = 0; bj < 2; ++bj) {
                        const unsigned a0 = pk2(acc[ai][bj][m][0].x, acc[ai][bj][m][0].y), a1 = pk2(acc[ai][bj][m][0].z, acc[ai][bj][m][0].w);
                        const unsigned b0 = pk2(acc[ai][bj][m][1].x, acc[ai][bj][m][1].y), b1 = pk2(acc[ai][bj][m][1].z, acc[ai][bj][m][1].w);
                        const auto r0 = __builtin_amdgcn_permlane16_swap(a0, b0, false, false); const auto r1 = __builtin_amdgcn_permlane16_swap(a1, b1, false, false);
                        const int g = (u.pn * 256 + bj * 128 + wc * 32) / 16 + (fq & 1);
                        *(u32x4*)((bf16_t*)(ws + OV_AS5) + ((size_t)g * S5_MROWS + mrow) * S5_KC + s * 16 + 4 * (fq & 2)) = (u32x4){r0[0], r1[0], r0[1], r1[1]};
                    }
                } else if (u.pn < 4) {
                    const int pos = (wc & 1) ? (tok & 63) : (tok >> 6);
#pragma unroll
                    for (int bj = 0; bj < 2; ++bj) {
                        f32x4 x0 = acc[ai][bj][m][0] * QSCALE, x1 = acc[ai][bj][m][1] * QSCALE;
                        if (lat) rope_pair(x0, x1, tab, pos, fq);
                        st_bf16_pair((bf16_t*)(ws + OV_Q0) + (size_t)row * 512 + (u.pn - 2) * 256 + bj * 128 + wc * 32, fq, x0, x1);
                    }
                } else {
                    const int kp = lat ? NC + tok : tok;
                    {
                        const int pos = (wc & 1) ? (tok & 63) : (tok >> 6);
                        f32x4 x0 = acc[ai][0][m][0], x1 = acc[ai][0][m][1];
                        if (lat) rope_pair(x0, x1, tab, pos, fq);
                        st_bf16_pair((bf16_t*)(ws + OV_K0) + ((size_t)b * NPOS + kp) * 128 + wc * 32, fq, x0, x1);
                    }
#pragma unroll
                    for (int n = 0; n < 2; ++n)
#pragma unroll
                        for (int j = 0; j < 4; ++j) {
                            const int cv = wc * 32 + n * 16 + fq * 4 + j;
                            ((bf16_t*)(ws + OV_VT0))[((size_t)b * 128 + cv) * NPOS + kp] = (bf16_t)f2bf(acc[ai][1][m][n][j]);
                        }
                }
            }
    }
};
struct EpiS5a {
    static constexpr bool PERM = false, AFTER_DRAIN = false;
    unsigned char* ws;
    DI void operator()(const ACC_T& acc, const pg8::Unit& u, int wr, int wc, int fr, int fq) const {
        const int g = u.pn, mt = u.pm % 3;
#pragma unroll
        for (int ai = 0; ai < 2; ++ai)
#pragma unroll
            for (int m = 0; m < 4; ++m) {
                const int n = mt * 256 + ai * 128 + wr * 64 + m * 16 + fr;
                if (n < S5_VALID) {
                    float* dst = (float*)(ws + OV_S) + ((size_t)g * S5_MROWS + n) * 256 + wc * 32 + fq * 4;
#pragma unroll
                    for (int bj = 0; bj < 2; ++bj)
#pragma unroll
                        for (int nn = 0; nn < 2; ++nn) *(f32x4*)(dst + bj * 128 + nn * 16) = acc[ai][bj][m][nn];
                }
            }
    }
};
DI float gelu_tanh(float x) {
    const float u = 0.7978845608028654f * (x + 0.044715f * x * x * x);
    const float e = __expf(2.0f * u);
    const float th = 1.0f - 2.0f * __builtin_amdgcn_rcpf(e + 1.0f);
    return 0.5f * x * (1.0f + th);
}
struct EpiS5c {
    static constexpr bool PERM = false, AFTER_DRAIN = false;
    unsigned char* ws; const float* dskip;
    DI void operator()(const ACC_T& acc, const pg8::Unit& u, int wr, int wc, int fr, int fq) const {
        const int g = u.pm / 3, mt = u.pm % 3, nt = u.pn & 1;
#pragma unroll
        for (int ai = 0; ai < 2; ++ai)
#pragma unroll
            for (int m = 0; m < 4; ++m) {
                const int n = mt * 256 + ai * 128 + wr * 64 + m * 16 + fr;
                if (n < S5_VALID) {
                    const int tokrow0 = n < 512 ? (n >> 6) * NL + (n & 63) * 32 : ROWS_L + ((n - 512) >> 3) * NC + ((n - 512) & 7) * 32;
                    const bf16_t* ur = (const bf16_t*)(ws + OV_AS5) + ((size_t)g * S5_MROWS + n) * S5_KC;
#pragma unroll
                    for (int bj = 0; bj < 2; ++bj) {
                        f32x4 y[2];
#pragma unroll
                        for (int nn = 0; nn < 2; ++nn) {
                            const int oc = nt * 256 + bj * 128 + wc * 32 + nn * 16 + fq * 4, c0 = oc & 15;
                            const f32x4 uu = ld_bf16x4(ur + oc), dd = *(const f32x4*)(dskip + g * 16 + c0);
                            y[nn] = acc[ai][bj][m][nn] + dd * uu;
                            y[nn].x = gelu_tanh(y[nn].x); y[nn].y = gelu_tanh(y[nn].y); y[nn].z = gelu_tanh(y[nn].z); y[nn].w = gelu_tanh(y[nn].w);
                        }
                        const unsigned a0 = pk2(y[0].x, y[0].y), a1 = pk2(y[0].z, y[0].w), b0 = pk2(y[1].x, y[1].y), b1 = pk2(y[1].z, y[1].w);
                        const auto r0 = __builtin_amdgcn_permlane16_swap(a0, b0, false, false); const auto r1 = __builtin_amdgcn_permlane16_swap(a1, b1, false, false);
                        const int t = (nt * 256 + bj * 128 + wc * 32) / 16 + (fq & 1);
                        *(u32x4*)((bf16_t*)(ws + OV_Z) + (size_t)(tokrow0 + t) * 512 + g * 16 + 4 * (fq & 2)) = (u32x4){r0[0], r1[0], r0[1], r1[1]};
                    }
                }
            }
    }
};
struct EpiGlu {
    static constexpr bool PERM = false, AFTER_DRAIN = false;
    unsigned char* ws; const float* bias;
    DI void operator()(const ACC_T& acc, const pg8::Unit& u, int wr, int wc, int fr, int fq) const {
#pragma unroll
        for (int ai = 0; ai < 2; ++ai)
#pragma unroll
            for (int m = 0; m < 4; ++m) {
                const int row = u.pm * 256 + ai * 128 + wr * 64 + m * 16 + fr;
#pragma unroll
                for (int bj = 0; bj < 2; ++bj) {
                    f32x4 o[2];
#pragma unroll
                    for (int n = 0; n < 2; ++n) {
                        const int col = u.pn * 256 + bj * 128 + wc * 32 + n * 16 + fq * 4;
                        const f32x4 z = ld_bf16x4((const bf16_t*)(ws + OV_Z) + (size_t)row * 512 + col), t = acc[ai][bj][m][n] + *(const f32x4*)(bias + col);
                        o[n].x = z.x * __builtin_amdgcn_rcpf(1.0f + __expf(-t.x)); o[n].y = z.y * __builtin_amdgcn_rcpf(1.0f + __expf(-t.y)); o[n].z = z.z * __builtin_amdgcn_rcpf(1.0f + __expf(-t.z)); o[n].w = z.w * __builtin_amdgcn_rcpf(1.0f + __expf(-t.w));
                    }
                    st_bf16_pair((bf16_t*)(ws + WS_MIX) + (size_t)row * DM + u.pn * 256 + bj * 128 + wc * 32, fq, o[0], o[1]);
                }
            }
    }
};
struct EpiResid {
    static constexpr bool PERM = false, AFTER_DRAIN = false;
    unsigned char* ws; const float* x; const float* ctx; int layer;
    DI void operator()(const ACC_T& acc, const pg8::Unit& u, int wr, int wc, int fr, int fq) const {
#pragma unroll
        for (int ai = 0; ai < 2; ++ai)
#pragma unroll
            for (int m = 0; m < 4; ++m) {
                const int row = u.pm * 256 + ai * 128 + wr * 64 + m * 16 + fr;
                const int r = row < ROWS_L ? (row >> 11) : 8;
                const float* md = (const float*)(ws + WS_MOD) + (size_t)(layer * 9 + r) * 6144 + 2 * 1024;
                bf16_t* xs = (bf16_t*)(ws + WS_XS) + (size_t)row * DM;
                const float* base = row < ROWS_L ? x + (size_t)row * DM : ctx + (size_t)(row - ROWS_L) * DM;
#pragma unroll
                for (int bj = 0; bj < 2; ++bj) {
                    f32x4 o[2];
#pragma unroll
                    for (int n = 0; n < 2; ++n) {
                        const int col = u.pn * 256 + bj * 128 + wc * 32 + n * 16 + fq * 4;
                        const f32x4 bv = layer == 0 ? *(const f32x4*)(base + col) : ld_bf16x4(xs + col);
                        o[n] = bv + *(const f32x4*)(md + col) * acc[ai][bj][m][n];
                    }
                    st_bf16_pair(xs + u.pn * 256 + bj * 128 + wc * 32, fq, o[0], o[1]);
                }
            }
    }
};
struct EpiSwiglu {
    static constexpr bool PERM = false, AFTER_DRAIN = false;
    unsigned char* ws; int MT;
    DI void operator()(const ACC_T& acc, const pg8::Unit& u, int wr, int wc, int fr, int fq) const {
        const int j = u.pn & 15;
#pragma unroll
        for (int ai = 0; ai < 2; ++ai)
#pragma unroll
            for (int m = 0; m < 4; ++m) {
                const size_t row = (size_t)u.pm * 256 + ai * 128 + wr * 64 + m * 16 + fr;
                f32x4 o[2];
#pragma unroll
                for (int n = 0; n < 2; ++n) {
                    const f32x4 gt = acc[ai][0][m][n], up = acc[ai][1][m][n];
                    o[n].x = gt.x * __builtin_amdgcn_rcpf(1.0f + __expf(-gt.x)) * up.x; o[n].y = gt.y * __builtin_amdgcn_rcpf(1.0f + __expf(-gt.y)) * up.y; o[n].z = gt.z * __builtin_amdgcn_rcpf(1.0f + __expf(-gt.z)) * up.z; o[n].w = gt.w * __builtin_amdgcn_rcpf(1.0f + __expf(-gt.w)) * up.w;
                }
                st_bf16_pair((bf16_t*)(ws + OV_HID) + row * DE + j * 128 + wc * 32, fq, o[0], o[1]);
            }
    }
};
struct EpiMoeOut {
    static constexpr bool PERM = false, AFTER_DRAIN = false;
    unsigned char* ws;
    DI void operator()(const ACC_T& acc, const pg8::Unit& u, int wr, int wc, int fr, int fq) const {
        const int j = u.pn & 3;
#pragma unroll
        for (int ai = 0; ai < 2; ++ai)
#pragma unroll
            for (int m = 0; m < 4; ++m) {
                const size_t row = (size_t)u.pm * 256 + ai * 128 + wr * 64 + m * 16 + fr;
                const float gt = ((const float*)(ws + WS_GATE))[row];
#pragma unroll
                for (int bj = 0; bj < 2; ++bj)
                    st_bf16_pair((bf16_t*)(ws + OV_YB) + row * DM + j * 256 + bj * 128 + wc * 32, fq, acc[ai][bj][m][0] * gt, acc[ai][bj][m][1] * gt);
            }
    }
};
struct EpiMoeTail {
    static constexpr bool PERM = false, AFTER_DRAIN = false;
    unsigned char* ws; int q, s;
    DI void operator()(const ACC_T& acc, const pg8::Unit& u, int wr, int wc, int fr, int fq) const {
        bf16_t* dst = (bf16_t*)(ws + OV_YBS) + ((size_t)(q * 64 + s) * 256) * 256;
#pragma unroll
        for (int ai = 0; ai < 2; ++ai)
#pragma unroll
            for (int m = 0; m < 4; ++m) {
                const int r = ai * 128 + wr * 64 + m * 16 + fr;
                const float gt = ((const float*)(ws + WS_GATE))[(size_t)u.pm * 256 + r];
#pragma unroll
                for (int bj = 0; bj < 2; ++bj)
#pragma unroll
                    for (int n = 0; n < 2; ++n)
                        st_bf16x4(dst + (size_t)r * 256 + bj * 128 + wc * 32 + n * 16 + fq * 4, acc[ai][bj][m][n] * gt);
            }
    }
};
struct EpiWin1 {
    static constexpr bool PERM = false, AFTER_DRAIN = false;
    unsigned char* ws;
    DI void operator()(const ACC_T& acc, const pg8::Unit& u, int wr, int wc, int fr, int fq) const {
        if (u.pm < 0) {
            const int vt = u.pm + W1_SWAP - 8, ht = u.pn - W1_SWAP;
            const int b = ht < 64 ? ht >> 3 : ht - 64, kp0 = ht < 64 ? NC + (ht & 7) * 256 : 0;
#pragma unroll
            for (int ai = 0; ai < 2; ++ai)
#pragma unroll
                for (int m = 0; m < 4; ++m) {
                    const int cv = vt * 256 + ai * 128 + wr * 64 + m * 16 + fr;
                    bf16_t* dst = (bf16_t*)(ws + OV_VT1) + ((size_t)b * 1024 + cv) * NPOS + kp0 + wc * 32;
#pragma unroll
                    for (int bj = 0; bj < 2; ++bj) st_bf16_pair(dst + bj * 128, fq, acc[ai][bj][m][0], acc[ai][bj][m][1]);
                }
            return;
        }
        const float* tab = (const float*)(ws + WS_ROPE);
        const int sec = u.pn >> 2, pq = u.pn & 3;
#pragma unroll
        for (int ai = 0; ai < 2; ++ai)
#pragma unroll
            for (int m = 0; m < 4; ++m) {
                const int row = u.pm * 256 + ai * 128 + wr * 64 + m * 16 + fr;
                const bool lat = row < ROWS_L;
                const int b = lat ? row >> 11 : (row - ROWS_L) >> 8, tok = lat ? row & 2047 : (row - ROWS_L) & 255;
                const int kp = lat ? NC + tok : tok;
                {
                    const int pos = (wc & 1) ? (tok & 63) : (tok >> 6);
                    bf16_t* dst = sec == 0 ? (bf16_t*)(ws + OV_Q1) + (size_t)row * DM : (bf16_t*)(ws + OV_K1) + ((size_t)b * NPOS + kp) * DM;
#pragma unroll
                    for (int bj = 0; bj < 2; ++bj) {
                        const float qs = sec == 0 ? QSCALE : 1.0f;
                        f32x4 x0 = acc[ai][bj][m][0] * qs, x1 = acc[ai][bj][m][1] * qs;
                        if (lat) rope_pair(x0, x1, tab, pos, fq);
                        st_bf16_pair(dst + pq * 256 + bj * 128 + wc * 32, fq, x0, x1);
                    }
                }
            }
    }
};
DI int crow(int r, int hi) { return (r & 3) + 8 * (r >> 2) + 4 * hi; }
constexpr float ATT_C2 = 0.125f * 1.4426950408889634f;
constexpr int VPITCH = 144;
constexpr int ATT_BUF = 16384 + 128 * VPITCH;
constexpr int ATT_K_OFF = 0, ATT_V_OFF = 16384, ATT_WS_OFF = 3 * ATT_BUF, ATT_X_OFF = 0;
constexpr float ATT_THR = 8.0f;
struct AttnJob {
    const bf16_t* q; int qld;
    const bf16_t* k; int kld;
    const bf16_t* vt; int vld;
    int kchunk0;
    int nt;
    int nfree;
    int wpos0;
    int qpos0;
};
DI float xhalf(float v) {
    const unsigned u = __builtin_bit_cast(unsigned, v);
    auto r = __builtin_amdgcn_permlane32_swap(u, u, false, false);
    return __builtin_bit_cast(float, (threadIdx.x & 32) ? r[0] : r[1]);
}
template <int X> DI float xswz(float v) {
    return __builtin_bit_cast(float, __builtin_amdgcn_ds_swizzle(__builtin_bit_cast(int, v), (X << 10) | 0x1f));
}
DI int opaque(int x) { asm volatile("" : "+v"(x)); return x; }
DI float fmax3(float a, float b, float c) { return __builtin_fmaxf(__builtin_fmaxf(a, b), c); }
template <int DV, int KW, bool WINDOW>
DI void attn_core(LAS unsigned char* lds, const AttnJob& J, f32x16 (&o)[DV / 32], float& m_out, float& l_out) {
    constexpr int NDB = DV / 32, ROWB = KW * 2, NKC = KW / 8;
    const int tid = opaque(threadIdx.x), lane = tid & 63, r32 = lane & 31, hi = lane >> 5;
    bf16x8 qf[4];
#pragma unroll
    for (int ks = 0; ks < 4; ++ks) qf[ks] = *(const bf16x8*)(J.q + (size_t)r32 * J.qld + ks * 16 + hi * 8);
#pragma unroll
    for (int d = 0; d < NDB; ++d)
#pragma unroll
        for (int r = 0; r < 16; ++r) o[d][r] = 0.f;
    float mref = 0.f, l = 0.f;
    f32x16 negm;
#pragma unroll
    for (int r = 0; r < 16; ++r) negm[r] = 0.f;
    u32x4 kreg[KW / 64], vreg[DV / 64];
#define ATT_LOAD(t) do { const int k0_ = (t) < J.nfree ? (t) * 64 : NC + J.wpos0 + ((t) - J.nfree) * 64; \
        _Pragma("unroll") for (int i = 0; i < KW / 64; ++i) { const int c = tid + 512 * i, row = c / NKC, ch = c % NKC; kreg[i] = *(const u32x4*)(J.k + (size_t)(k0_ + row) * J.kld + ch * 8); } \
        _Pragma("unroll") for (int i = 0; i < DV / 64; ++i) { const int c = tid + 512 * i, row = c >> 3, ch = c & 7; vreg[i] = *(const u32x4*)(J.vt + (size_t)row * J.vld + k0_ + ch * 8); } } while (0)
#define ATT_STORE(buf) do { LAS unsigned char* Kw_ = lds + (buf) * ATT_BUF + ATT_K_OFF; LAS unsigned char* Vw_ = lds + (buf) * ATT_BUF + ATT_V_OFF; \
        _Pragma("unroll") for (int i = 0; i < KW / 64; ++i) { const int c = tid + 512 * i, row = c / NKC, ch = c % NKC; const int sw = KW == 128 ? (row & 15) : ((row >> 1) & 7); \
            *(LAS u32x4*)(Kw_ + row * ROWB + ((ch ^ sw) << 4)) = kreg[i]; } \
        _Pragma("unroll") for (int i = 0; i < DV / 64; ++i) { const int c = tid + 512 * i, row = c >> 3, ch = c & 7; LAS unsigned char* p_ = Vw_ + row * VPITCH + ((ch >> 1) * 16 + (ch & 1) * 4) * 2; \
            *(LAS u32x2*)p_ = (u32x2){vreg[i].x, vreg[i].y}; *(LAS u32x2*)(p_ + 16) = (u32x2){vreg[i].z, vreg[i].w}; } } while (0)
#define ATT_SOFTMAX(s, t_, hh_, pa0, pa1) do { \
        if (WINDOW && (t_) >= J.nfree) { const int qp_ = J.qpos0 + r32, kp0_ = J.wpos0 + ((t_) - J.nfree) * 64 + (hh_) * 32; \
            _Pragma("unroll") for (int r = 0; r < 16; ++r) { const int d0_ = kp0_ + crow(r, hi) - qp_; if (d0_ > 128 || d0_ < -128) s[r] = -1e30f; } } \
        float mx_ = fmax3(s[0], s[1], s[2]); \
        _Pragma("unroll") for (int r = 3; r < 15; r += 2) mx_ = fmax3(mx_, s[r], s[r + 1]); \
        mx_ = __builtin_fmaxf(mx_, s[15]); mx_ = __builtin_fmaxf(mx_, xhalf(mx_)); \
        if (__any(mx_ > ATT_THR)) { const float dl_ = __builtin_fmaxf(mx_, 0.f), f_ = __builtin_amdgcn_exp2f(-dl_); mref += dl_; l *= f_; \
            _Pragma("unroll") for (int r = 0; r < 16; ++r) { s[r] -= dl_; negm[r] = -mref; } \
            ATT_RESC_OTHER(dl_); \
            LAS float* wsf_ = (LAS float*)(lds + ATT_WS_OFF) + (tid >> 6) * 32; if (hi == 0) wsf_[r32] = f_; \
            _Pragma("unroll") for (int r = 0; r < 16; ++r) { const float g_ = wsf_[crow(r, hi)]; _Pragma("unroll") for (int d = 0; d < NDB; ++d) o[d][r] *= g_; } } \
        float ls_ = 0.f; \
        _Pragma("unroll") for (int r = 0; r < 16; ++r) { s[r] = __builtin_amdgcn_exp2f(s[r]); ls_ += s[r]; } \
        l += ls_; \
        { u32x4 w0_, w1_; w0_.x = pk2(s[0], s[1]); w0_.y = pk2(s[2], s[3]); w0_.z = pk2(s[4], s[5]); w0_.w = pk2(s[6], s[7]); \
          w1_.x = pk2(s[8], s[9]); w1_.y = pk2(s[10], s[11]); w1_.z = pk2(s[12], s[13]); w1_.w = pk2(s[14], s[15]); \
          pa0 = __builtin_bit_cast(bf16x8, w0_); pa1 = __builtin_bit_cast(bf16x8, w1_); } } while (0)
#define ATT_QK(s, Kb_, hh_) do { s = negm; \
        _Pragma("unroll") for (int ks = 0; ks < 4; ++ks) { const int ch_ = J.kchunk0 + ks * 2 + hi; const int sw_ = KW == 128 ? (r32 & 15) : ((r32 >> 1) & 7); \
            const bf16x8 kf_ = *(const LAS bf16x8*)((Kb_) + ((hh_) * 32 + r32) * ROWB + ((ch_ ^ sw_) << 4)); \
            s = __builtin_amdgcn_mfma_f32_32x32x16_bf16(kf_, qf[ks], s, 0, 0, 0); } } while (0)
    const unsigned lds0 = (unsigned)(size_t)lds, vx = (unsigned)(r32 * VPITCH + hi * 16);
    bf16x8 vf[4];
#define ATT_VREADS(buf_, hh_) do { const unsigned va_ = lds0 + (unsigned)((buf_) * ATT_BUF + ATT_V_OFF) + vx; \
        asm volatile("ds_read_b128 %0, %4 offset:%5\n\tds_read_b128 %1, %4 offset:%6\n\tds_read_b128 %2, %4 offset:%7\n\tds_read_b128 %3, %4 offset:%8" \
            : "=&v"(vf[0]), "=&v"(vf[1]), "=&v"(vf[2]), "=&v"(vf[3]) \
            : "v"(va_), "i"(0 * 32 * VPITCH + (2 * (hh_)) * 32), "i"(0 * 32 * VPITCH + (2 * (hh_) + 1) * 32), "i"(1 * 32 * VPITCH + (2 * (hh_)) * 32), "i"(1 * 32 * VPITCH + (2 * (hh_) + 1) * 32)); } while (0)
#define ATT_PV(Vb_, hh_, pa0, pa1) do { \
        asm volatile("s_waitcnt lgkmcnt(0)" : "+v"(vf[0]), "+v"(vf[1]), "+v"(vf[2]), "+v"(vf[3])); \
        _Pragma("unroll") for (int d = 0; d < 2; ++d) { \
            o[d] = __builtin_amdgcn_mfma_f32_32x32x16_bf16(pa0, vf[2 * d], o[d], 0, 0, 0); \
            o[d] = __builtin_amdgcn_mfma_f32_32x32x16_bf16(pa1, vf[2 * d + 1], o[d], 0, 0, 0); } \
        _Pragma("unroll") for (int d = 2; d < NDB; ++d) { \
            const bf16x8 v0_ = *(const LAS bf16x8*)((Vb_) + (d * 32 + r32) * VPITCH + ((2 * (hh_)) * 16 + hi * 8) * 2); \
            const bf16x8 v1_ = *(const LAS bf16x8*)((Vb_) + (d * 32 + r32) * VPITCH + ((2 * (hh_) + 1) * 16 + hi * 8) * 2); \
            o[d] = __builtin_amdgcn_mfma_f32_32x32x16_bf16(pa0, v0_, o[d], 0, 0, 0); \
            o[d] = __builtin_amdgcn_mfma_f32_32x32x16_bf16(pa1, v1_, o[d], 0, 0, 0); } } while (0)
    __syncthreads();
    ATT_LOAD(0); ATT_STORE(0);
    if (J.nt > 1) ATT_LOAD(1);
    __syncthreads();
    f32x16 sa, sb;
    ATT_QK(sa, lds + ATT_K_OFF, 0);
    int cur = 0;
    for (int t = 0; t < J.nt; ++t) {
        const int nxt = cur == 2 ? 0 : cur + 1;
        if (t + 1 < J.nt) ATT_STORE(nxt);
        if (t + 2 < J.nt) ATT_LOAD(t + 2);
        __syncthreads();
        LAS unsigned char* Kb = lds + cur * ATT_BUF + ATT_K_OFF; LAS unsigned char* Vb = lds + cur * ATT_BUF + ATT_V_OFF;
        bf16x8 p0, p1;
#define ATT_RESC_OTHER(dl) do { _Pragma("unroll") for (int r = 0; r < 16; ++r) sb[r] -= (dl); } while (0)
        ATT_QK(sb, Kb, 1);
        ATT_VREADS(cur, 0);
        ATT_SOFTMAX(sa, t, 0, p0, p1);
        ATT_PV(Vb, 0, p0, p1);
#undef ATT_RESC_OTHER
#define ATT_RESC_OTHER(dl) do { _Pragma("unroll") for (int r = 0; r < 16; ++r) sa[r] -= (dl); } while (0)
        if (t + 1 < J.nt) ATT_QK(sa, lds + nxt * ATT_BUF + ATT_K_OFF, 0);
        ATT_VREADS(cur, 1);
        ATT_SOFTMAX(sb, t, 1, p0, p1);
        ATT_PV(Vb, 1, p0, p1);
#undef ATT_RESC_OTHER
        cur = nxt;
    }
    __syncthreads();
#undef ATT_SOFTMAX
#undef ATT_QK
#undef ATT_PV
#undef ATT_VREADS
#undef ATT_LOAD
#undef ATT_STORE
    m_out = mref; l_out = l + xhalf(l);
}
template <int NDB> DI void attn_scale_rows(LAS unsigned char* lds, f32x16 (&o)[NDB], float f) {
    const int tid = opaque(threadIdx.x), lane = tid & 63, r32 = lane & 31, hi = lane >> 5;
    LAS float* wsf = (LAS float*)(lds + ATT_WS_OFF) + (tid >> 6) * 32;
    if (hi == 0) wsf[r32] = f;
#pragma unroll
    for (int r = 0; r < 16; ++r) { const float g = wsf[crow(r, hi)];
#pragma unroll
        for (int d = 0; d < NDB; ++d) o[d][r] *= g; }
}
DI void pwin_attn_phase(const Args& a, LAS unsigned char* lds, int G, int stage, int& conv_pos) {
    const int tid = threadIdx.x, wave = __builtin_amdgcn_readfirstlane(tid >> 6);
    const bf16_t* Q0 = (const bf16_t*)(a.ws + OV_Q0); const bf16_t* K0 = (const bf16_t*)(a.ws + OV_K0); const bf16_t* VT0 = (const bf16_t*)(a.ws + OV_VT0);
    bf16_t* MIX = (bf16_t*)(a.ws + WS_MIX);
    const int bx = (int)blockIdx.x;
    int first, step, count;
    if (G != 256) { first = (bx - 160 % G + G) % G; step = G; count = stage == 0 ? (576 - first + G - 1) / G : 0; }
    else if (stage == 0) { first = (bx + 96) & 255; step = 256; count = first < 144 ? 2 : 1; }
    else if (stage == 1) { first = 400 + (bx - 192); step = 1; count = bx >= 192 ? 1 : 0; }
    else { const int c = (bx + 64) & 255; first = 464 + (c - 144); step = 1; count = c >= 144 ? 1 : 0; }
    const int conv_at = stage == 0 ? ((bx & 1) < count ? (bx & 1) : count) : -1;
    for (int ku = 0; ku <= count; ++ku) {
        if (ku == conv_at) steal_conv(a, lds, G, 3, 0, false, conv_pos);
        if (ku == count) break;
        const int it = first + step * ku;
        AttnJob J; int qh, row0;
        int b, kvh;
        if (it < 512) {
            b = it >> 6; kvh = (it >> 5) & 1; const int nb = (it >> 1) & 15, pr = it & 1;
            qh = kvh * 4 + pr * 2 + (wave >> 2); const int ql = nb * 128 + (wave & 3) * 32; row0 = b * NL + ql;
            const int first = nb == 0 ? 0 : (nb - 1) * 128, last = nb == 15 ? NL : (nb + 2) * 128;
            J.nfree = 4; J.nt = 4 + (last - first) / 64; J.wpos0 = first; J.qpos0 = ql;
        } else {
            const int r = it - 512; b = r >> 3; kvh = (r >> 2) & 1; const int idx = (r & 3) * 8 + wave;
            qh = kvh * 4 + (idx >> 3); row0 = ROWS_L + b * NC + (idx & 7) * 32;
            J.nfree = 4; J.nt = 4; J.wpos0 = 0; J.qpos0 = 0;
        }
        J.q = Q0 + (size_t)row0 * 512 + qh * 64; J.qld = 512;
        J.k = K0 + (size_t)b * NPOS * 128 + kvh * 64; J.kld = 128;
        J.vt = VT0 + (size_t)(b * 2 + kvh) * 64 * NPOS; J.vld = NPOS;
        J.kchunk0 = 0;
        f32x16 o[2]; float m, l;
        attn_core<64, 64, true>(lds, J, o, m, l);
        l += exp2f(a.in[I_SINK][qh] * 1.4426950408889634f - m);
        attn_scale_rows<2>(lds, o, 1.0f / l);
        const int tid2 = opaque(threadIdx.x), r32 = tid2 & 31, hi = (tid2 >> 5) & 1;
#pragma unroll
        for (int d = 0; d < 2; ++d)
#pragma unroll
            for (int r = 0; r < 16; ++r)
                MIX[(size_t)(row0 + crow(r, hi)) * DM + 512 + qh * 64 + d * 32 + r32] = (bf16_t)f2bf(o[d][r]);
    }
}
DI void pdiff_attn_phase(const Args& a, LAS unsigned char* lds, int G, int& conv_pos) {
    const int tid = threadIdx.x, lane = tid & 63, wave = __builtin_amdgcn_readfirstlane(tid >> 6);
    const bf16_t* Q1 = (const bf16_t*)(a.ws + OV_Q1); const bf16_t* K1 = (const bf16_t*)(a.ws + OV_K1); const bf16_t* VT1 = (const bf16_t*)(a.ws + OV_VT1);
    bf16_t* MIX = (bf16_t*)(a.ws + WS_MIX);
    float d1 = a.in[I_LQ1][lane] * a.in[I_LK1][lane], d2 = a.in[I_LQ2][lane] * a.in[I_LK2][lane];
    d1 = wave_sum(d1); d2 = wave_sum(d2);
    const float lam = expf(d1) - expf(d2) + LAM_INIT1;
    int ku = 0;
    const int vcu = (G % 8 == 0) ? (int)(blockIdx.x % 8) * (G / 8) + (int)(blockIdx.x / 8) : (int)blockIdx.x;
    for (int it = vcu; it < 1024; it += G, ++ku) {
        if (ku == (int)(blockIdx.x & 3)) steal_conv(a, lds, G, 14, 1, false, conv_pos);
        const int b = it >> 7, h = (it >> 4) & 7, qb = it & 15, mp = wave >> 2;
        const int row0 = b * NL + qb * 128 + (wave & 3) * 32;
        AttnJob J;
        J.q = Q1 + (size_t)row0 * DM + h * 128 + mp * 64; J.qld = DM;
        J.k = K1 + (size_t)b * NPOS * DM + h * 128; J.kld = DM;
        J.vt = VT1 + (size_t)(b * 8 + h) * 128 * NPOS; J.vld = NPOS;
        J.kchunk0 = mp * 8; J.nt = NPOS / 64; J.nfree = NPOS / 64; J.wpos0 = 0; J.qpos0 = 0;
        f32x16 o[4]; float m, l;
        attn_core<128, 128, false>(lds, J, o, m, l);
        attn_scale_rows<4>(lds, o, 1.0f / l);
        const int tid2 = opaque(threadIdx.x), r32 = tid2 & 31, hi = (tid2 >> 5) & 1;
        __syncthreads();
        LAS float* xb = (LAS float*)(lds + ATT_X_OFF) + (wave & 3) * 32 * 128;
        if (mp == 1) {
#pragma unroll
            for (int d = 0; d < 4; ++d)
#pragma unroll
                for (int r = 0; r < 16; ++r) xb[crow(r, hi) * 128 + d * 32 + r32] = o[d][r];
        }
        __syncthreads();
        if (mp == 0) {
            float ss[16];
#pragma unroll
            for (int r = 0; r < 16; ++r) {
                float s = 0.f;
#pragma unroll
                for (int d = 0; d < 4; ++d) { const float v = o[d][r] - lam * xb[crow(r, hi) * 128 + d * 32 + r32]; o[d][r] = v; s += v * v; }
                ss[r] = s;
            }
#pragma unroll
            for (int r = 0; r < 16; ++r) {
                ss[r] += xswz<1>(ss[r]); ss[r] += xswz<2>(ss[r]); ss[r] += xswz<4>(ss[r]); ss[r] += xswz<8>(ss[r]); ss[r] += xswz<16>(ss[r]);
                ss[r] = (1.0f - LAM_INIT1) / sqrtf(ss[r] * (1.0f / 128.0f) + NORM_EPS);
            }
#pragma unroll
            for (int d = 0; d < 4; ++d) {
                const float gsub = a.in[I_SUBLN][d * 32 + r32];
#pragma unroll
                for (int r = 0; r < 16; ++r)
                    MIX[(size_t)(row0 + crow(r, hi)) * DM + h * 128 + d * 32 + r32] = (bf16_t)f2bf(o[d][r] * ss[r] * gsub);
            }
        }
        __syncthreads();
    }
}
__global__ void __launch_bounds__(NTHREADS, 2) fwd_megakernel(Args a) {
    extern __shared__ __attribute__((aligned(16))) unsigned char lds_raw[];
    LAS unsigned char* lds = (LAS unsigned char*)lds_raw;
    volatile LAS unsigned* MISC = (volatile LAS unsigned*)(lds + MISC_OFF);
    const int tid = threadIdx.x, G = gridDim.x;
    for (int u = tid; u < (LDS_BYTES - RING_BYTES) / 4; u += NTHREADS) ((LAS unsigned*)(lds + RING_BYTES))[u] = 0u;
    __syncthreads();
    unsigned char* ws = a.ws;
    XcdBarrier bar = xcd_barrier_post((unsigned*)(ws + WS_CTL) + 4096, MISC + 8);
    const int lo = a.ph_lo, hi = a.ph_hi;
#ifndef DUP_MASK
#define DUP_MASK 0u
#endif
#define IN(k) (lo <= (k) && (k) < hi)
#define REP(k) for (int rep_ = 0; rep_ < 1 + (int)((DUP_MASK >> (k)) & 1u); ++rep_)
#ifdef PROBE_A
    unsigned long long* ts = (unsigned long long*)(ws + WS_DBG);
    if (blockIdx.x == 0 && tid == 0) ts[0] = __builtin_amdgcn_s_memrealtime();
#define SEAM(k) do { xcd_barrier(bar); if (blockIdx.x == 0 && tid == 0) ts[(k) + 1] = __builtin_amdgcn_s_memrealtime(); } while (0)
#else
#define SEAM(k) do { if (IN(k) && IN((k) + 1)) xcd_barrier(bar); } while (0)
#endif
    const int cblk = (int)blockIdx.x;
    int conv_pos = 0;
#define ROT(r) ((cblk + (r)) % G)
    if (IN(0)) REP(0) { p0_phase(a, lds, G); } SEAM(0);
    if (IN(1)) REP(1) { p1_phase(a, lds, G); } SEAM(1);
    if (IN(2)) REP(2) {
        pg8::Gemm g{(const bf16_t*)(ws + WS_HX), (const bf16_t*)(ws + WS_WIN0T), 1024, 1024, 1024}; pg8::StaticOrder S; S.init(ROWS, 1280, G, cblk);
        EpiWin0 E{ws}; pg8::gemm_phase<EpiWin0, pg8::StaticOrder, true, true>(lds, g, S, E);
        {
            const int first_idle = (G < 360 && G >= 180) ? 360 - G : 0;
            if (cblk >= first_idle) toeplitz_fill(a, (cblk - first_idle) * NWAVES + __builtin_amdgcn_readfirstlane(tid >> 6), (G - first_idle) * NWAVES, tid & 63);
        }
    } SEAM(2);
    if (IN(3)) REP(3) {
        pg8::Gemm g{(const bf16_t*)(ws + OV_AS5), (const bf16_t*)(ws + OV_BTA), 512, S5_KC, 512}; GroupOrder S; S.init(S5G, 3, 1, G, ROT(G - 64));
        EpiS5a E{ws}; pg8::gemm_phase<EpiS5a, GroupOrder, true, true>(lds, g, S, E);
        pwin_attn_phase(a, lds, G, 0, conv_pos);
    } SEAM(3);
    if (IN(4)) REP(4) { ps5_rec_phase(a, G); } SEAM(4);
    if (IN(5)) REP(5) {
        pg8::Gemm g{(const bf16_t*)(ws + OV_AS5), (const bf16_t*)(ws + OV_BTC), S5_KC, S5_KC, S5_KC}; GroupOrder S; S.init(S5G, 3, 2, G, cblk);
        EpiS5c E{ws, a.in[I_S5D]}; pg8::gemm_phase<EpiS5c, GroupOrder, true, true>(lds, g, S, E);
        pwin_attn_phase(a, lds, G, 1, conv_pos);
    } SEAM(5);
    if (IN(6)) REP(6) {
        pg8::Gemm g{(const bf16_t*)(ws + OV_Z), (const bf16_t*)(ws + WS_WGLUT), 512, 512, 512}; pg8::StaticOrder S; S.init(ROWS, 512, G, ROT(G - 192));
        EpiGlu E{ws, a.in[I_GLUB]}; pg8::gemm_phase<EpiGlu, pg8::StaticOrder, true, true>(lds, g, S, E);
        pwin_attn_phase(a, lds, G, 2, conv_pos);
    } SEAM(6);
    if (IN(7)) REP(7) {
        pg8::Gemm g{(const bf16_t*)(ws + WS_MIX), (const bf16_t*)(ws + WS_WOUT0T), 1024, 1024, 1024}; pg8::StaticOrder S; S.init(ROWS, 1024, G, ROT(G - 80));
        EpiResid E{ws, a.in[I_X], a.in[I_CTX], 0}; pg8::gemm_phase<EpiResid, pg8::StaticOrder, true, true>(lds, g, S, E);
    } SEAM(7);
    if (IN(8)) REP(8) { pnorm_router_phase(a, lds, G, 0, ROWS); } SEAM(8);
    if (IN(9)) REP(9) { ptopk_phase(a, lds, G, 1, 2304); } if (IN(9)) steal_conv(a, lds, G, 9, 0, false, conv_pos); SEAM(9);
    if (IN(10)) REP(10) {
        GroupOrder S; S.init(NE, 9, 16, G, cblk);
        LAS int* gidx = (LAS int*)(lds + RING_BYTES + 1024);
        for (int i = 0;; ++i) { pg8::Unit u; if (!S.next(i, u)) break; if (tid < 256) gidx[i * 256 + tid] = ((const int*)(ws + WS_SELROW))[(size_t)u.pm * 256 + tid]; }
        __syncthreads();
        pg8::Gemm g{(const bf16_t*)(ws + WS_HX), (const bf16_t*)(ws + WS_W1T), 1024, 1024, 1024};
        EpiSwiglu E{ws, 9}; pg8::gemm_phase<EpiSwiglu, GroupOrder, true, true, true>(lds, g, S, E, gidx);
    } SEAM(10);
    if (IN(11)) REP(11) {
        pg8::Gemm g{(const bf16_t*)(ws + OV_HID), (const bf16_t*)(ws + WS_W2T), 2048, 2048, 2048}; GroupOrder S; S.init(NE, 9, 4, G, ROT(G - 112));
        EpiMoeOut E{ws}; pg8::gemm_phase<EpiMoeOut, GroupOrder, true, true>(lds, g, S, E);
    } SEAM(11);
    if (IN(12)) REP(12) { pcombine_phase(a, G, 0, ROWS, 2304); } SEAM(12);
    if (IN(13)) REP(13) {
        pg8::Gemm g{(const bf16_t*)(ws + WS_HX), (const bf16_t*)(ws + WS_WIN1T), 1024, 1024, 1024}; Win1Order S; S.init(G, ROT(G - 176));
        EpiWin1 E{ws}; pg8::gemm_phase<EpiWin1, Win1Order, true, true>(lds, g, S, E);
    } SEAM(13);
    if (IN(14)) REP(14) { pdiff_attn_phase(a, lds, G, conv_pos); } SEAM(14);
    if (IN(15)) REP(15) {
        pg8::Gemm g{(const bf16_t*)(ws + WS_MIX), (const bf16_t*)(ws + WS_WOUT1T), 1024, 1024, 1024}; pg8::StaticOrder S; S.init(ROWS_L, 1024, G, cblk);
        EpiResid E{ws, a.in[I_X], a.in[I_CTX], 1}; pg8::gemm_phase<EpiResid, pg8::StaticOrder, true, true>(lds, g, S, E);
    } SEAM(15);
    if (IN(16)) REP(16) { pnorm_router_phase(a, lds, G, 1, ROWS_L); } SEAM(16);
    if (IN(17)) REP(17) { ptopk_phase(a, lds, G, 0, 2048); } if (IN(17)) steal_conv(a, lds, G, 17, 1, false, conv_pos); SEAM(17);
    if (IN(18)) REP(18) {
        GroupOrder S; S.init(NE, 8, 16, G, cblk);
        LAS int* gidx = (LAS int*)(lds + RING_BYTES + 1024);
        for (int i = 0;; ++i) { pg8::Unit u; if (!S.next(i, u)) break; if (tid < 256) gidx[i * 256 + tid] = ((const int*)(ws + WS_SELROW))[(size_t)u.pm * 256 + tid]; }
        __syncthreads();
        pg8::Gemm g{(const bf16_t*)(ws + WS_HX), (const bf16_t*)(ws + WS_W1T) + (size_t)16 * 4096 * 1024, 1024, 1024, 1024};
        EpiSwiglu E{ws, 8}; pg8::gemm_phase<EpiSwiglu, GroupOrder, true, true, true>(lds, g, S, E, gidx);
    } SEAM(18);
    if (IN(19)) REP(19) {
        pg8::Gemm g{(const bf16_t*)(ws + OV_HID), (const bf16_t*)(ws + WS_W2T) + (size_t)16 * 1024 * 2048, 2048, 2048, 2048}; GroupOrder S; S.init(NE, 8, 4, G, cblk);
        EpiMoeOut E{ws}; pg8::gemm_phase<EpiMoeOut, GroupOrder, true, true>(lds, g, S, E);
    } SEAM(19);
    if (IN(20)) REP(20) { pcombine_phase(a, G, 1, ROWS_L, 2048); }
#ifdef PROBE_A
    SEAM(20);
    xcd_barrier(bar);
    {
        const float da = (float)(ts[PROBE_A + 1] - ts[PROBE_A]) * 0.01f, db = (float)(ts[PROBE_B + 1] - ts[PROBE_B]) * 0.01f;
        const float c = 2.0f * logf(fmaxf(da, 1.0f));
        for (size_t i = (size_t)blockIdx.x * NTHREADS + tid; i < (size_t)ROWS_L * DM; i += (size_t)G * NTHREADS) a.out[i] = (i == 0) ? db : c;
    }
#endif
#undef IN
#undef SEAM
}

extern "C" void kernel_launch(void* const* d_in, const int* in_sizes, int n_in, void* d_out, int out_size, void* d_ws, size_t ws_size, hipStream_t stream) {
    static int grid = 0;
    if (grid == 0) {
        if (n_in != 33 || out_size != ROWS_L * DM || ws_size < WS_END) { fprintf(stderr, "kernel_launch: unexpected shapes (n_in %d, out %d, ws %zu; need ws >= %zu)\n", n_in, out_size, ws_size, (size_t)WS_END); grid = -1; return; }
        int dev = 0, cus = 0, per_cu = 0;
        if (hipGetDevice(&dev) != hipSuccess || hipDeviceGetAttribute(&cus, hipDeviceAttributeMultiprocessorCount, dev) != hipSuccess) { grid = -1; return; }
        if (hipFuncSetAttribute((const void*)fwd_megakernel, hipFuncAttributeMaxDynamicSharedMemorySize, LDS_BYTES) != hipSuccess) { fprintf(stderr, "kernel_launch: hipFuncSetAttribute failed\n"); grid = -1; return; }
        if (hipOccupancyMaxActiveBlocksPerMultiprocessor(&per_cu, (const void*)fwd_megakernel, NTHREADS, LDS_BYTES) != hipSuccess || per_cu < 1) { fprintf(stderr, "kernel_launch: occupancy query reports %d\n", per_cu); }
        (void)hipGetLastError();
        grid = cus;
    }
    if (grid < 0) return;
    (void)hipMemsetAsync((char*)d_ws + WS_CTL, 0, CTL_BYTES, stream);
    Args a{};
    for (int i = 0; i < 33; ++i) a.in[i] = (const float*)d_in[i];
    a.out = (float*)d_out; a.ws = (unsigned char*)d_ws; a.ph_lo = 0; a.ph_hi = 21;
    hipLaunchKernelGGL(fwd_megakernel, dim3(grid), dim3(NTHREADS), LDS_BYTES, stream, a);
}
```

```cpp
#include <hip/hip_runtime.h>
#include <cstdio>
#include <cstdint>
#include <cmath>

#define LAS __attribute__((address_space(3)))
#define GAS __attribute__((address_space(1)))
#define DI __device__ __forceinline__
typedef unsigned short bf16_t;
typedef short bf16x8 __attribute__((ext_vector_type(8)));
typedef short s16x4 __attribute__((ext_vector_type(4)));
typedef float f32x4 __attribute__((ext_vector_type(4)));
typedef float f32x2 __attribute__((ext_vector_type(2)));
typedef float f32x16 __attribute__((ext_vector_type(16)));
typedef unsigned u32x4 __attribute__((ext_vector_type(4)));
typedef unsigned u32x2 __attribute__((ext_vector_type(2)));
typedef __bf16 bf16x2_t __attribute__((ext_vector_type(2)));

constexpr int DM = 1024, NB = 8, NL = 2048, NC = 256;
constexpr int ROWS_L = NB * NL, ROWS_C = NB * NC, ROWS = ROWS_L + ROWS_C;
constexpr int NPOS = NC + NL;
constexpr int NE = 16, DE = 2048, CAP_L = 256, CAP_C = 32;
constexpr int S5G = 32, S5P = 64, S5T = 32;
constexpr int S5_MROWS = 768, S5_VALID = 576, S5_KC = 768;
constexpr float NORM_EPS = 1e-6f;
constexpr float LAM_INIT1 = 0.35550906759f;

constexpr size_t MiB = 1u << 20;
constexpr size_t WS_CTL = 0, CTL_BYTES = 64 * 1024;
constexpr size_t WS_MOD = 1 * MiB;
constexpr size_t WS_ROPE = 2 * MiB;
constexpr size_t WS_APOW = 2 * MiB + 65536;
constexpr size_t WS_DBG = 2 * MiB + 262144;
constexpr size_t WS_KTAB = 3 * MiB;
constexpr size_t WS_WIN0T = 8 * MiB;
constexpr size_t WS_WGLUT = 11 * MiB;
constexpr size_t WS_WOUT0T = 12 * MiB;
constexpr size_t WS_WIN1T = 14 * MiB;
constexpr size_t WS_WOUT1T = 20 * MiB;
constexpr size_t WS_AFFL = 22 * MiB;
constexpr size_t WS_AFFC = 23 * MiB;
constexpr size_t WS_TOKSLOT = 24 * MiB;
constexpr size_t WS_GATE = 26 * MiB;
constexpr size_t WS_SELROW = 27 * MiB;
constexpr size_t WS_XS = 32 * MiB;
constexpr size_t WS_HX = 104 * MiB;
constexpr size_t WS_MIX = 140 * MiB;
constexpr size_t WS_W1T = 176 * MiB;
constexpr size_t WS_W2T = 432 * MiB;
constexpr size_t WS_OV = 560 * MiB;
constexpr size_t OV_BTA = WS_OV + 0 * MiB;
constexpr size_t OV_BTC = WS_OV + 16 * MiB;
constexpr size_t OV_AS5 = WS_OV + 96 * MiB;
constexpr size_t OV_S = WS_OV + 40 * MiB;
constexpr size_t OV_Z = WS_OV + 152 * MiB;
constexpr size_t OV_Q0 = WS_OV + 170 * MiB;
constexpr size_t OV_K0 = WS_OV + 188 * MiB;
constexpr size_t OV_VT0 = WS_OV + 193 * MiB;
constexpr size_t OV_XG = WS_OV + 0 * MiB;
constexpr size_t OV_HID = WS_OV + 72 * MiB;
constexpr size_t OV_YB = WS_OV + 216 * MiB;
constexpr size_t OV_Q1 = WS_OV + 0 * MiB;
constexpr size_t OV_K1 = WS_OV + 32 * MiB;
constexpr size_t OV_VT1 = WS_OV + 68 * MiB;
constexpr size_t OV_YBS = WS_OV + 288 * MiB;
constexpr size_t WS_END = WS_OV + 320 * MiB;

constexpr int NTHREADS = 512, NWAVES = 8;
constexpr int RING_BYTES = 131072, MISC_OFF = RING_BYTES + 320, LDS_BYTES = 147456;

DI unsigned f2bf(float f) { unsigned u = __builtin_bit_cast(unsigned, f); return (u + 0x7fffu + ((u >> 16) & 1u)) >> 16; }
DI unsigned pk2(float lo, float hi) { f32x2 v = {lo, hi}; bf16x2_t b = __builtin_convertvector(v, bf16x2_t); return __builtin_bit_cast(unsigned, b); }
DI float bf2f(unsigned short h) { return __builtin_bit_cast(float, (unsigned)h << 16); }
DI float bflo(unsigned w) { return __builtin_bit_cast(float, w << 16); }
DI float bfhi(unsigned w) { return __builtin_bit_cast(float, w & 0xffff0000u); }
DI float wave_sum(float v) {
#pragma unroll
    for (int o = 1; o < 64; o <<= 1) v += __shfl_xor(v, o);
    return v;
}
namespace pg8 {
#define PG8_LAS __attribute__((address_space(3)))
typedef unsigned short bf16_t;
typedef short bf16x8 __attribute__((ext_vector_type(8)));
typedef float f32x4 __attribute__((ext_vector_type(4)));
typedef unsigned u32x4 __attribute__((ext_vector_type(4)));
constexpr int BM = 256, BK = 64, HALF = 128, HTB = HALF * BK * 2  , STAGE_BYTES = 8 * HTB, NXCD = 8, WGM = 8;

__host__ __device__ __forceinline__ int lds_byte(int r, int c) { const int st = (r >> 4) * 2 + (c >> 5), rr = r & 15, cc = c & 31, ob = rr * 64 + cc * 2; return st * 1024 + (ob ^ (((ob >> 9) & 1) << 5)); }
__host__ __device__ __forceinline__ void stage_rc(int b, int& R, int& C) { const int st = b / 1024, sb = b % 1024, swz = sb ^ (((sb >> 9) & 1) << 5); R = (st >> 1) * 16 + swz / 64; C = (st & 1) * 32 + (swz % 64) / 2; }
__host__ __device__ __forceinline__ int perm32(int rho) { const int n = rho >> 4, i = rho & 15; return 8 * (i >> 2) + 4 * n + (i & 3); }

struct Unit { int pm, pn; };
struct Gemm { const bf16_t* A; const bf16_t* Bt; int K, lda, ldb; };

struct StaticOrder {
    int nM, nN, nwg, G, c;
    __host__ __device__ void init(int M, int N, int G_, int c_) { nM = M / BM; nN = N / BM; nwg = nM * nN; G = G_; c = c_; }
    __host__ __device__ bool next(int i, Unit& u) const {
        const long L = (long)i * G + c; if (L >= nwg) return false;
        int wgid = (int)L; { const int q = nwg / NXCD, r = nwg % NXCD, xcd = wgid % NXCD, off = wgid / NXCD; wgid = (xcd < r ? xcd * (q + 1) : r * (q + 1) + (xcd - r) * q) + off; }
        const int nig = WGM * nN, gid = wgid / nig, fm = gid * WGM, gsz = (nM - fm) < WGM ? (nM - fm) : WGM;
        u.pm = fm + ((wgid % nig) % gsz); u.pn = (wgid % nig) / gsz; return true;
    }
    __device__ __forceinline__ void a_ready(const Unit&) const {}
    __device__ __forceinline__ void done(const Unit&) const {}
};


template <class Epi, class Sched, bool ALIGN_EPI = false, bool SP2 = false, bool GATHER = false>
__device__ __forceinline__ void gemm_phase(PG8_LAS unsigned char* lds, const Gemm g, const Sched& S, const Epi& E, const PG8_LAS int* gidx = nullptr) {
    const int tid = threadIdx.x, wid = __builtin_amdgcn_readfirstlane(tid >> 6), lane = tid & 63, wr = wid >> 2, wc = wid & 3, fr = lane & 15, fq = lane >> 4;
    const int K = g.K, nt = K / BK, lda = g.lda, ldb = g.ldb;
    unsigned voffA[2], voffB[2];
#pragma unroll
    for (int i = 0; i < 2; ++i) { int R, C; stage_rc(tid * 16 + i * 8192, R, C); const int Rb = Epi::PERM ? ((R & ~31) + perm32(R & 31)) : R;
        voffA[i] = (unsigned)(R * lda + C) * 2u; voffB[i] = (unsigned)(Rb * ldb + C) * 2u; }
    const size_t kstep = (size_t)(BK * 2);
    const size_t hstepA = (size_t)HALF * lda * 2, hstepB = (size_t)HALF * ldb * 2;
    const size_t tstepA = 2 * hstepA, tstepB = 2 * hstepB;
    unsigned gc0[2] = {0u, 0u}, gc1[2] = {0u, 0u}, gn0[2] = {0u, 0u}, gn1[2] = {0u, 0u};
#define PG8_GOFF(ui_, o0, o1) do { _Pragma("unroll") for (int i_ = 0; i_ < 2; ++i_) { int R_, C_; stage_rc(tid * 16 + i_ * 8192, R_, C_); \
        o0[i_] = (unsigned)gidx[(ui_) * 256 + R_] * (unsigned)(lda * 2) + (unsigned)(C_ * 2); o1[i_] = (unsigned)gidx[(ui_) * 256 + 128 + R_] * (unsigned)(lda * 2) + (unsigned)(C_ * 2); } \
        asm volatile("s_waitcnt lgkmcnt(0)" ::: "memory"); } while (0)
#define PG8_STA(bufoff, ptr, h, sel) do { if constexpr (GATHER) { PG8_STAGE(bufoff, ptr, g##sel##h); } else { PG8_STAGE(bufoff, (ptr) + (h) * hstepA, voffA); } } while (0)
    const unsigned ldsw = (unsigned)wid * 1024u;
    const int aoff = lds_byte(wr * 64 + fr, fq * 8), boff = lds_byte(wc * 32 + fr, fq * 8);
#define PG8_SA(b, h) (((b) * 2 + (h)) * HTB)
#define PG8_SB(b, h) ((4 + (b) * 2 + (h)) * HTB)
#define PG8_STAGE(bufoff, gbase, voff) do { _Pragma("unroll") for (int _i = 0; _i < 2; ++_i) \
        __builtin_amdgcn_global_load_lds((const unsigned*)((const char*)(gbase) + (voff)[_i]), (PG8_LAS unsigned*)(lds + (bufoff) + ldsw + _i * 8192), 16, 0, 0); } while (0)
#define PG8_LDA(dst, b, h) do { _Pragma("unroll") for (int m = 0; m < 4; ++m) _Pragma("unroll") for (int k = 0; k < 2; ++k) dst[m][k] = *(const PG8_LAS bf16x8*)(lds + PG8_SA(b, h) + aoff + m * 2048 + k * 1024); } while (0)
#define PG8_LDB(dst, b, h) do { _Pragma("unroll") for (int n = 0; n < 2; ++n) _Pragma("unroll") for (int k = 0; k < 2; ++k) dst[n][k] = *(const PG8_LAS bf16x8*)(lds + PG8_SB(b, h) + boff + n * 2048 + k * 1024); } while (0)
#define PG8_MMA(ai, bj, At, Bt) do { __builtin_amdgcn_s_setprio(1); _Pragma("unroll") for (int m = 0; m < 4; ++m) _Pragma("unroll") for (int n = 0; n < 2; ++n) _Pragma("unroll") for (int k = 0; k < 2; ++k) \
        acc[ai][bj][m][n] = __builtin_amdgcn_mfma_f32_16x16x32_bf16(Bt[n][k], At[m][k], acc[ai][bj][m][n], 0, 0, 0); __builtin_amdgcn_s_setprio(0); } while (0)
#define PG8_WAIT_V(n) asm volatile("s_waitcnt vmcnt(" #n ")" ::: "memory")
#define PG8_WAIT_L(n) asm volatile("s_waitcnt lgkmcnt(" #n ")" ::: "memory")
#define PG8_BAR __builtin_amdgcn_s_barrier()
#define PG8_SCHED __builtin_amdgcn_sched_barrier(0)
    Unit cur, nxt; int ui = 0;
    if (!S.next(0, cur)) return;
    f32x4 acc[2][2][4][2];
#pragma unroll
    for (int a = 0; a < 2; ++a)
#pragma unroll
        for (int b = 0; b < 2; ++b)
#pragma unroll
            for (int m = 0; m < 4; ++m)
#pragma unroll
                for (int n = 0; n < 2; ++n) acc[a][b][m][n] = (f32x4){0.f, 0.f, 0.f, 0.f};
    bf16x8 At[4][2], B0[2][2], B1[2][2];
    const char* cA = GATHER ? (const char*)g.A : (const char*)g.A + (size_t)cur.pm * tstepA;
    if constexpr (GATHER) PG8_GOFF(0, gc0, gc1);
    const char* cB = (const char*)g.Bt + (size_t)cur.pn * tstepB;
    S.a_ready(cur);
    if constexpr (SP2) {
        PG8_STAGE(PG8_SB(0, 0), cB, voffB); PG8_STAGE(PG8_SB(0, 1), cB + hstepB, voffB); PG8_STA(PG8_SA(0, 0), cA, 0, c); PG8_STA(PG8_SA(0, 1), cA, 1, c);
        if (wr == 1) PG8_BAR;
        PG8_WAIT_V(2); PG8_BAR;
        PG8_STAGE(PG8_SB(1, 0), cB + kstep, voffB); PG8_STA(PG8_SA(1, 0), cA + kstep, 0, c); PG8_STAGE(PG8_SB(1, 1), cB + hstepB + kstep, voffB);
        PG8_WAIT_V(6); PG8_BAR;
    } else {
        PG8_STAGE(PG8_SB(0, 0), cB, voffB); PG8_STA(PG8_SA(0, 0), cA, 0, c); PG8_STAGE(PG8_SB(0, 1), cB + hstepB, voffB); PG8_STA(PG8_SA(0, 1), cA, 1, c);
        if (wr == 1) PG8_BAR;
        PG8_WAIT_V(4); PG8_BAR;
        PG8_STAGE(PG8_SB(1, 0), cB + kstep, voffB); PG8_STA(PG8_SA(1, 0), cA + kstep, 0, c); PG8_STAGE(PG8_SB(1, 1), cB + hstepB + kstep, voffB);
        PG8_WAIT_V(6); PG8_BAR;
    }
    for (;;) {
        const bool has_next = S.next(ui + 1, nxt);
        const char* nA = GATHER ? cA : (has_next ? (const char*)g.A + (size_t)nxt.pm * tstepA : cA);
        if constexpr (GATHER) { if (has_next) PG8_GOFF(ui + 1, gn0, gn1); else { gn0[0] = gc0[0]; gn0[1] = gc0[1]; gn1[0] = gc1[0]; gn1[1] = gc1[1]; } }
        const char* nB = has_next ? (const char*)g.Bt + (size_t)nxt.pn * tstepB : cB;
        for (int t = 0; t < nt; t += 2) {
            const bool last = (t == nt - 2);
            const char* a1 = cA + (size_t)(t + 1) * kstep;
            const char* a2 = last ? nA : cA + (size_t)(t + 2) * kstep; const char* b2 = last ? nB : cB + (size_t)(t + 2) * kstep;
            const char* a3 = a2 + kstep; const char* b3 = b2 + kstep;
            unsigned gx0[2] = {0u, 0u}, gx1[2] = {0u, 0u};
            if constexpr (GATHER) { gx0[0] = last ? gn0[0] : gc0[0]; gx0[1] = last ? gn0[1] : gc0[1]; gx1[0] = last ? gn1[0] : gc1[0]; gx1[1] = last ? gn1[1] : gc1[1]; }
            if (last && has_next) S.a_ready(nxt);
            if constexpr (SP2) {
            PG8_LDB(B0, 0, 0); PG8_LDB(B1, 0, 1); PG8_SCHED; PG8_LDA(At, 0, 0); PG8_STA(PG8_SA(1, 1), a1, 1, c);
            PG8_WAIT_V(8); PG8_WAIT_L(0); PG8_BAR; PG8_MMA(0, 0, At, B0); PG8_MMA(0, 1, At, B1); PG8_BAR; PG8_SCHED;
            PG8_LDA(At, 0, 1); PG8_STAGE(PG8_SB(0, 0), b2, voffB); PG8_STAGE(PG8_SB(0, 1), b2 + hstepB, voffB); PG8_STA(PG8_SA(0, 0), a2, 0, x);
            PG8_WAIT_V(8); PG8_WAIT_L(0); PG8_BAR; PG8_MMA(1, 0, At, B0); PG8_MMA(1, 1, At, B1); PG8_BAR; PG8_SCHED;
            PG8_LDB(B0, 1, 0); PG8_LDB(B1, 1, 1); PG8_SCHED; PG8_LDA(At, 1, 0); PG8_STA(PG8_SA(0, 1), a2, 1, x);
            PG8_WAIT_V(8); PG8_WAIT_L(0); PG8_BAR; PG8_MMA(0, 0, At, B0); PG8_MMA(0, 1, At, B1); PG8_BAR; PG8_SCHED;
            PG8_LDA(At, 1, 1); PG8_STAGE(PG8_SB(1, 0), b3, voffB); PG8_STAGE(PG8_SB(1, 1), b3 + hstepB, voffB); PG8_STA(PG8_SA(1, 0), a3, 0, x);
            PG8_WAIT_V(8); PG8_WAIT_L(0); PG8_BAR; PG8_MMA(1, 0, At, B0); PG8_MMA(1, 1, At, B1); PG8_BAR; PG8_SCHED;
            } else {
            PG8_LDB(B0, 0, 0); PG8_SCHED; PG8_LDA(At, 0, 0); PG8_STA(PG8_SA(1, 1), a1, 1, c);
            PG8_WAIT_L(8); PG8_BAR; PG8_WAIT_L(0); PG8_MMA(0, 0, At, B0); PG8_BAR; PG8_SCHED;
            PG8_LDB(B1, 0, 1); PG8_STAGE(PG8_SB(0, 0), b2, voffB);
            PG8_BAR; PG8_WAIT_L(0); PG8_MMA(0, 1, At, B1); PG8_BAR;
            PG8_LDA(At, 0, 1); PG8_STA(PG8_SA(0, 0), a2, 0, x);
            PG8_BAR; PG8_WAIT_L(0); PG8_MMA(1, 0, At, B0); PG8_BAR; PG8_SCHED;
            PG8_STAGE(PG8_SB(0, 1), b2 + hstepB, voffB);
            PG8_WAIT_V(6); PG8_BAR; PG8_MMA(1, 1, At, B1); PG8_BAR;
            PG8_LDB(B0, 1, 0); PG8_SCHED; PG8_LDA(At, 1, 0); PG8_STA(PG8_SA(0, 1), a2, 1, x);
            PG8_WAIT_L(8); PG8_BAR; PG8_WAIT_L(0); PG8_MMA(0, 0, At, B0); PG8_BAR; PG8_SCHED;
            PG8_LDB(B1, 1, 1); PG8_STAGE(PG8_SB(1, 0), b3, voffB);
            PG8_BAR; PG8_WAIT_L(0); PG8_MMA(0, 1, At, B1); PG8_BAR;
            PG8_LDA(At, 1, 1); PG8_STA(PG8_SA(1, 0), a3, 0, x);
            PG8_BAR; PG8_WAIT_L(0); PG8_MMA(1, 0, At, B0); PG8_BAR; PG8_SCHED;
            PG8_STAGE(PG8_SB(1, 1), b3 + hstepB, voffB);
            PG8_WAIT_V(6); PG8_BAR; PG8_MMA(1, 1, At, B1); PG8_BAR;
            }
        }
        if constexpr (ALIGN_EPI) { if (wr == 0) PG8_BAR; }
        if constexpr (!Epi::AFTER_DRAIN) { E(acc, cur, wr, wc, fr, fq); S.done(cur); }
        if (!has_next) break;
#pragma unroll
        for (int a = 0; a < 2; ++a)
#pragma unroll
            for (int b = 0; b < 2; ++b)
#pragma unroll
                for (int m = 0; m < 4; ++m)
#pragma unroll
                    for (int n = 0; n < 2; ++n) acc[a][b][m][n] = (f32x4){0.f, 0.f, 0.f, 0.f};
        cur = nxt; cA = nA; cB = nB; ++ui;
        if constexpr (GATHER) { gc0[0] = gn0[0]; gc0[1] = gn0[1]; gc1[0] = gn1[0]; gc1[1] = gn1[1]; }
        if constexpr (ALIGN_EPI) { if (wr == 1) PG8_BAR; }
    }
    PG8_WAIT_V(0);
    if constexpr (!ALIGN_EPI) { if (wr == 0) PG8_BAR; }
    PG8_BAR;
    if constexpr (Epi::AFTER_DRAIN) { E.fused(acc, cur, wr, wc, fr, fq, lds, wid, lane); S.done(cur); }
#undef PG8_SA
#undef PG8_SB
#undef PG8_STAGE
#undef PG8_STA
#undef PG8_GOFF
#undef PG8_LDA
#undef PG8_LDB
#undef PG8_MMA
#undef PG8_WAIT_V
#undef PG8_WAIT_L
#undef PG8_BAR
#undef PG8_SCHED
}
}

#define XB_TMO      128
#define XB_XCNT(j)  (256  + 64 * (j))
#define XB_XSUB(j)  (1280 + 64 * (j))
#define XB_XGEN(j)  (2304 + 64 * (j))
#define XB_TOP      3328
#define XB_TOPGEN   3392
#define XCD_BAR_WORDS 3456
#define XB_SPIN_CAP (1u << 24)

__device__ __forceinline__ unsigned xb_ld(unsigned* p)              { return __hip_atomic_load(p, __ATOMIC_RELAXED, __HIP_MEMORY_SCOPE_AGENT); }
__device__ __forceinline__ unsigned xb_add(unsigned* p, unsigned v) { return __hip_atomic_fetch_add(p, v, __ATOMIC_RELAXED, __HIP_MEMORY_SCOPE_AGENT); }
__device__ __forceinline__ unsigned xb_xcc_id() { return (unsigned)__builtin_amdgcn_s_getreg((3 << 11) | 20) & 0xFu; }
#define XB_SPIN(cond, bar) do { unsigned _sp = 0; while (cond) { __builtin_amdgcn_s_sleep(1); \
    if ((++_sp & 255u) == 0u) { if (xb_ld(&(bar)[XB_TMO])) break; if (_sp > XB_SPIN_CAP) { atomicAdd(&(bar)[XB_TMO], 1u); break; } } } } while (0)

struct XcdBarrier {
    unsigned* bar; unsigned x;
    volatile LAS unsigned* st;
};

__device__ __forceinline__ XcdBarrier xcd_barrier_post(unsigned* bar, volatile LAS unsigned* st) {
    XcdBarrier b; b.bar = bar; b.x = xb_xcc_id(); b.st = st;
    if (threadIdx.x == 0) (void)xb_add(&bar[XB_XCNT(b.x)], 1u);
    return b;
}
__device__ __forceinline__ void xcd_barrier_complete(unsigned* bar, unsigned x, unsigned& nloc, unsigned& nx) {
    const unsigned G = gridDim.x * gridDim.y * gridDim.z;
    unsigned sum, cnt, mine, sp = 0u;
    for (;;) {
        sum = 0u; cnt = 0u; mine = 0u;
#pragma unroll
        for (unsigned j = 0; j < 16; ++j) { const unsigned c = xb_ld(&bar[XB_XCNT(j)]); sum += c; cnt += (c > 0u) ? 1u : 0u; mine = (j == x) ? c : mine; }
        if (sum == G) break;
        __builtin_amdgcn_s_sleep(1);
        if ((++sp & 255u) == 0u) { if (xb_ld(&bar[XB_TMO])) break; if (sp > XB_SPIN_CAP) { atomicAdd(&bar[XB_TMO], 1u); break; } }
    }
    nloc = mine > 0u ? mine : 1u; nx = cnt > 0u ? cnt : 1u;
}

__device__ __forceinline__ void xcd_barrier(const XcdBarrier& b) {
    asm volatile("s_waitcnt vmcnt(0)" ::: "memory");
    __syncthreads();
    if (threadIdx.x == 0) {
        unsigned* bar = b.bar;
        __builtin_amdgcn_s_waitcnt(0);
        unsigned nloc = b.st[0], nx = b.st[1];
        if (nloc == 0u) { xcd_barrier_complete(bar, b.x, nloc, nx); b.st[0] = nloc; b.st[1] = nx; }
        const unsigned old = xb_add(&bar[XB_XSUB(b.x)], 1u);
        const unsigned gen = old / nloc;
        if (old + 1u == (gen + 1u) * nloc) {
            __builtin_amdgcn_fence(__ATOMIC_RELEASE, "agent");
            asm volatile("s_waitcnt vmcnt(0)" ::: "memory");
            const unsigned og = xb_add(&bar[XB_TOP], 1u);
            const unsigned tg = og / nx;
            if (og + 1u == (tg + 1u) * nx) xb_add(&bar[XB_TOPGEN], 1u);
            else XB_SPIN(xb_ld(&bar[XB_TOPGEN]) == tg, bar);
            __builtin_amdgcn_fence(__ATOMIC_ACQUIRE, "agent");
            xb_add(&bar[XB_XGEN(b.x)], 1u);
            asm volatile("s_waitcnt vmcnt(0)" ::: "memory");
        } else {
            XB_SPIN(xb_ld(&bar[XB_XGEN(b.x)]) == gen, bar);
            __builtin_amdgcn_fence(__ATOMIC_ACQUIRE, "agent");
            asm volatile("s_waitcnt vmcnt(0)" ::: "memory");
        }
    }
    __syncthreads();
}
struct Args { const float* in[33]; float* out; unsigned char* ws; int ph_lo, ph_hi; };
enum { I_X = 0, I_C, I_CTX, I_CCTX, I_ADAW, I_ADAB, I_NMIXG, I_NFFNG, I_EVWIN, I_EVWOUT, I_LAMRE, I_LAMIM, I_LOGSTEP, I_BRE, I_BIM, I_CRE, I_CIM, I_S5D, I_GLUW, I_GLUB,
       I_SINK, I_ODWIN, I_ODWOUT, I_LQ1, I_LK1, I_LQ2, I_LK2, I_SUBLN, I_ROUTER, I_WGATE, I_WUP, I_WDOWN, I_FINALG };

DI void p0_ada_item(const Args& a, LAS unsigned char* lds, int item) {
    const int tid = threadIdx.x, lane = tid & 63, wave = tid >> 6;
    const int l = item / 96, j0 = (item % 96) * 64;
    LAS float* sc = (LAS float*)lds;
    LAS float* red = (LAS float*)(lds + 9 * 1024 * 4);
    for (int i = tid; i < 9 * 1024; i += NTHREADS) {
        const int r = i >> 10, k = i & 1023;
        const float v = (r < 8) ? a.in[I_C][r * 1024 + k] : a.in[I_CCTX][k];
        sc[i] = v / (1.0f + __expf(-v));
    }
    __syncthreads();
    float acc[9];
#pragma unroll
    for (int r = 0; r < 9; ++r) acc[r] = 0.f;
    const float* W = a.in[I_ADAW] + (size_t)l * 1024 * 6144 + j0 + lane;
    const int k0 = wave * 128;
#pragma unroll 1
    for (int kb = 0; kb < 128; kb += 32) {
        float w[32];
#pragma unroll
        for (int i = 0; i < 32; ++i) w[i] = __builtin_nontemporal_load(W + (size_t)(k0 + kb + i) * 6144);
#pragma unroll
        for (int i = 0; i < 32; ++i)
#pragma unroll
            for (int r = 0; r < 9; ++r) acc[r] += sc[r * 1024 + k0 + kb + i] * w[i];
    }
#pragma unroll
    for (int r = 0; r < 9; ++r) red[(wave * 9 + r) * 64 + lane] = acc[r];
    __syncthreads();
    for (int i = tid; i < 9 * 64; i += NTHREADS) {
        const int r = i >> 6, jj = i & 63; float s = 0.f;
#pragma unroll
        for (int w = 0; w < 8; ++w) s += red[(w * 9 + r) * 64 + jj];
        ((float*)(a.ws + WS_MOD))[(size_t)(l * 9 + r) * 6144 + j0 + jj] = s + a.in[I_ADAB][l * 6144 + j0 + jj];
    }
    __syncthreads();
}
DI void p0_rope(const Args& a) {
    for (int i = threadIdx.x; i < 1024; i += NTHREADS) {
        const int pos = i >> 4, fi = i & 15;
        const float inv = powf(10000.0f, -(float)fi / 16.0f);
        const float ang = (float)pos * inv;
        ((float*)(a.ws + WS_ROPE))[2 * i] = cosf(ang); ((float*)(a.ws + WS_ROPE))[2 * i + 1] = sinf(ang);
    }
}
DI void p0_s5_item(const Args& a, LAS unsigned char* lds, int item) {
    const int tid = threadIdx.x, g = item >> 1, dir = item & 1;
    LAS float* apr = (LAS float*)lds;
    LAS float* api = apr + 33 * 64;
    LAS float* bbr = api + 33 * 64;
    LAS float* bbi = bbr + 1024;
    LAS float* ccr = bbi + 1024;
    LAS float* cci = ccr + 1024;
    const int gp = (dir * S5G + g) * S5P;
    const float dt = __expf(a.in[I_LOGSTEP][dir * S5G + g]);
    for (int i = tid; i < 33 * 64; i += NTHREADS) {
        const int j = i >> 6, p = i & 63;
        const float lr = a.in[I_LAMRE][gp + p], li = a.in[I_LAMIM][gp + p];
        const float mag = expf((float)j * lr * dt), ang = (float)j * li * dt;
        apr[i] = mag * cosf(ang); api[i] = mag * sinf(ang);
    }
    for (int i = tid; i < 1024; i += NTHREADS) {
        const int p = i >> 4;
        const float lr = a.in[I_LAMRE][gp + p], li = a.in[I_LAMIM][gp + p];
        const float mag = expf(lr * dt), are = mag * cosf(li * dt), aim = mag * sinf(li * dt);
        const float den = lr * lr + li * li;
        const float fre = ((are - 1.0f) * lr + aim * li) / den, fim = (aim * lr - (are - 1.0f) * li) / den;
        const float br = a.in[I_BRE][(size_t)gp * 16 + i], bi = a.in[I_BIM][(size_t)gp * 16 + i];
        bbr[i] = fre * br - fim * bi; bbi[i] = fre * bi + fim * br;
        ccr[i] = a.in[I_CRE][(size_t)(dir * S5G + g) * 1024 + i]; cci[i] = a.in[I_CIM][(size_t)(dir * S5G + g) * 1024 + i];
    }
    __syncthreads();
    if (tid < 64) { float* ap = (float*)(a.ws + WS_APOW) + ((g * 2 + dir) * 64 + tid) * 2; ap[0] = apr[32 * 64 + tid]; ap[1] = api[32 * 64 + tid]; }
    {
        const int c = (tid >> 4) & 15, h = tid & 15, jh = tid >> 8;
        float cbr[64], cbi[64];
#pragma unroll
        for (int p = 0; p < 64; ++p) { const float cr = ccr[c * 64 + p], ci = cci[c * 64 + p], br = bbr[p * 16 + h], bi = bbi[p * 16 + h]; cbr[p] = cr * br - ci * bi; cbi[p] = cr * bi + ci * br; }
        float* kt = (float*)(a.ws + WS_KTAB) + (size_t)(g * 2 + dir) * 32 * 256;
        for (int j = jh * 16; j < jh * 16 + 16; ++j) {
            float s = 0.f;
#pragma unroll
            for (int p = 0; p < 64; p += 4) {
                const f32x4 ar = *(const LAS f32x4*)(apr + j * 64 + p), ai = *(const LAS f32x4*)(api + j * 64 + p);
#pragma unroll
                for (int q = 0; q < 4; ++q) s += cbr[p + q] * ar[q] - cbi[p + q] * ai[q];
            }
            kt[j * 256 + c * 16 + h] = s;
        }
    }
    bf16_t* bta = (bf16_t*)(a.ws + OV_BTA) + (size_t)g * 256 * 512;
    for (int i = tid; i < 128 * 256; i += NTHREADS) {
        const int row = i >> 8, cp = i & 255, ri = row >> 6, p = row & 63, s = cp >> 3, h = (cp & 7) * 2;
        const int e = dir ? s : 31 - s;
        const float pr = apr[e * 64 + p], pi = api[e * 64 + p];
        float v0, v1;
        if (ri == 0) { v0 = pr * bbr[p * 16 + h] - pi * bbi[p * 16 + h]; v1 = pr * bbr[p * 16 + h + 1] - pi * bbi[p * 16 + h + 1]; }
        else         { v0 = pr * bbi[p * 16 + h] + pi * bbr[p * 16 + h]; v1 = pr * bbi[p * 16 + h + 1] + pi * bbr[p * 16 + h + 1]; }
        *(unsigned*)(bta + (size_t)(dir * 128 + row) * 512 + s * 16 + h) = pk2(v0, v1);
    }
    bf16_t* btc = (bf16_t*)(a.ws + OV_BTC) + (size_t)g * 512 * S5_KC;
    for (int i = tid; i < 512 * 64; i += NTHREADS) {
        const int row = i >> 6, cp = i & 63, ri = cp >> 5, p = (cp & 31) * 2, t = row >> 4, c = row & 15;
        const int f = dir ? 32 - t : t + 1;
        float v[2];
#pragma unroll
        for (int q = 0; q < 2; ++q) {
            const float cr = ccr[c * 64 + p + q], ci = cci[c * 64 + p + q], pr = apr[f * 64 + p + q], pi = api[f * 64 + p + q];
            v[q] = ri == 0 ? (cr * pr - ci * pi) : -(cr * pi + ci * pr);
        }
        *(unsigned*)(btc + (size_t)row * S5_KC + 512 + dir * 128 + ri * 64 + p) = pk2(v[0], v[1]);
    }
    __syncthreads();
}
DI void p0_conv_item(const float* W, int K, int N, bf16_t* WT, int mode, int sel, int kb, int nb, int lane, LAS unsigned* scr) {
    const int nq = lane & 15, kq = lane >> 4;
    const float* src = W + (size_t)(kb * 64 + kq * 2) * N + nb * 64 + nq * 4;
    f32x4 v[16];
#pragma unroll
    for (int i = 0; i < 8; ++i) { v[2 * i] = *(const f32x4*)(src + (size_t)(i * 8) * N); v[2 * i + 1] = *(const f32x4*)(src + (size_t)(i * 8 + 1) * N); }
#pragma unroll
    for (int i = 0; i < 8; ++i)
#pragma unroll
        for (int j = 0; j < 4; ++j) scr[(nq * 4 + j) * 32 + ((i ^ (nq & 7)) << 2) + kq] = pk2(v[2 * i][j], v[2 * i + 1][j]);
#pragma unroll
    for (int r = 0; r < 8; ++r) {
        const int n = (lane >> 3) + 8 * r, c = lane & 7;
        const u32x4 d = *(const LAS u32x4*)(scr + n * 32 + ((c ^ ((n >> 2) & 7)) << 2));
        const int ng = nb * 64 + n;
        const int row = mode == 1 ? ((ng >> 7) * 256 + sel * 128 + (ng & 127)) : ng;
        *(u32x4*)(WT + (size_t)row * K + kb * 64 + c * 8) = d;
    }
}
constexpr int POOL_ITEMS = 16 * 1536;
constexpr int CW_PHDONE = 8704;
struct ConvItem { const float* W; bf16_t* WT; int K, N, mode, sel, kb, nb; };
DI ConvItem conv_decode(const Args& a, int pool, int item) {
    ConvItem c; const int le = pool * 16 + item / 1536; int r = item % 1536;
    if (r < 512) { c.W = a.in[I_WGATE] + (size_t)le * 1024 * 2048; c.WT = (bf16_t*)(a.ws + WS_W1T) + (size_t)le * 4096 * 1024; c.K = 1024; c.N = 2048; c.mode = 1; c.sel = 0; c.kb = r / 32; c.nb = r % 32; }
    else if (r < 1024) { r -= 512; c.W = a.in[I_WUP] + (size_t)le * 1024 * 2048; c.WT = (bf16_t*)(a.ws + WS_W1T) + (size_t)le * 4096 * 1024; c.K = 1024; c.N = 2048; c.mode = 1; c.sel = 1; c.kb = r / 32; c.nb = r % 32; }
    else { r -= 1024; c.W = a.in[I_WDOWN] + (size_t)le * 2048 * 1024; c.WT = (bf16_t*)(a.ws + WS_W2T) + (size_t)le * 1024 * 2048; c.K = 2048; c.N = 1024; c.mode = 0; c.sel = 0; c.kb = r / 16; c.nb = r % 16; }
    return c;
}
DI void conv_load(const ConvItem& c, int lane, f32x4 (&v)[16]) {
    const int nq = lane & 15, kq = lane >> 4;
    const float* src = c.W + (size_t)(c.kb * 64 + kq * 2) * c.N + c.nb * 64 + nq * 4;
#pragma unroll
    for (int i = 0; i < 8; ++i) { v[2 * i] = __builtin_nontemporal_load((const f32x4*)(src + (size_t)(i * 8) * c.N)); v[2 * i + 1] = __builtin_nontemporal_load((const f32x4*)(src + (size_t)(i * 8 + 1) * c.N)); }
}
DI void conv_store(const ConvItem& c, int lane, const f32x4 (&v)[16], LAS unsigned* scr) {
    const int nq = lane & 15, kq = lane >> 4;
#pragma unroll
    for (int i = 0; i < 8; ++i)
#pragma unroll
        for (int j = 0; j < 4; ++j) scr[(nq * 4 + j) * 32 + ((i ^ (nq & 7)) << 2) + kq] = pk2(v[2 * i][j], v[2 * i + 1][j]);
#pragma unroll
    for (int r = 0; r < 8; ++r) {
        const int n = (lane >> 3) + 8 * r, cc = lane & 7;
        const u32x4 d = *(const LAS u32x4*)(scr + n * 32 + ((cc ^ ((n >> 2) & 7)) << 2));
        const int ng = c.nb * 64 + n;
        const int row = c.mode == 1 ? ((ng >> 7) * 256 + c.sel * 128 + (ng & 127)) : ng;
        __builtin_nontemporal_store(d, (u32x4*)(c.WT + (size_t)row * c.K + c.kb * 64 + cc * 8));
    }
}
DI void steal_conv(const Args& a, LAS unsigned char* lds, int G, int phase, int last_pool, bool opportunistic, int& pos) {
    const int tid = threadIdx.x, lane = tid & 63, wave = __builtin_amdgcn_readfirstlane(tid >> 6);
    unsigned* ctl = (unsigned*)(a.ws + WS_CTL);
    LAS unsigned* scr = (LAS unsigned*)(lds + wave * 8192);
    const int NGW = G * NWAVES, ppw = (POOL_ITEMS + NGW - 1) / NGW;
    const int gw = blockIdx.x * NWAVES + wave, end = (last_pool + 1) * ppw;
    __syncthreads();
    if (tid == 0 && opportunistic) __hip_atomic_fetch_add(ctl + CW_PHDONE + 64 * phase, 1u, __ATOMIC_RELAXED, __HIP_MEMORY_SCOPE_AGENT);
#define CONV_MORE() (pos < end && (!opportunistic || (unsigned)__builtin_amdgcn_readfirstlane((int)__hip_atomic_load(ctl + CW_PHDONE + 64 * phase, __ATOMIC_RELAXED, __HIP_MEMORY_SCOPE_AGENT)) < (unsigned)G))
#define CONV_NEXT(c, ok) do { const int it_ = ((int)blockIdx.x * ppw + (pos % ppw)) * NWAVES + wave; ok = it_ < POOL_ITEMS; c = conv_decode(a, pos / ppw, ok ? it_ : 0); ++pos; } while (0)
    if (CONV_MORE()) {
        ConvItem ca, cb; f32x4 va[16], vb[16]; bool oka, okb;
        CONV_NEXT(ca, oka); if (oka) conv_load(ca, lane, va);
        for (;;) {
            okb = false; const bool moreb = CONV_MORE();
            if (moreb) { CONV_NEXT(cb, okb); if (okb) conv_load(cb, lane, vb); }
            if (oka) conv_store(ca, lane, va, scr);
            if (!moreb) break;
            oka = false; const bool morea = CONV_MORE();
            if (morea) { CONV_NEXT(ca, oka); if (oka) conv_load(ca, lane, va); }
            if (okb) conv_store(cb, lane, vb, scr);
            if (!morea) break;
        }
    }
#undef CONV_MORE
#undef CONV_NEXT
    __syncthreads();
}
DI void p0_phase(const Args& a, LAS unsigned char* lds, int G) {
    const int tid = threadIdx.x, lane = tid & 63, wave = __builtin_amdgcn_readfirstlane(tid >> 6);
    for (int it = blockIdx.x; it < 193; it += G) {
        if (it < 192) p0_ada_item(a, lds, it);
        else p0_rope(a);
    }
    __syncthreads();
    const int gw = blockIdx.x * NWAVES + wave, NGW = G * NWAVES;
    LAS unsigned* scr = (LAS unsigned*)(lds + wave * 8192);
    constexpr int I_IN0 = 16 * 20, I_GLU = 8 * 8, I_OUT0 = 16 * 16, I_IN1 = 16 * 48, I_OUT1 = 16 * 16, NITEMS = I_IN0 + I_GLU + I_OUT0 + I_IN1 + I_OUT1;
    for (int it = gw; it < NITEMS; it += NGW) {
        int r = it;
        if (r < I_IN0) { p0_conv_item(a.in[I_EVWIN], 1024, 1280, (bf16_t*)(a.ws + WS_WIN0T), 0, 0, r / 20, r % 20, lane, scr); continue; } r -= I_IN0;
        if (r < I_GLU) { p0_conv_item(a.in[I_GLUW], 512, 512, (bf16_t*)(a.ws + WS_WGLUT), 0, 0, r / 8, r % 8, lane, scr); continue; } r -= I_GLU;
        if (r < I_OUT0) { p0_conv_item(a.in[I_EVWOUT], 1024, 1024, (bf16_t*)(a.ws + WS_WOUT0T), 0, 0, r / 16, r % 16, lane, scr); continue; } r -= I_OUT0;
        if (r < I_IN1) { p0_conv_item(a.in[I_ODWIN], 1024, 3072, (bf16_t*)(a.ws + WS_WIN1T), 0, 0, r / 48, r % 48, lane, scr); continue; } r -= I_IN1;
        p0_conv_item(a.in[I_ODWOUT], 1024, 1024, (bf16_t*)(a.ws + WS_WOUT1T), 0, 0, r / 16, r % 16, lane, scr);
    }
}
DI const float* mod_ptr(const Args& a, int layer, int row) {
    const int r = row < ROWS_L ? (row >> 11) : 8;
    return (const float*)(a.ws + WS_MOD) + (size_t)(layer * 9 + r) * 6144;
}
DI f32x4 ld_bf16x4(const bf16_t* p);
DI void load_row_bf16(const bf16_t* p, int lane, f32x4 (&v)[4]) {
#pragma unroll
    for (int j = 0; j < 4; ++j) v[j] = ld_bf16x4(p + lane * 4 + 256 * j);
}
DI void load_row(const float* p, int lane, f32x4 (&v)[4]) {
#pragma unroll
    for (int j = 0; j < 4; ++j) v[j] = *(const f32x4*)(p + lane * 4 + 256 * j);
}
DI float row_rstd(const f32x4 (&v)[4]) {
    float s = 0.f;
#pragma unroll
    for (int j = 0; j < 4; ++j) s += (v[j].x * v[j].x + v[j].y * v[j].y) + (v[j].z * v[j].z + v[j].w * v[j].w);
    return 1.0f / sqrtf(wave_sum(s) * (1.0f / 1024.0f) + NORM_EPS);
}
DI void norm_mod(f32x4 (&v)[4], const float* g, const float* shift, const float* scale, int lane) {
    const float rs = row_rstd(v);
#pragma unroll
    for (int j = 0; j < 4; ++j) {
        const f32x4 gg = *(const f32x4*)(g + lane * 4 + 256 * j), sh = *(const f32x4*)(shift + lane * 4 + 256 * j), sc = *(const f32x4*)(scale + lane * 4 + 256 * j);
        v[j] = (v[j] * rs) * gg * (sc + 1.0f) + sh;
    }
}
DI void store_row_bf16(bf16_t* p, int lane, const f32x4 (&v)[4]) {
#pragma unroll
    for (int j = 0; j < 4; ++j) { u32x2 w; w.x = pk2(v[j].x, v[j].y); w.y = pk2(v[j].z, v[j].w); *(u32x2*)(p + lane * 4 + 256 * j) = w; }
}
DI float rt_xhalf(float v) {
    const unsigned u = __builtin_bit_cast(unsigned, v);
    auto r = __builtin_amdgcn_permlane32_swap(u, u, false, false);
    return __builtin_bit_cast(float, (threadIdx.x & 32) ? r[0] : r[1]);
}
template <int X> DI float rt_xswz(float v) {
    return __builtin_bit_cast(float, __builtin_amdgcn_ds_swizzle(__builtin_bit_cast(int, v), (X << 10) | 0x1f));
}
DI void router_fill(const Args& a, LAS float* ldsw, int layer) {
    const float* wr = a.in[I_ROUTER] + (size_t)layer * 1024 * 16;
    for (int i = threadIdx.x; i < 16384; i += NTHREADS) ldsw[(i & 15) * 1024 + (i >> 4)] = wr[i];
    __syncthreads();
}
DI void router_row(const Args& a, const LAS float* ldsw, int row, const f32x4 (&v)[4], int lane) {
    float lg[16];
    {
        f32x2 acc2[16];
#pragma unroll
        for (int e = 0; e < 16; ++e) acc2[e] = (f32x2){0.f, 0.f};
#pragma unroll
        for (int j = 0; j < 4; ++j) {
            const f32x2 vlo = {v[j].x, v[j].y}, vhi = {v[j].z, v[j].w};
            f32x4 w[16];
#pragma unroll
            for (int e = 0; e < 16; ++e) w[e] = *(const LAS f32x4*)(ldsw + e * 1024 + lane * 4 + 256 * j);
#pragma unroll
            for (int e = 0; e < 16; ++e) { acc2[e] += vlo * (f32x2){w[e].x, w[e].y}; acc2[e] += vhi * (f32x2){w[e].z, w[e].w}; }
            __builtin_amdgcn_sched_barrier(0);
        }
#pragma unroll
        for (int e = 0; e < 16; ++e) lg[e] = acc2[e].x + acc2[e].y;
    }
    const bool b5 = lane & 32, b4 = lane & 16, b3 = lane & 8, b2 = lane & 4;
    float k8[8], k4[4], k2[2];
#pragma unroll
    for (int i = 0; i < 8; ++i) { const float snd = b5 ? lg[i] : lg[i + 8]; k8[i] = (b5 ? lg[i + 8] : lg[i]) + rt_xhalf(snd); }
#pragma unroll
    for (int i = 0; i < 4; ++i) { const float snd = b4 ? k8[i] : k8[i + 4]; k4[i] = (b4 ? k8[i + 4] : k8[i]) + rt_xswz<16>(snd); }
#pragma unroll
    for (int i = 0; i < 2; ++i) { const float snd = b3 ? k4[i] : k4[i + 2]; k2[i] = (b3 ? k4[i + 2] : k4[i]) + rt_xswz<8>(snd); }
    float tot = (b2 ? k2[1] : k2[0]) + rt_xswz<4>(b2 ? k2[0] : k2[1]);
    tot += rt_xswz<1>(tot); tot += rt_xswz<2>(tot);
    float mx = fmaxf(tot, rt_xswz<4>(tot)); mx = fmaxf(mx, rt_xswz<8>(mx)); mx = fmaxf(mx, rt_xswz<16>(mx)); mx = fmaxf(mx, rt_xhalf(mx));
    const float ex = expf(tot - mx);
    float den = ex + rt_xswz<4>(ex); den += rt_xswz<8>(den); den += rt_xswz<16>(den); den += rt_xhalf(den);
    const float mine = ex / den;
    const int e = (lane >> 2) & 15;
    if ((lane & 3) == 0) {
        if (row < ROWS_L) ((float*)(a.ws + WS_AFFL))[((size_t)(row >> 11) * 16 + e) * NL + (row & 2047)] = mine;
        else { const int rc = row - ROWS_L; ((float*)(a.ws + WS_AFFC))[((size_t)(rc >> 8) * 16 + e) * NC + (rc & 255)] = mine; }
    }
}
DI void toeplitz_fill(const Args& a, int wv, int nwv, int lane) {
    for (int it = wv; it < S5G * 32; it += nwv) {
        const int g = it >> 5, t = it & 31;
        const float* kf = (const float*)(a.ws + WS_KTAB) + (size_t)(g * 2 + 0) * 32 * 256;
        const float* kr = kf + 32 * 256;
        bf16_t* base = (bf16_t*)(a.ws + OV_BTC) + ((size_t)g * 512 + t * 16) * S5_KC;
#pragma unroll
        for (int q = 0; q < 2; ++q) {
            const int col = q * 256 + lane * 4, s = col >> 4, h0 = col & 15;
            const float mf = s <= t ? 1.f : 0.f, mr = s >= t ? 1.f : 0.f;
            const float* pf = kf + (s <= t ? t - s : 0) * 256 + h0; const float* pr = kr + (s >= t ? s - t : 0) * 256 + h0;
#pragma unroll 8
            for (int c = 0; c < 16; ++c) {
                const f32x4 v = *(const f32x4*)(pf + c * 16) * mf + *(const f32x4*)(pr + c * 16) * mr;
                u32x2 w; w.x = pk2(v.x, v.y); w.y = pk2(v.z, v.w);
                *(u32x2*)(base + (size_t)c * S5_KC + col) = w;
            }
        }
    }
}
DI void p1_phase(const Args& a, LAS unsigned char* lds, int G) {
    const int tid = threadIdx.x, lane = tid & 63, wave = __builtin_amdgcn_readfirstlane(tid >> 6);
    const int ntab = G > 128 ? 64 : 0;
    for (int it = blockIdx.x; it < 64; it += (ntab ? 64 : G)) { if (ntab && (int)blockIdx.x >= ntab) break; p0_s5_item(a, lds, it); }
    if ((int)blockIdx.x < ntab) return;
    const int gw = ((int)blockIdx.x - ntab) * NWAVES + wave, NGW = (G - ntab) * NWAVES;
    f32x4 vn[4];
    if (gw < ROWS) load_row(gw < ROWS_L ? a.in[I_X] + (size_t)gw * DM : a.in[I_CTX] + (size_t)(gw - ROWS_L) * DM, lane, vn);
    for (int row = gw; row < ROWS; row += NGW) {
        f32x4 v[4];
#pragma unroll
        for (int j = 0; j < 4; ++j) v[j] = vn[j];
        const int nr = row + NGW;
        if (nr < ROWS) load_row(nr < ROWS_L ? a.in[I_X] + (size_t)nr * DM : a.in[I_CTX] + (size_t)(nr - ROWS_L) * DM, lane, vn);
        const float* md = mod_ptr(a, 0, row);
        norm_mod(v, a.in[I_NMIXG], md, md + 1024, lane);
        store_row_bf16((bf16_t*)(a.ws + WS_HX) + (size_t)row * DM, lane, v);
    }
}
DI void pnorm_router_phase(const Args& a, LAS unsigned char* lds, int G, int layer, int nrows) {
    const int tid = threadIdx.x, lane = tid & 63, wave = __builtin_amdgcn_readfirstlane(tid >> 6);
    const int gw = blockIdx.x * NWAVES + wave, NGW = G * NWAVES;
    LAS float* ldsw = (LAS float*)lds; router_fill(a, ldsw, layer);
    for (int row = gw; row < nrows; row += NGW) {
        f32x4 v[4]; load_row_bf16((const bf16_t*)(a.ws + WS_XS) + (size_t)row * DM, lane, v);
        const float* md = mod_ptr(a, layer, row);
        norm_mod(v, a.in[I_NFFNG] + layer * 1024, md + 3 * 1024, md + 4 * 1024, lane);
        store_row_bf16((bf16_t*)(a.ws + WS_HX) + (size_t)row * DM, lane, v);
        router_row(a, ldsw, row, v, lane);
    }
}
DI f32x4 ld_bf16x4(const bf16_t* p);
DI void pcombine_phase(const Args& a, int G, int layer, int nrows, int mrows) {
    const bool tails = false;
    const int tid = threadIdx.x, lane = tid & 63, wave = __builtin_amdgcn_readfirstlane(tid >> 6);
    const int gw = blockIdx.x * NWAVES + wave, NGW = G * NWAVES;
    const bf16_t* yb = (const bf16_t*)(a.ws + OV_YB);
    for (int row = gw; row < nrows; row += NGW) {
        bf16_t* xr = (bf16_t*)(a.ws + WS_XS) + (size_t)row * DM;
        f32x4 v[4]; load_row_bf16(xr, lane, v);
        f32x4 acc[4];
#pragma unroll
        for (int j = 0; j < 4; ++j) acc[j] = (f32x4){0.f, 0.f, 0.f, 0.f};
        const int* ts = (const int*)(a.ws + WS_TOKSLOT) + (size_t)row * 16;
        const int myslot = lane < 16 ? ts[lane] : -1;
        unsigned msk = (unsigned)__ballot(myslot >= 0);
        while (msk) {
            const int e0 = __builtin_ctz(msk); msk &= msk - 1;
            const int e1 = msk ? __builtin_ctz(msk) : e0; const bool two = msk != 0; msk &= msk - 1;
            const int s0 = __builtin_amdgcn_readlane(myslot, e0), s1 = __builtin_amdgcn_readlane(myslot, e1);
            const bf16_t* y0 = yb + ((size_t)e0 * mrows + s0) * DM; const bf16_t* y1 = yb + ((size_t)e1 * mrows + s1) * DM;
            u32x2 w0[4], w1[4];
#pragma unroll
            for (int j = 0; j < 3; ++j) { w0[j] = *(const u32x2*)(y0 + lane * 4 + 256 * j); w1[j] = *(const u32x2*)(y1 + lane * 4 + 256 * j); }
            const bool t0 = tails && (e0 & 1) && s0 >= 256, t1 = tails && (e1 & 1) && s1 >= 256;
            const float f1 = two ? 1.f : 0.f;
            if (!t0) w0[3] = *(const u32x2*)(y0 + lane * 4 + 768);
            if (!t1) w1[3] = *(const u32x2*)(y1 + lane * 4 + 768);
            if (t0 || t1) {
                const bf16_t* ybs = (const bf16_t*)(a.ws + OV_YBS);
                f32x4 ex = {0.f, 0.f, 0.f, 0.f};
                if (t0) { const int ss = (e0 >> 1) * 8 + (s0 >> 8) - 1;
#pragma unroll
                    for (int q = 0; q < 4; ++q) ex += ld_bf16x4(ybs + ((size_t)(q * 64 + ss) * 256 + (s0 & 255)) * 256 + lane * 4); w0[3] = (u32x2){0u, 0u}; }
                if (t1) { const int ss = (e1 >> 1) * 8 + (s1 >> 8) - 1;
#pragma unroll
                    for (int q = 0; q < 4; ++q) ex += ld_bf16x4(ybs + ((size_t)(q * 64 + ss) * 256 + (s1 & 255)) * 256 + lane * 4) * f1; w1[3] = (u32x2){0u, 0u}; }
                acc[3] += ex;
            }
#pragma unroll
            for (int j = 0; j < 4; ++j) {
                acc[j].x += bflo(w0[j].x) + f1 * bflo(w1[j].x); acc[j].y += bfhi(w0[j].x) + f1 * bfhi(w1[j].x);
                acc[j].z += bflo(w0[j].y) + f1 * bflo(w1[j].y); acc[j].w += bfhi(w0[j].y) + f1 * bfhi(w1[j].y);
            }
        }
        const float* md = mod_ptr(a, layer, row);
#pragma unroll
        for (int j = 0; j < 4; ++j) v[j] += *(const f32x4*)(md + 5 * 1024 + lane * 4 + 256 * j) * acc[j];
        if (layer == 0) {
            store_row_bf16(xr, lane, v);
            const float* m1 = mod_ptr(a, 1, row);
            norm_mod(v, a.in[I_NMIXG] + 1024, m1, m1 + 1024, lane);
            store_row_bf16((bf16_t*)(a.ws + WS_HX) + (size_t)row * DM, lane, v);
        } else {
            const float rs = row_rstd(v);
#pragma unroll
            for (int j = 0; j < 4; ++j) *(f32x4*)(a.out + (size_t)row * DM + lane * 4 + 256 * j) = (v[j] * rs) * *(const f32x4*)(a.in[I_FINALG] + lane * 4 + 256 * j);
        }
    }
}
DI void ptopk_phase(const Args& a, LAS unsigned char* lds, int G, int with_ctx, int mrows) {
    const int tid = threadIdx.x, lane = tid & 63, wave = __builtin_amdgcn_readfirstlane(tid >> 6);
    LAS int* hist = (LAS int*)lds;
    LAS int* st = (LAS int*)(lds + 1024);
    LAS int* wsum = (LAS int*)(lds + 1024 + 32);
    LAS unsigned* wtot = (LAS unsigned*)(lds + 1024 + 64);
    LAS int* list = (LAS int*)(lds + 2048);
    const int nitems = with_ctx ? 256 : 128;
    for (int it = blockIdx.x; it < nitems; it += G) {
        const bool lat = it < 128;
        const int r = lat ? it : it - 128, b = r >> 4, e = r & 15, n = lat ? NL : NC, cap = lat ? CAP_L : CAP_C;
        const float* src = lat ? (const float*)(a.ws + WS_AFFL) + ((size_t)b * 16 + e) * NL : (const float*)(a.ws + WS_AFFC) + ((size_t)b * 16 + e) * NC;
        const bool valid = tid * 4 < n;
        u32x4 key = {0u, 0u, 0u, 0u};
        if (valid) key = *(const u32x4*)(src + tid * 4);
        unsigned prefix = 0u; int remaining = cap;
#pragma unroll
        for (int pass = 0; pass < 4; ++pass) {
            const int shift = 24 - 8 * pass;
            if (tid < 256) hist[tid] = 0;
            __syncthreads();
            if (valid) {
#pragma unroll
                for (int i = 0; i < 4; ++i)
                    if (pass == 0 || (key[i] >> (shift + 8)) == prefix) __hip_atomic_fetch_add(&hist[(key[i] >> shift) & 255u], 1, __ATOMIC_RELAXED, __HIP_MEMORY_SCOPE_WORKGROUP);
            }
            __syncthreads();
            {
                const int mine = tid < 256 ? hist[tid] : 0;
                int sfx = mine;
#pragma unroll
                for (int o = 1; o < 64; o <<= 1) { const int y = __shfl_down(sfx, o); if (lane + o < 64) sfx += y; }
                if (tid < 256 && lane == 0) wsum[wave] = sfx;
                __syncthreads();
                if (tid < 256) {
                    int above = sfx - mine;
                    for (int w = wave + 1; w < 4; ++w) above += wsum[w];
                    if (above < remaining && remaining <= above + mine) { st[0] = tid; st[1] = remaining - above; }
                }
            }
            __syncthreads();
            prefix = (prefix << 8) | (unsigned)st[0]; remaining = st[1];
        }
        const unsigned T = prefix; const int req = remaining;
        unsigned cnt = 0u;
#pragma unroll
        for (int i = 0; i < 4; ++i) cnt += (valid && key[i] > T ? 1u : 0u) + (valid && key[i] == T ? 0x10000u : 0u);
        unsigned inc = cnt;
#pragma unroll
        for (int o = 1; o < 64; o <<= 1) { const unsigned y = __shfl_up(inc, o); if (lane >= o) inc += y; }
        if (lane == 63) wtot[wave] = inc;
        __syncthreads();
        unsigned off = inc - cnt;
        for (int w = 0; w < wave; ++w) off += wtot[w];
        int gtp = (int)(off & 0xffffu), eqp = (int)(off >> 16);
        if (valid) {
#pragma unroll
            for (int i = 0; i < 4; ++i) {
                const unsigned kv = key[i];
                const bool gt = kv > T, eq = kv == T;
                const bool sel = gt || (eq && eqp < req);
                const int t = tid * 4 + i, trow = lat ? b * NL + t : ROWS_L + b * NC + t;
                int erow = -1;
                if (sel) {
                    const int slot = gtp + (eqp < req ? eqp : req);
                    erow = lat ? b * CAP_L + slot : NB * CAP_L + b * CAP_C + slot;
                    ((float*)(a.ws + WS_GATE))[(size_t)e * mrows + erow] = __uint_as_float(kv);
                    list[slot] = trow;
                }
                ((int*)(a.ws + WS_TOKSLOT))[(size_t)trow * 16 + e] = erow;
                gtp += gt ? 1 : 0; eqp += eq ? 1 : 0;
            }
        }
        __syncthreads();
        const int ebase = lat ? b * CAP_L : NB * CAP_L + b * CAP_C;
        if (tid < cap) ((int*)(a.ws + WS_SELROW))[(size_t)e * mrows + ebase + tid] = list[tid];
        __syncthreads();
    }
}
DI void ps5_rec_phase(const Args& a, int G) {
    if (threadIdx.x >= 128) return;
    for (int it = blockIdx.x; it < 256; it += G) {
        const int gid = it * 128 + threadIdx.x;
        const int p = gid & 63, dir = (gid >> 6) & 1, b = (gid >> 7) & 7, g = gid >> 10;
        const float* ap = (const float*)(a.ws + WS_APOW) + ((g * 2 + dir) * 64 + p) * 2;
        const float ar = ap[0], ai = ap[1];
        const float* S = (const float*)(a.ws + OV_S) + (size_t)g * S5_MROWS * 256 + dir * 128 + p;
        bf16_t* H = (bf16_t*)(a.ws + OV_AS5) + (size_t)g * S5_MROWS * S5_KC + 512 + dir * 128 + p;
        float sr = 0.f, si = 0.f;
#pragma unroll 1
        for (int kh = 0; kh < 72; kh += 24) {
            float cr[24], ci[24];
#pragma unroll
            for (int kk = 0; kk < 24; ++kk) {
                const int k = kh + kk;
                const int row = dir == 0 ? (k < 8 ? 512 + b * 8 + k : b * 64 + (k - 8)) : (k < 8 ? 512 + b * 8 + (7 - k) : b * 64 + (63 - (k - 8)));
                cr[kk] = S[(size_t)row * 256]; ci[kk] = S[(size_t)row * 256 + 64];
            }
#pragma unroll
            for (int kk = 0; kk < 24; ++kk) {
                const int k = kh + kk;
                const int row = dir == 0 ? (k < 8 ? 512 + b * 8 + k : b * 64 + (k - 8)) : (k < 8 ? 512 + b * 8 + (7 - k) : b * 64 + (63 - (k - 8)));
                H[(size_t)row * S5_KC] = (bf16_t)f2bf(sr); H[(size_t)row * S5_KC + 64] = (bf16_t)f2bf(si);
                const float nr = ar * sr - ai * si + cr[kk], ni = ar * si + ai * sr + ci[kk];
                sr = nr; si = ni;
            }
        }
    }
}
struct ListOrder {
    int n, G, c;
    DI int idx(int i) const {
        const long L = (long)i * G + c; if (L >= n) return -1;
        const int w = (int)L, q = n / 8, r = n % 8, x = w % 8, off = w / 8;
        return (x < r ? x * (q + 1) : r * (q + 1) + (x - r) * q) + off;
    }
};
struct GroupOrder {
    ListOrder lo; int MT, NT, max_rounds;
    DI void init(int groups, int MT_, int NT_, int G, int c) { MT = MT_; NT = NT_; lo.n = groups * MT_ * NT_; lo.G = G; lo.c = c; max_rounds = 1 << 30; }
    DI bool next(int i, pg8::Unit& u) const {
        if (i >= max_rounds) return false;
        const int w = lo.idx(i); if (w < 0) return false;
        const int g = w / (MT * NT), rem = w % (MT * NT), j = rem / MT, mi = rem % MT;
        u.pm = g * MT + mi; u.pn = g * NT + j; return true;
    }
    DI void a_ready(const pg8::Unit&) const {}
    DI void done(const pg8::Unit&) const {}
};
struct OneUnit {
    int pm, pn;
    DI bool next(int i, pg8::Unit& u) const { if (i > 0) return false; u.pm = pm; u.pn = pn; return true; }
    DI void a_ready(const pg8::Unit&) const {}
    DI void done(const pg8::Unit&) const {}
};
constexpr int W1_SWAP = (int)((WS_HX - WS_WIN1T) / (512 * 1024));
static_assert((WS_HX - WS_WIN1T) % (512 * 1024) == 0, "tile-aligned operand bases");
struct Win1Order {
    ListOrder lo;
    DI void init(int G, int c) { lo.n = 64 * 12 + 8 * 8; lo.G = G; lo.c = c; }
    DI bool next(int i, pg8::Unit& u) const {
        const int w = lo.idx(i); if (w < 0) return false;
        if (w < 768) { const int mg = w / 96, rem = w % 96; u.pn = rem / 8; u.pm = mg * 8 + rem % 8; }
        else { const int r = w - 768; u.pn = 4 + r / 8; u.pm = 64 + r % 8; }
        if (u.pn >= 8) { const int ht = u.pm; u.pm = u.pn - W1_SWAP; u.pn = ht + W1_SWAP; }
        return true;
    }
    DI void a_ready(const pg8::Unit&) const {}
    DI void done(const pg8::Unit&) const {}
};

typedef pg8::f32x4 (ACC_T)[2][2][4][2];
constexpr float QSCALE = 0.125f * 1.4426950408889634f;
DI void st_bf16x4(bf16_t* p, f32x4 v) { u32x2 w; w.x = pk2(v.x, v.y); w.y = pk2(v.z, v.w); *(u32x2*)p = w; }
DI f32x4 ld_bf16x4(const bf16_t* p) { const u32x2 w = *(const u32x2*)p; return (f32x4){bflo(w.x), bfhi(w.x), bflo(w.y), bfhi(w.y)}; }
DI void st_bf16_pair(bf16_t* p, int fq, f32x4 v0, f32x4 v1) {
    const unsigned a0 = pk2(v0.x, v0.y), a1 = pk2(v0.z, v0.w), b0 = pk2(v1.x, v1.y), b1 = pk2(v1.z, v1.w);
    const auto r0 = __builtin_amdgcn_permlane16_swap(a0, b0, false, false);
    const auto r1 = __builtin_amdgcn_permlane16_swap(a1, b1, false, false);
    const u32x4 w = {r0[0], r1[0], r0[1], r1[1]};
    *(u32x4*)(p + 4 * (fq & 2) + 16 * (fq & 1)) = w;
}
DI void rope_pair(f32x4& x0, f32x4& x1, const float* tab, int pos, int fq) {
    const float* t = tab + (size_t)(pos * 16 + 4 * fq) * 2;
    const f32x4 cs0 = *(const f32x4*)t, cs1 = *(const f32x4*)(t + 4);
    const f32x4 c = {cs0.x, cs0.z, cs1.x, cs1.z}, s = {cs0.y, cs0.w, cs1.y, cs1.w};
    const f32x4 a = x0, b = x1;
    x0 = a * c - b * s; x1 = b * c + a * s;
}
struct EpiWin0 {
    static constexpr bool PERM = false, AFTER_DRAIN = false;
    unsigned char* ws;
    DI void operator()(const ACC_T& acc, const pg8::Unit& u, int wr, int wc, int fr, int fq) const {
        const float* tab = (const float*)(ws + WS_ROPE);
#pragma unroll
        for (int ai = 0; ai < 2; ++ai)
#pragma unroll
            for (int m = 0; m < 4; ++m) {
                const int row = u.pm * 256 + ai * 128 + wr * 64 + m * 16 + fr;
                const bool lat = row < ROWS_L;
                const int b = lat ? row >> 11 : (row - ROWS_L) >> 8, tok = lat ? row & 2047 : (row - ROWS_L) & 255;
                if (u.pn < 2) {
                    const int mrow = lat ? b * 64 + (tok >> 5) : 512 + b * 8 + (tok >> 5), s = tok & 31;
#pragma unroll
                    for (int bj = 0; bj < 2; ++bj) {
                        const unsigned a0 = pk2(acc[ai][bj][m][0].x, acc[ai][bj][m][0].y), a1 = pk2(acc[ai][bj][m][0].z, acc[ai][bj][m][0].w);
                        const unsigned b0 = pk2(acc[ai][bj][m][1].x, acc[ai][bj][m][1].y), b1 = pk2(acc[ai][bj][m][1].z, acc[ai][bj][m][1].w);
                        const auto r0 = __builtin_amdgcn_permlane16_swap(a0, b0, false, false); const auto r1 = __builtin_amdgcn_permlane16_swap(a1, b1, false, false);
                        const int g = (u.pn * 256 + bj * 128 + wc * 32) / 16 + (fq & 1);
                        *(u32x4*)((bf16_t*)(ws + OV_AS5) + ((size_t)g * S5_MROWS + mrow) * S5_KC + s * 16 + 4 * (fq & 2)) = (u32x4){r0[0], r1[0], r0[1], r1[1]};
                    }
                } else if (u.pn < 4) {
                    const int pos = (wc & 1) ? (tok & 63) : (tok >> 6);
#pragma unroll
                    for (int bj = 0; bj < 2; ++bj) {
                        f32x4 x0 = acc[ai][bj][m][0] * QSCALE, x1 = acc[ai][bj][m][1] * QSCALE;
                        if (lat) rope_pair(x0, x1, tab, pos, fq);
                        st_bf16_pair((bf16_t*)(ws + OV_Q0) + (size_t)row * 512 + (u.pn - 2) * 256 + bj * 128 + wc * 32, fq, x0, x1);
                    }
                } else {
                    const int kp = lat ? NC + tok : tok;
                    {
                        const int pos = (wc & 1) ? (tok & 63) : (tok >> 6);
                        f32x4 x0 = acc[ai][0][m][0], x1 = acc[ai][0][m][1];
                        if (lat) rope_pair(x0, x1, tab, pos, fq);
                        st_bf16_pair((bf16_t*)(ws + OV_K0) + ((size_t)b * NPOS + kp) * 128 + wc * 32, fq, x0, x1);
                    }
#pragma unroll
                    for (int n = 0; n < 2; ++n)
#pragma unroll
                        for (int j = 0; j < 4; ++j) {
                            const int cv = wc * 32 + n * 16 + fq * 4 + j;
                            ((bf16_t*)(ws + OV_VT0))[((size_t)b * 128 + cv) * NPOS + kp] = (bf16_t)f2bf(acc[ai][1][m][n][j]);
                        }
                }
            }
    }
};
struct EpiS5a {
    static constexpr bool PERM = false, AFTER_DRAIN = false;
    unsigned char* ws;
    DI void operator()(const ACC_T& acc, const pg8::Unit& u, int wr, int wc, int fr, int fq) const {
        const int g = u.pn, mt = u.pm % 3;
#pragma unroll
        for (int ai = 0; ai < 2; ++ai)
#pragma unroll
            for (int m = 0; m < 4; ++m) {
                const int n = mt * 256 + ai * 128 + wr * 64 + m * 16 + fr;
                if (n < S5_VALID) {
                    float* dst = (float*)(ws + OV_S) + ((size_t)g * S5_MROWS + n) * 256 + wc * 32 + fq * 4;
#pragma unroll
                    for (int bj = 0; bj < 2; ++bj)
#pragma unroll
                        for (int nn = 0; nn < 2; ++nn) *(f32x4*)(dst + bj * 128 + nn * 16) = acc[ai][bj][m][nn];
                }
            }
    }
};
DI float gelu_tanh(float x) {
    const float u = 0.7978845608028654f * (x + 0.044715f * x * x * x);
    const float e = __expf(2.0f * u);
    const float th = 1.0f - 2.0f * __builtin_amdgcn_rcpf(e + 1.0f);
    return 0.5f * x * (1.0f + th);
}
struct EpiS5c {
    static constexpr bool PERM = false, AFTER_DRAIN = false;
    unsigned char* ws; const float* dskip;
    DI void operator()(const ACC_T& acc, const pg8::Unit& u, int wr, int wc, int fr, int fq) const {
        const int g = u.pm / 3, mt = u.pm % 3, nt = u.pn & 1;
#pragma unroll
        for (int ai = 0; ai < 2; ++ai)
#pragma unroll
            for (int m = 0; m < 4; ++m) {
                const int n = mt * 256 + ai * 128 + wr * 64 + m * 16 + fr;
                if (n < S5_VALID) {
                    const int tokrow0 = n < 512 ? (n >> 6) * NL + (n & 63) * 32 : ROWS_L + ((n - 512) >> 3) * NC + ((n - 512) & 7) * 32;
                    const bf16_t* ur = (const bf16_t*)(ws + OV_AS5) + ((size_t)g * S5_MROWS + n) * S5_KC;
#pragma unroll
                    for (int bj = 0; bj < 2; ++bj) {
                        f32x4 y[2];
#pragma unroll
                        for (int nn = 0; nn < 2; ++nn) {
                            const int oc = nt * 256 + bj * 128 + wc * 32 + nn * 16 + fq * 4, c0 = oc & 15;
                            const f32x4 uu = ld_bf16x4(ur + oc), dd = *(const f32x4*)(dskip + g * 16 + c0);
                            y[nn] = acc[ai][bj][m][nn] + dd * uu;
                            y[nn].x = gelu_tanh(y[nn].x); y[nn].y = gelu_tanh(y[nn].y); y[nn].z = gelu_tanh(y[nn].z); y[nn].w = gelu_tanh(y[nn].w);
                        }
                        const unsigned a0 = pk2(y[0].x, y[0].y), a1 = pk2(y[0].z, y[0].w), b0 = pk2(y[1].x, y[1].y), b1 = pk2(y[1].z, y[1].w);
                        const auto r0 = __builtin_amdgcn_permlane16_swap(a0, b0, false, false); const auto r1 = __builtin_amdgcn_permlane16_swap(a1, b1, false, false);
                        const int t = (nt * 256 + bj * 128 + wc * 32) / 16 + (fq & 1);
                        *(u32x4*)((bf16_t*)(ws + OV_Z) + (size_t)(tokrow0 + t) * 512 + g * 16 + 4 * (fq & 2)) = (u32x4){r0[0], r1[0], r0[1], r1[1]};
                    }
                }
            }
    }
};
struct EpiGlu {
    static constexpr bool PERM = false, AFTER_DRAIN = false;
    unsigned char* ws; const float* bias;
    DI void operator()(const ACC_T& acc, const pg8::Unit& u, int wr, int wc, int fr, int fq) const {
#pragma unroll
        for (int ai = 0; ai < 2; ++ai)
#pragma unroll
            for (int m = 0; m < 4; ++m) {
                const int row = u.pm * 256 + ai * 128 + wr * 64 + m * 16 + fr;
#pragma unroll
                for (int bj = 0; bj < 2; ++bj) {
                    f32x4 o[2];
#pragma unroll
                    for (int n = 0; n < 2; ++n) {
                        const int col = u.pn * 256 + bj * 128 + wc * 32 + n * 16 + fq * 4;
                        const f32x4 z = ld_bf16x4((const bf16_t*)(ws + OV_Z) + (size_t)row * 512 + col), t = acc[ai][bj][m][n] + *(const f32x4*)(bias + col);
                        o[n].x = z.x * __builtin_amdgcn_rcpf(1.0f + __expf(-t.x)); o[n].y = z.y * __builtin_amdgcn_rcpf(1.0f + __expf(-t.y)); o[n].z = z.z * __builtin_amdgcn_rcpf(1.0f + __expf(-t.z)); o[n].w = z.w * __builtin_amdgcn_rcpf(1.0f + __expf(-t.w));
                    }
                    st_bf16_pair((bf16_t*)(ws + WS_MIX) + (size_t)row * DM + u.pn * 256 + bj * 128 + wc * 32, fq, o[0], o[1]);
                }
            }
    }
};
struct EpiResid {
    static constexpr bool PERM = false, AFTER_DRAIN = false;
    unsigned char* ws; const float* x; const float* ctx; int layer;
    DI void operator()(const ACC_T& acc, const pg8::Unit& u, int wr, int wc, int fr, int fq) const {
#pragma unroll
        for (int ai = 0; ai < 2; ++ai)
#pragma unroll
            for (int m = 0; m < 4; ++m) {
                const int row = u.pm * 256 + ai * 128 + wr * 64 + m * 16 + fr;
                const int r = row < ROWS_L ? (row >> 11) : 8;
                const float* md = (const float*)(ws + WS_MOD) + (size_t)(layer * 9 + r) * 6144 + 2 * 1024;
                bf16_t* xs = (bf16_t*)(ws + WS_XS) + (size_t)row * DM;
                const float* base = row < ROWS_L ? x + (size_t)row * DM : ctx + (size_t)(row - ROWS_L) * DM;
#pragma unroll
                for (int bj = 0; bj < 2; ++bj) {
                    f32x4 o[2];
#pragma unroll
                    for (int n = 0; n < 2; ++n) {
                        const int col = u.pn * 256 + bj * 128 + wc * 32 + n * 16 + fq * 4;
                        const f32x4 bv = layer == 0 ? *(const f32x4*)(base + col) : ld_bf16x4(xs + col);
                        o[n] = bv + *(const f32x4*)(md + col) * acc[ai][bj][m][n];
                    }
                    st_bf16_pair(xs + u.pn * 256 + bj * 128 + wc * 32, fq, o[0], o[1]);
                }
            }
    }
};
struct EpiSwiglu {
    static constexpr bool PERM = false, AFTER_DRAIN = false;
    unsigned char* ws; int MT;
    DI void operator()(const ACC_T& acc, const pg8::Unit& u, int wr, int wc, int fr, int fq) const {
        const int j = u.pn & 15;
#pragma unroll
        for (int ai = 0; ai < 2; ++ai)
#pragma unroll
            for (int m = 0; m < 4; ++m) {
                const size_t row = (size_t)u.pm * 256 + ai * 128 + wr * 64 + m * 16 + fr;
                f32x4 o[2];
#pragma unroll
                for (int n = 0; n < 2; ++n) {
                    const f32x4 gt = acc[ai][0][m][n], up = acc[ai][1][m][n];
                    o[n].x = gt.x * __builtin_amdgcn_rcpf(1.0f + __expf(-gt.x)) * up.x; o[n].y = gt.y * __builtin_amdgcn_rcpf(1.0f + __expf(-gt.y)) * up.y; o[n].z = gt.z * __builtin_amdgcn_rcpf(1.0f + __expf(-gt.z)) * up.z; o[n].w = gt.w * __builtin_amdgcn_rcpf(1.0f + __expf(-gt.w)) * up.w;
                }
                st_bf16_pair((bf16_t*)(ws + OV_HID) + row * DE + j * 128 + wc * 32, fq, o[0], o[1]);
            }
    }
};
struct EpiMoeOut {
    static constexpr bool PERM = false, AFTER_DRAIN = false;
    unsigned char* ws;
    DI void operator()(const ACC_T& acc, const pg8::Unit& u, int wr, int wc, int fr, int fq) const {
        const int j = u.pn & 3;
#pragma unroll
        for (int ai = 0; ai < 2; ++ai)
#pragma unroll
            for (int m = 0; m < 4; ++m) {
                const size_t row = (size_t)u.pm * 256 + ai * 128 + wr * 64 + m * 16 + fr;
                const float gt = ((const float*)(ws + WS_GATE))[row];
#pragma unroll
                for (int bj = 0; bj < 2; ++bj)
                    st_bf16_pair((bf16_t*)(ws + OV_YB) + row * DM + j * 256 + bj * 128 + wc * 32, fq, acc[ai][bj][m][0] * gt, acc[ai][bj][m][1] * gt);
            }
    }
};
struct EpiMoeTail {
    static constexpr bool PERM = false, AFTER_DRAIN = false;
    unsigned char* ws; int q, s;
    DI void operator()(const ACC_T& acc, const pg8::Unit& u, int wr, int wc, int fr, int fq) const {
        bf16_t* dst = (bf16_t*)(ws + OV_YBS) + ((size_t)(q * 64 + s) * 256) * 256;
#pragma unroll
        for (int ai = 0; ai < 2; ++ai)
#pragma unroll
            for (int m = 0; m < 4; ++m) {
                const int r = ai * 128 + wr * 64 + m * 16 + fr;
                const float gt = ((const float*)(ws + WS_GATE))[(size_t)u.pm * 256 + r];
#pragma unroll
                for (int bj = 0; bj < 2; ++bj)
#pragma unroll
                    for (int n = 0; n < 2; ++n)
                        st_bf16x4(dst + (size_t)r * 256 + bj * 128 + wc * 32 + n * 16 + fq * 4, acc[ai][bj][m][n] * gt);
            }
    }
};
struct EpiWin1 {
    static constexpr bool PERM = false, AFTER_DRAIN = false;
    unsigned char* ws;
    DI void operator()(const ACC_T& acc, const pg8::Unit& u, int wr, int wc, int fr, int fq) const {
        if (u.pm < 0) {
            const int vt = u.pm + W1_SWAP - 8, ht = u.pn - W1_SWAP;
            const int b = ht < 64 ? ht >> 3 : ht - 64, kp0 = ht < 64 ? NC + (ht & 7) * 256 : 0;
#pragma unroll
            for (int ai = 0; ai < 2; ++ai)
#pragma unroll
                for (int m = 0; m < 4; ++m) {
                    const int cv = vt * 256 + ai * 128 + wr * 64 + m * 16 + fr;
                    bf16_t* dst = (bf16_t*)(ws + OV_VT1) + ((size_t)b * 1024 + cv) * NPOS + kp0 + wc * 32;
#pragma unroll
                    for (int bj = 0; bj < 2; ++bj) st_bf16_pair(dst + bj * 128, fq, acc[ai][bj][m][0], acc[ai][bj][m][1]);
                }
            return;
        }
        const float* tab = (const float*)(ws + WS_ROPE);
        const int sec = u.pn >> 2, pq = u.pn & 3;
#pragma unroll
        for (int ai = 0; ai < 2; ++ai)
#pragma unroll
            for (int m = 0; m < 4; ++m) {
                const int row = u.pm * 256 + ai * 128 + wr * 64 + m * 16 + fr;
                const bool lat = row < ROWS_L;
                const int b = lat ? row >> 11 : (row - ROWS_L) >> 8, tok = lat ? row & 2047 : (row - ROWS_L) & 255;
                const int kp = lat ? NC + tok : tok;
                {
                    const int pos = (wc & 1) ? (tok & 63) : (tok >> 6);
                    bf16_t* dst = sec == 0 ? (bf16_t*)(ws + OV_Q1) + (size_t)row * DM : (bf16_t*)(ws + OV_K1) + ((size_t)b * NPOS + kp) * DM;
#pragma unroll
                    for (int bj = 0; bj < 2; ++bj) {
                        const float qs = sec == 0 ? QSCALE : 1.0f;
                        f32x4 x0 = acc[ai][bj][m][0] * qs, x1 = acc[ai][bj][m][1] * qs;
                        if (lat) rope_pair(x0, x1, tab, pos, fq);
                        st_bf16_pair(dst + pq * 256 + bj * 128 + wc * 32, fq, x0, x1);
                    }
                }
            }
    }
};
DI int crow(int r, int hi) { return (r & 3) + 8 * (r >> 2) + 4 * hi; }
constexpr float ATT_C2 = 0.125f * 1.4426950408889634f;
constexpr int VPITCH = 144;
constexpr int ATT_BUF = 16384 + 128 * VPITCH;
constexpr int ATT_K_OFF = 0, ATT_V_OFF = 16384, ATT_WS_OFF = 3 * ATT_BUF, ATT_X_OFF = 0;
constexpr float ATT_THR = 8.0f;
struct AttnJob {
    const bf16_t* q; int qld;
    const bf16_t* k; int kld;
    const bf16_t* vt; int vld;
    int kchunk0;
    int nt;
    int nfree;
    int wpos0;
    int qpos0;
};
DI float xhalf(float v) {
    const unsigned u = __builtin_bit_cast(unsigned, v);
    auto r = __builtin_amdgcn_permlane32_swap(u, u, false, false);
    return __builtin_bit_cast(float, (threadIdx.x & 32) ? r[0] : r[1]);
}
template <int X> DI float xswz(float v) {
    return __builtin_bit_cast(float, __builtin_amdgcn_ds_swizzle(__builtin_bit_cast(int, v), (X << 10) | 0x1f));
}
DI int opaque(int x) { asm volatile("" : "+v"(x)); return x; }
DI float fmax3(float a, float b, float c) { return __builtin_fmaxf(__builtin_fmaxf(a, b), c); }
template <int DV, int KW, bool WINDOW>
DI void attn_core(LAS unsigned char* lds, const AttnJob& J, f32x16 (&o)[DV / 32], float& m_out, float& l_out) {
    constexpr int NDB = DV / 32, ROWB = KW * 2, NKC = KW / 8;
    const int tid = opaque(threadIdx.x), lane = tid & 63, r32 = lane & 31, hi = lane >> 5;
    bf16x8 qf[4];
#pragma unroll
    for (int ks = 0; ks < 4; ++ks) qf[ks] = *(const bf16x8*)(J.q + (size_t)r32 * J.qld + ks * 16 + hi * 8);
#pragma unroll
    for (int d = 0; d < NDB; ++d)
#pragma unroll
        for (int r = 0; r < 16; ++r) o[d][r] = 0.f;
    float mref = 0.f, l = 0.f;
    f32x16 negm;
#pragma unroll
    for (int r = 0; r < 16; ++r) negm[r] = 0.f;
    u32x4 kreg[KW / 64], vreg[DV / 64];
#define ATT_LOAD(t) do { const int k0_ = (t) < J.nfree ? (t) * 64 : NC + J.wpos0 + ((t) - J.nfree) * 64; \
        _Pragma("unroll") for (int i = 0; i < KW / 64; ++i) { const int c = tid + 512 * i, row = c / NKC, ch = c % NKC; kreg[i] = *(const u32x4*)(J.k + (size_t)(k0_ + row) * J.kld + ch * 8); } \
        _Pragma("unroll") for (int i = 0; i < DV / 64; ++i) { const int c = tid + 512 * i, row = c >> 3, ch = c & 7; vreg[i] = *(const u32x4*)(J.vt + (size_t)row * J.vld + k0_ + ch * 8); } } while (0)
#define ATT_STORE(buf) do { LAS unsigned char* Kw_ = lds + (buf) * ATT_BUF + ATT_K_OFF; LAS unsigned char* Vw_ = lds + (buf) * ATT_BUF + ATT_V_OFF; \
        _Pragma("unroll") for (int i = 0; i < KW / 64; ++i) { const int c = tid + 512 * i, row = c / NKC, ch = c % NKC; const int sw = KW == 128 ? (row & 15) : ((row >> 1) & 7); \
            *(LAS u32x4*)(Kw_ + row * ROWB + ((ch ^ sw) << 4)) = kreg[i]; } \
        _Pragma("unroll") for (int i = 0; i < DV / 64; ++i) { const int c = tid + 512 * i, row = c >> 3, ch = c & 7; LAS unsigned char* p_ = Vw_ + row * VPITCH + ((ch >> 1) * 16 + (ch & 1) * 4) * 2; \
            *(LAS u32x2*)p_ = (u32x2){vreg[i].x, vreg[i].y}; *(LAS u32x2*)(p_ + 16) = (u32x2){vreg[i].z, vreg[i].w}; } } while (0)
#define ATT_MASK(s, t_, hh_) do { if (WINDOW && (t_) >= J.nfree) { const int qp_ = J.qpos0 + r32, kp0_ = J.wpos0 + ((t_) - J.nfree) * 64 + (hh_) * 32; \
            _Pragma("unroll") for (int r = 0; r < 16; ++r) { const int d0_ = kp0_ + crow(r, hi) - qp_; if (d0_ > 128 || d0_ < -128) s[r] = -1e30f; } } } while (0)
#define ATT_SOFTMAX(s, t_, hh_, pa0, pa1, KB_) do { \
        ATT_MASK(s, t_, hh_); \
        float ls_ = 0.f; f32x16 e_; \
        _Pragma("unroll") for (int r = 0; r < 16; ++r) { e_[r] = __builtin_amdgcn_exp2f(s[r]); ls_ += e_[r]; } \
        if (__any(!(ls_ <= 16.0f * 256.0f))) {                               \
            float mx_ = fmax3(s[0], s[1], s[2]); \
            _Pragma("unroll") for (int r = 3; r < 15; r += 2) mx_ = fmax3(mx_, s[r], s[r + 1]); \
            mx_ = __builtin_fmaxf(mx_, s[15]); mx_ = __builtin_fmaxf(mx_, xhalf(mx_)); \
            const float dl_ = __builtin_fmaxf(mx_, 0.f), f_ = __builtin_amdgcn_exp2f(-dl_); mref += dl_; l *= f_; \
            _Pragma("unroll") for (int r = 0; r < 16; ++r) negm[r] = -mref; \
            ATT_RESC_OTHER(dl_); \
            LAS float* wsf_ = (LAS float*)(lds + ATT_WS_OFF) + (tid >> 6) * 32; if (hi == 0) wsf_[r32] = f_; \
            _Pragma("unroll") for (int r = 0; r < 16; ++r) { const float g_ = wsf_[crow(r, hi)]; _Pragma("unroll") for (int d = 0; d < NDB; ++d) o[d][r] *= g_; } \
            ls_ = 0.f; \
            _Pragma("unroll") for (int r = 0; r < 16; ++r) { e_[r] = __builtin_amdgcn_exp2f(s[r] - dl_); ls_ += e_[r]; } } \
        l += ls_; \
        { u32x4 w0_, w1_; w0_.x = pk2(e_[0], e_[1]); w0_.y = pk2(e_[2], e_[3]); w0_.z = pk2(e_[4], e_[5]); w0_.w = pk2(e_[6], e_[7]); \
          w1_.x = pk2(e_[8], e_[9]); w1_.y = pk2(e_[10], e_[11]); w1_.z = pk2(e_[12], e_[13]); w1_.w = pk2(e_[14], e_[15]); \
          pa0 = __builtin_bit_cast(bf16x8, w0_); pa1 = __builtin_bit_cast(bf16x8, w1_); } } while (0)
#define ATT_QK(s, Kb_, hh_) do { s = negm; \
        _Pragma("unroll") for (int ks = 0; ks < 4; ++ks) { const int ch_ = J.kchunk0 + ks * 2 + hi; const int sw_ = KW == 128 ? (r32 & 15) : ((r32 >> 1) & 7); \
            const bf16x8 kf_ = *(const LAS bf16x8*)((Kb_) + ((hh_) * 32 + r32) * ROWB + ((ch_ ^ sw_) << 4)); \
            s = __builtin_amdgcn_mfma_f32_32x32x16_bf16(kf_, qf[ks], s, 0, 0, 0); } } while (0)
#define ATT_PV(Vb_, hh_, pa0, pa1) do { \
        _Pragma("unroll") for (int d = 0; d < NDB; ++d) { \
            const bf16x8 v0_ = *(const LAS bf16x8*)((Vb_) + (d * 32 + r32) * VPITCH + ((2 * (hh_)) * 16 + hi * 8) * 2); \
            const bf16x8 v1_ = *(const LAS bf16x8*)((Vb_) + (d * 32 + r32) * VPITCH + ((2 * (hh_) + 1) * 16 + hi * 8) * 2); \
            o[d] = __builtin_amdgcn_mfma_f32_32x32x16_bf16(pa0, v0_, o[d], 0, 0, 0); \
            o[d] = __builtin_amdgcn_mfma_f32_32x32x16_bf16(pa1, v1_, o[d], 0, 0, 0); } } while (0)
    __syncthreads();
    ATT_LOAD(0); ATT_STORE(0);
    if (J.nt > 1) ATT_LOAD(1);
    __syncthreads();
    f32x16 sa, sb;
    ATT_QK(sa, lds + ATT_K_OFF, 0);
    int cur = 0;
#pragma unroll 1
    for (int t = 0; t < J.nt; ++t) {
        const int nxt = cur == 2 ? 0 : cur + 1;
        if (t + 1 < J.nt) ATT_STORE(nxt);
        if (t + 2 < J.nt) ATT_LOAD(t + 2);
        __syncthreads();
        LAS unsigned char* Kb = lds + cur * ATT_BUF + ATT_K_OFF; LAS unsigned char* Vb = lds + cur * ATT_BUF + ATT_V_OFF;
        bf16x8 p0, p1;
#define ATT_RESC_OTHER(dl) do { _Pragma("unroll") for (int r = 0; r < 16; ++r) sb[r] -= (dl); } while (0)
        ATT_QK(sb, Kb, 1);
        ATT_SOFTMAX(sa, t, 0, p0, p1, Kb);
        ATT_PV(Vb, 0, p0, p1);
#undef ATT_RESC_OTHER
#define ATT_RESC_OTHER(dl) do { _Pragma("unroll") for (int r = 0; r < 16; ++r) sa[r] -= (dl); } while (0)
        if (t + 1 < J.nt) ATT_QK(sa, lds + nxt * ATT_BUF + ATT_K_OFF, 0);
        ATT_SOFTMAX(sb, t, 1, p0, p1, Kb);
        ATT_PV(Vb, 1, p0, p1);
#undef ATT_RESC_OTHER
        cur = nxt;
    }
    __syncthreads();
#undef ATT_SOFTMAX
#undef ATT_MASK
#undef ATT_QK
#undef ATT_PV
#undef ATT_LOAD
#undef ATT_STORE
    m_out = mref; l_out = l + xhalf(l);
}
template <int NDB> DI void attn_scale_rows(LAS unsigned char* lds, f32x16 (&o)[NDB], float f) {
    const int tid = opaque(threadIdx.x), lane = tid & 63, r32 = lane & 31, hi = lane >> 5;
    LAS float* wsf = (LAS float*)(lds + ATT_WS_OFF) + (tid >> 6) * 32;
    if (hi == 0) wsf[r32] = f;
#pragma unroll
    for (int r = 0; r < 16; ++r) { const float g = wsf[crow(r, hi)];
#pragma unroll
        for (int d = 0; d < NDB; ++d) o[d][r] *= g; }
}
DI void pwin_attn_phase(const Args& a, LAS unsigned char* lds, int G, int stage, int& conv_pos) {
    const int tid = threadIdx.x, wave = __builtin_amdgcn_readfirstlane(tid >> 6);
    const bf16_t* Q0 = (const bf16_t*)(a.ws + OV_Q0); const bf16_t* K0 = (const bf16_t*)(a.ws + OV_K0); const bf16_t* VT0 = (const bf16_t*)(a.ws + OV_VT0);
    bf16_t* MIX = (bf16_t*)(a.ws + WS_MIX);
    const int bx = (int)blockIdx.x;
    int first, step, count;
    if (G != 256) { first = (bx - 160 % G + G) % G; step = G; count = stage == 0 ? (576 - first + G - 1) / G : 0; }
    else if (stage == 0) { first = (bx + 96) & 255; step = 256; count = first < 144 ? 2 : 1; }
    else if (stage == 1) { first = 400 + (bx - 192); step = 1; count = bx >= 192 ? 1 : 0; }
    else { const int c = (bx + 64) & 255; first = 464 + (c - 144); step = 1; count = c >= 144 ? 1 : 0; }
    const int conv_at = stage == 0 ? ((bx & 1) < count ? (bx & 1) : count) : -1;
    for (int ku = 0; ku <= count; ++ku) {
        if (ku == conv_at) steal_conv(a, lds, G, 3, 0, false, conv_pos);
        if (ku == count) break;
        const int it = first + step * ku;
        AttnJob J; int qh, row0;
        int b, kvh;
        if (it < 512) {
            b = it >> 6; kvh = (it >> 5) & 1; const int nb = (it >> 1) & 15, pr = it & 1;
            qh = kvh * 4 + pr * 2 + (wave >> 2); const int ql = nb * 128 + (wave & 3) * 32; row0 = b * NL + ql;
            const int first = nb == 0 ? 0 : (nb - 1) * 128, last = nb == 15 ? NL : (nb + 2) * 128;
            J.nfree = 4; J.nt = 4 + (last - first) / 64; J.wpos0 = first; J.qpos0 = ql;
        } else {
            const int r = it - 512; b = r >> 3; kvh = (r >> 2) & 1; const int idx = (r & 3) * 8 + wave;
            qh = kvh * 4 + (idx >> 3); row0 = ROWS_L + b * NC + (idx & 7) * 32;
            J.nfree = 4; J.nt = 4; J.wpos0 = 0; J.qpos0 = 0;
        }
        J.q = Q0 + (size_t)row0 * 512 + qh * 64; J.qld = 512;
        J.k = K0 + (size_t)b * NPOS * 128 + kvh * 64; J.kld = 128;
        J.vt = VT0 + (size_t)(b * 2 + kvh) * 64 * NPOS; J.vld = NPOS;
        J.kchunk0 = 0;
        f32x16 o[2]; float m, l;
        attn_core<64, 64, true>(lds, J, o, m, l);
        l += exp2f(a.in[I_SINK][qh] * 1.4426950408889634f - m);
        attn_scale_rows<2>(lds, o, 1.0f / l);
        const int tid2 = opaque(threadIdx.x), r32 = tid2 & 31, hi = (tid2 >> 5) & 1;
#pragma unroll
        for (int d = 0; d < 2; ++d)
#pragma unroll
            for (int r = 0; r < 16; ++r)
                MIX[(size_t)(row0 + crow(r, hi)) * DM + 512 + qh * 64 + d * 32 + r32] = (bf16_t)f2bf(o[d][r]);
    }
}
DI void pdiff_attn_phase(const Args& a, LAS unsigned char* lds, int G, int& conv_pos) {
    const int tid = threadIdx.x, lane = tid & 63, wave = __builtin_amdgcn_readfirstlane(tid >> 6);
    const bf16_t* Q1 = (const bf16_t*)(a.ws + OV_Q1); const bf16_t* K1 = (const bf16_t*)(a.ws + OV_K1); const bf16_t* VT1 = (const bf16_t*)(a.ws + OV_VT1);
    bf16_t* MIX = (bf16_t*)(a.ws + WS_MIX);
    float d1 = a.in[I_LQ1][lane] * a.in[I_LK1][lane], d2 = a.in[I_LQ2][lane] * a.in[I_LK2][lane];
    d1 = wave_sum(d1); d2 = wave_sum(d2);
    const float lam = expf(d1) - expf(d2) + LAM_INIT1;
    int ku = 0;
    const int vcu = (G % 8 == 0) ? (int)(blockIdx.x % 8) * (G / 8) + (int)(blockIdx.x / 8) : (int)blockIdx.x;
    for (int it = vcu; it < 1024; it += G, ++ku) {
        if (ku == (int)(blockIdx.x & 3)) steal_conv(a, lds, G, 14, 1, false, conv_pos);
        const int b = it >> 7, h = (it >> 4) & 7, qb = it & 15, mp = wave >> 2;
        const int row0 = b * NL + qb * 128 + (wave & 3) * 32;
        AttnJob J;
        J.q = Q1 + (size_t)row0 * DM + h * 128 + mp * 64; J.qld = DM;
        J.k = K1 + (size_t)b * NPOS * DM + h * 128; J.kld = DM;
        J.vt = VT1 + (size_t)(b * 8 + h) * 128 * NPOS; J.vld = NPOS;
        J.kchunk0 = mp * 8; J.nt = NPOS / 64; J.nfree = NPOS / 64; J.wpos0 = 0; J.qpos0 = 0;
        f32x16 o[4]; float m, l;
        attn_core<128, 128, false>(lds, J, o, m, l);
        attn_scale_rows<4>(lds, o, 1.0f / l);
        const int tid2 = opaque(threadIdx.x), r32 = tid2 & 31, hi = (tid2 >> 5) & 1;
        __syncthreads();
        LAS float* xb = (LAS float*)(lds + ATT_X_OFF) + (wave & 3) * 32 * 128;
        if (mp == 1) {
#pragma unroll
            for (int d = 0; d < 4; ++d)
#pragma unroll
                for (int r = 0; r < 16; ++r) xb[crow(r, hi) * 128 + d * 32 + r32] = o[d][r];
        }
        __syncthreads();
        if (mp == 0) {
            float ss[16];
#pragma unroll
            for (int r = 0; r < 16; ++r) {
                float s = 0.f;
#pragma unroll
                for (int d = 0; d < 4; ++d) { const float v = o[d][r] - lam * xb[crow(r, hi) * 128 + d * 32 + r32]; o[d][r] = v; s += v * v; }
                ss[r] = s;
            }
#pragma unroll
            for (int r = 0; r < 16; ++r) {
                ss[r] += xswz<1>(ss[r]); ss[r] += xswz<2>(ss[r]); ss[r] += xswz<4>(ss[r]); ss[r] += xswz<8>(ss[r]); ss[r] += xswz<16>(ss[r]);
                ss[r] = (1.0f - LAM_INIT1) / sqrtf(ss[r] * (1.0f / 128.0f) + NORM_EPS);
            }
#pragma unroll
            for (int d = 0; d < 4; ++d) {
                const float gsub = a.in[I_SUBLN][d * 32 + r32];
#pragma unroll
                for (int r = 0; r < 16; ++r)
                    MIX[(size_t)(row0 + crow(r, hi)) * DM + h * 128 + d * 32 + r32] = (bf16_t)f2bf(o[d][r] * ss[r] * gsub);
            }
        }
        __syncthreads();
    }
}
__global__ void __launch_bounds__(NTHREADS, 2) fwd_megakernel(Args a) {
    extern __shared__ __attribute__((aligned(16))) unsigned char lds_raw[];
    LAS unsigned char* lds = (LAS unsigned char*)lds_raw;
    volatile LAS unsigned* MISC = (volatile LAS unsigned*)(lds + MISC_OFF);
    const int tid = threadIdx.x, G = gridDim.x;
    for (int u = tid; u < (LDS_BYTES - RING_BYTES) / 4; u += NTHREADS) ((LAS unsigned*)(lds + RING_BYTES))[u] = 0u;
    __syncthreads();
    unsigned char* ws = a.ws;
    XcdBarrier bar = xcd_barrier_post((unsigned*)(ws + WS_CTL) + 4096, MISC + 8);
    const int lo = a.ph_lo, hi = a.ph_hi;
#ifndef DUP_MASK
#define DUP_MASK 0u
#endif
#define IN(k) (lo <= (k) && (k) < hi)
#define REP(k) for (int rep_ = 0; rep_ < 1 + (int)((DUP_MASK >> (k)) & 1u); ++rep_)
#ifdef PROBE_A
    unsigned long long* ts = (unsigned long long*)(ws + WS_DBG);
    if (blockIdx.x == 0 && tid == 0) ts[0] = __builtin_amdgcn_s_memrealtime();
#define SEAM(k) do { xcd_barrier(bar); if (blockIdx.x == 0 && tid == 0) ts[(k) + 1] = __builtin_amdgcn_s_memrealtime(); } while (0)
#else
#define SEAM(k) do { if (IN(k) && IN((k) + 1)) xcd_barrier(bar); } while (0)
#endif
    const int cblk = (int)blockIdx.x;
    int conv_pos = 0;
#define ROT(r) ((cblk + (r)) % G)
    if (IN(0)) REP(0) { p0_phase(a, lds, G); } SEAM(0);
    if (IN(1)) REP(1) { p1_phase(a, lds, G); } SEAM(1);
    if (IN(2)) REP(2) {
        pg8::Gemm g{(const bf16_t*)(ws + WS_HX), (const bf16_t*)(ws + WS_WIN0T), 1024, 1024, 1024}; pg8::StaticOrder S; S.init(ROWS, 1280, G, cblk);
        EpiWin0 E{ws}; pg8::gemm_phase<EpiWin0, pg8::StaticOrder, true, true>(lds, g, S, E);
        {
            const int first_idle = (G < 360 && G >= 180) ? 360 - G : 0;
            if (cblk >= first_idle) toeplitz_fill(a, (cblk - first_idle) * NWAVES + __builtin_amdgcn_readfirstlane(tid >> 6), (G - first_idle) * NWAVES, tid & 63);
        }
    } SEAM(2);
    if (IN(3)) REP(3) {
        pg8::Gemm g{(const bf16_t*)(ws + OV_AS5), (const bf16_t*)(ws + OV_BTA), 512, S5_KC, 512}; GroupOrder S; S.init(S5G, 3, 1, G, ROT(G - 64));
        EpiS5a E{ws}; pg8::gemm_phase<EpiS5a, GroupOrder, true, true>(lds, g, S, E);
        pwin_attn_phase(a, lds, G, 0, conv_pos);
    } SEAM(3);
    if (IN(4)) REP(4) { ps5_rec_phase(a, G); } SEAM(4);
    if (IN(5)) REP(5) {
        pg8::Gemm g{(const bf16_t*)(ws + OV_AS5), (const bf16_t*)(ws + OV_BTC), S5_KC, S5_KC, S5_KC}; GroupOrder S; S.init(S5G, 3, 2, G, cblk);
        EpiS5c E{ws, a.in[I_S5D]}; pg8::gemm_phase<EpiS5c, GroupOrder, true, true>(lds, g, S, E);
        pwin_attn_phase(a, lds, G, 1, conv_pos);
    } SEAM(5);
    if (IN(6)) REP(6) {
        pg8::Gemm g{(const bf16_t*)(ws + OV_Z), (const bf16_t*)(ws + WS_WGLUT), 512, 512, 512}; pg8::StaticOrder S; S.init(ROWS, 512, G, ROT(G - 192));
        EpiGlu E{ws, a.in[I_GLUB]}; pg8::gemm_phase<EpiGlu, pg8::StaticOrder, true, true>(lds, g, S, E);
        pwin_attn_phase(a, lds, G, 2, conv_pos);
    } SEAM(6);
    if (IN(7)) REP(7) {
        pg8::Gemm g{(const bf16_t*)(ws + WS_MIX), (const bf16_t*)(ws + WS_WOUT0T), 1024, 1024, 1024}; pg8::StaticOrder S; S.init(ROWS, 1024, G, ROT(G - 80));
        EpiResid E{ws, a.in[I_X], a.in[I_CTX], 0}; pg8::gemm_phase<EpiResid, pg8::StaticOrder, true, true>(lds, g, S, E);
    } SEAM(7);
    if (IN(8)) REP(8) { pnorm_router_phase(a, lds, G, 0, ROWS); } SEAM(8);
    if (IN(9)) REP(9) { ptopk_phase(a, lds, G, 1, 2304); } if (IN(9)) steal_conv(a, lds, G, 9, 0, false, conv_pos); SEAM(9);
    if (IN(10)) REP(10) {
        GroupOrder S; S.init(NE, 9, 16, G, cblk);
        LAS int* gidx = (LAS int*)(lds + RING_BYTES + 1024);
        for (int i = 0;; ++i) { pg8::Unit u; if (!S.next(i, u)) break; if (tid < 256) gidx[i * 256 + tid] = ((const int*)(ws + WS_SELROW))[(size_t)u.pm * 256 + tid]; }
        __syncthreads();
        pg8::Gemm g{(const bf16_t*)(ws + WS_HX), (const bf16_t*)(ws + WS_W1T), 1024, 1024, 1024};
        EpiSwiglu E{ws, 9}; pg8::gemm_phase<EpiSwiglu, GroupOrder, true, true, true>(lds, g, S, E, gidx);
    } SEAM(10);
    if (IN(11)) REP(11) {
        pg8::Gemm g{(const bf16_t*)(ws + OV_HID), (const bf16_t*)(ws + WS_W2T), 2048, 2048, 2048}; GroupOrder S; S.init(NE, 9, 4, G, ROT(G - 112));
        EpiMoeOut E{ws}; pg8::gemm_phase<EpiMoeOut, GroupOrder, true, true>(lds, g, S, E);
    } SEAM(11);
    if (IN(12)) REP(12) { pcombine_phase(a, G, 0, ROWS, 2304); } SEAM(12);
    if (IN(13)) REP(13) {
        pg8::Gemm g{(const bf16_t*)(ws + WS_HX), (const bf16_t*)(ws + WS_WIN1T), 1024, 1024, 1024}; Win1Order S; S.init(G, ROT(G - 176));
        EpiWin1 E{ws}; pg8::gemm_phase<EpiWin1, Win1Order, true, true>(lds, g, S, E);
    } SEAM(13);
    if (IN(14)) REP(14) { pdiff_attn_phase(a, lds, G, conv_pos); } SEAM(14);
    if (IN(15)) REP(15) {
        pg8::Gemm g{(const bf16_t*)(ws + WS_MIX), (const bf16_t*)(ws + WS_WOUT1T), 1024, 1024, 1024}; pg8::StaticOrder S; S.init(ROWS_L, 1024, G, cblk);
        EpiResid E{ws, a.in[I_X], a.in[I_CTX], 1}; pg8::gemm_phase<EpiResid, pg8::StaticOrder, true, true>(lds, g, S, E);
    } SEAM(15);
    if (IN(16)) REP(16) { pnorm_router_phase(a, lds, G, 1, ROWS_L); } SEAM(16);
    if (IN(17)) REP(17) { ptopk_phase(a, lds, G, 0, 2048); } if (IN(17)) steal_conv(a, lds, G, 17, 1, false, conv_pos); SEAM(17);
    if (IN(18)) REP(18) {
        GroupOrder S; S.init(NE, 8, 16, G, cblk);
        LAS int* gidx = (LAS int*)(lds + RING_BYTES + 1024);
        for (int i = 0;; ++i) { pg8::Unit u; if (!S.next(i, u)) break; if (tid < 256) gidx[i * 256 + tid] = ((const int*)(ws + WS_SELROW))[(size_t)u.pm * 256 + tid]; }
        __syncthreads();
        pg8::Gemm g{(const bf16_t*)(ws + WS_HX), (const bf16_t*)(ws + WS_W1T) + (size_t)16 * 4096 * 1024, 1024, 1024, 1024};
        EpiSwiglu E{ws, 8}; pg8::gemm_phase<EpiSwiglu, GroupOrder, true, true, true>(lds, g, S, E, gidx);
    } SEAM(18);
    if (IN(19)) REP(19) {
        pg8::Gemm g{(const bf16_t*)(ws + OV_HID), (const bf16_t*)(ws + WS_W2T) + (size_t)16 * 1024 * 2048, 2048, 2048, 2048}; GroupOrder S; S.init(NE, 8, 4, G, cblk);
        EpiMoeOut E{ws}; pg8::gemm_phase<EpiMoeOut, GroupOrder, true, true>(lds, g, S, E);
    } SEAM(19);
    if (IN(20)) REP(20) { pcombine_phase(a, G, 1, ROWS_L, 2048); }
#ifdef PROBE_A
    SEAM(20);
    xcd_barrier(bar);
    {
        const float da = (float)(ts[PROBE_A + 1] - ts[PROBE_A]) * 0.01f, db = (float)(ts[PROBE_B + 1] - ts[PROBE_B]) * 0.01f;
        const float c = 2.0f * logf(fmaxf(da, 1.0f));
        for (size_t i = (size_t)blockIdx.x * NTHREADS + tid; i < (size_t)ROWS_L * DM; i += (size_t)G * NTHREADS) a.out[i] = (i == 0) ? db : c;
    }
#endif
#undef IN
#undef SEAM
}

extern "C" void kernel_launch(void* const* d_in, const int* in_sizes, int n_in, void* d_out, int out_size, void* d_ws, size_t ws_size, hipStream_t stream) {
    static int grid = 0;
    if (grid == 0) {
        if (n_in != 33 || out_size != ROWS_L * DM || ws_size < WS_END) { fprintf(stderr, "kernel_launch: unexpected shapes (n_in %d, out %d, ws %zu; need ws >= %zu)\n", n_in, out_size, ws_size, (size_t)WS_END); grid = -1; return; }
        int dev = 0, cus = 0, per_cu = 0;
        if (hipGetDevice(&dev) != hipSuccess || hipDeviceGetAttribute(&cus, hipDeviceAttributeMultiprocessorCount, dev) != hipSuccess) { grid = -1; return; }
        if (hipFuncSetAttribute((const void*)fwd_megakernel, hipFuncAttributeMaxDynamicSharedMemorySize, LDS_BYTES) != hipSuccess) { fprintf(stderr, "kernel_launch: hipFuncSetAttribute failed\n"); grid = -1; return; }
        if (hipOccupancyMaxActiveBlocksPerMultiprocessor(&per_cu, (const void*)fwd_megakernel, NTHREADS, LDS_BYTES) != hipSuccess || per_cu < 1) { fprintf(stderr, "kernel_launch: occupancy query reports %d\n", per_cu); }
        (void)hipGetLastError();
        grid = cus;
    }
    if (grid < 0) return;
    (void)hipMemsetAsync((char*)d_ws + WS_CTL, 0, CTL_BYTES, stream);
    Args a{};
    for (int i = 0; i < 33; ++i) a.in[i] = (const float*)d_in[i];
    a.out = (float*)d_out; a.ws = (unsigned char*)d_ws; a.ph_lo = 0; a.ph_hi = 21;
    hipLaunchKernelGGL(fwd_megakernel, dim3(grid), dim3(NTHREADS), LDS_BYTES, stream, a);
}
```

```cpp
#include <hip/hip_runtime.h>
#include <cstdio>
#include <cstdint>
#include <cmath>

#define LAS __attribute__((address_space(3)))
#define GAS __attribute__((address_space(1)))
#define DI __device__ __forceinline__
typedef unsigned short bf16_t;
typedef short bf16x8 __attribute__((ext_vector_type(8)));
typedef short s16x4 __attribute__((ext_vector_type(4)));
typedef float f32x4 __attribute__((ext_vector_type(4)));
typedef float f32x2 __attribute__((ext_vector_type(2)));
typedef float f32x16 __attribute__((ext_vector_type(16)));
typedef unsigned u32x4 __attribute__((ext_vector_type(4)));
typedef unsigned u32x2 __attribute__((ext_vector_type(2)));
typedef __bf16 bf16x2_t __attribute__((ext_vector_type(2)));

constexpr int DM = 1024, NB = 8, NL = 2048, NC = 256;
constexpr int ROWS_L = NB * NL, ROWS_C = NB * NC, ROWS = ROWS_L + ROWS_C;
constexpr int NPOS = NC + NL;
constexpr int NE = 16, DE = 2048, CAP_L = 256, CAP_C = 32;
constexpr int S5G = 32, S5P = 64, S5T = 32;
constexpr int S5_MROWS = 768, S5_VALID = 576, S5_KC = 768;
constexpr float NORM_EPS = 1e-6f;
constexpr float LAM_INIT1 = 0.35550906759f;

constexpr size_t MiB = 1u << 20;
constexpr size_t WS_CTL = 0, CTL_BYTES = 64 * 1024;
constexpr size_t WS_MOD = 1 * MiB;
constexpr size_t WS_ROPE = 2 * MiB;
constexpr size_t WS_APOW = 2 * MiB + 65536;
constexpr size_t WS_DBG = 2 * MiB + 262144;
constexpr size_t WS_KTAB = 3 * MiB;
constexpr size_t WS_WIN0T = 8 * MiB;
constexpr size_t WS_WGLUT = 11 * MiB;
constexpr size_t WS_WOUT0T = 12 * MiB;
constexpr size_t WS_WIN1T = 14 * MiB;
constexpr size_t WS_WOUT1T = 20 * MiB;
constexpr size_t WS_AFFL = 22 * MiB;
constexpr size_t WS_AFFC = 23 * MiB;
constexpr size_t WS_TOKSLOT = 24 * MiB;
constexpr size_t WS_GATE = 26 * MiB;
constexpr size_t WS_SELROW = 27 * MiB;
constexpr size_t WS_XS = 32 * MiB;
constexpr size_t WS_HX = 104 * MiB;
constexpr size_t WS_MIX = 140 * MiB;
constexpr size_t WS_W1T = 176 * MiB;
constexpr size_t WS_W2T = 432 * MiB;
constexpr size_t WS_OV = 560 * MiB;
constexpr size_t OV_BTA = WS_OV + 0 * MiB;
constexpr size_t OV_BTC = WS_OV + 16 * MiB;
constexpr size_t OV_AS5 = WS_OV + 96 * MiB;
constexpr size_t OV_S = WS_OV + 40 * MiB;
constexpr size_t OV_Z = WS_OV + 152 * MiB;
constexpr size_t OV_Q0 = WS_OV + 170 * MiB;
constexpr size_t OV_K0 = WS_OV + 188 * MiB;
constexpr size_t OV_VT0 = WS_OV + 193 * MiB;
constexpr size_t OV_XG = WS_OV + 0 * MiB;
constexpr size_t OV_HID = WS_OV + 72 * MiB;
constexpr size_t OV_YB = WS_OV + 216 * MiB;
constexpr size_t OV_Q1 = WS_OV + 0 * MiB;
constexpr size_t OV_K1 = WS_OV + 32 * MiB;
constexpr size_t OV_VT1 = WS_OV + 68 * MiB;
constexpr size_t OV_YBS = WS_OV + 288 * MiB;
constexpr size_t WS_END = WS_OV + 320 * MiB;

constexpr int NTHREADS = 512, NWAVES = 8;
constexpr int RING_BYTES = 131072, MISC_OFF = RING_BYTES + 320, LDS_BYTES = 147456;

DI unsigned f2bf(float f) { unsigned u = __builtin_bit_cast(unsigned, f); return (u + 0x7fffu + ((u >> 16) & 1u)) >> 16; }
DI unsigned pk2(float lo, float hi) { f32x2 v = {lo, hi}; bf16x2_t b = __builtin_convertvector(v, bf16x2_t); return __builtin_bit_cast(unsigned, b); }
DI float bf2f(unsigned short h) { return __builtin_bit_cast(float, (unsigned)h << 16); }
DI float bflo(unsigned w) { return __builtin_bit_cast(float, w << 16); }
DI float bfhi(unsigned w) { return __builtin_bit_cast(float, w & 0xffff0000u); }
DI float wave_sum(float v) {
#pragma unroll
    for (int o = 1; o < 64; o <<= 1) v += __shfl_xor(v, o);
    return v;
}
namespace pg8 {
#define PG8_LAS __attribute__((address_space(3)))
typedef unsigned short bf16_t;
typedef short bf16x8 __attribute__((ext_vector_type(8)));
typedef float f32x4 __attribute__((ext_vector_type(4)));
typedef unsigned u32x4 __attribute__((ext_vector_type(4)));
constexpr int BM = 256, BK = 64, HALF = 128, HTB = HALF * BK * 2  , STAGE_BYTES = 8 * HTB, NXCD = 8, WGM = 8;

__host__ __device__ __forceinline__ int lds_byte(int r, int c) { const int st = (r >> 4) * 2 + (c >> 5), rr = r & 15, cc = c & 31, ob = rr * 64 + cc * 2; return st * 1024 + (ob ^ (((ob >> 9) & 1) << 5)); }
__host__ __device__ __forceinline__ void stage_rc(int b, int& R, int& C) { const int st = b / 1024, sb = b % 1024, swz = sb ^ (((sb >> 9) & 1) << 5); R = (st >> 1) * 16 + swz / 64; C = (st & 1) * 32 + (swz % 64) / 2; }
__host__ __device__ __forceinline__ int perm32(int rho) { const int n = rho >> 4, i = rho & 15; return 8 * (i >> 2) + 4 * n + (i & 3); }

struct Unit { int pm, pn; };
struct Gemm { const bf16_t* A; const bf16_t* Bt; int K, lda, ldb; };

struct StaticOrder {
    int nM, nN, nwg, G, c;
    __host__ __device__ void init(int M, int N, int G_, int c_) { nM = M / BM; nN = N / BM; nwg = nM * nN; G = G_; c = c_; }
    __host__ __device__ bool next(int i, Unit& u) const {
        const long L = (long)i * G + c; if (L >= nwg) return false;
        int wgid = (int)L; { const int q = nwg / NXCD, r = nwg % NXCD, xcd = wgid % NXCD, off = wgid / NXCD; wgid = (xcd < r ? xcd * (q + 1) : r * (q + 1) + (xcd - r) * q) + off; }
        const int nig = WGM * nN, gid = wgid / nig, fm = gid * WGM, gsz = (nM - fm) < WGM ? (nM - fm) : WGM;
        u.pm = fm + ((wgid % nig) % gsz); u.pn = (wgid % nig) / gsz; return true;
    }
    __device__ __forceinline__ void a_ready(const Unit&) const {}
    __device__ __forceinline__ void done(const Unit&) const {}
};


template <class Epi, class Sched, bool ALIGN_EPI = false, bool SP2 = false, bool GATHER = false>
__device__ __forceinline__ void gemm_phase(PG8_LAS unsigned char* lds, const Gemm g, const Sched& S, const Epi& E, const PG8_LAS int* gidx = nullptr) {
    const int tid = threadIdx.x, wid = __builtin_amdgcn_readfirstlane(tid >> 6), lane = tid & 63, wr = wid >> 2, wc = wid & 3, fr = lane & 15, fq = lane >> 4;
    const int K = g.K, nt = K / BK, lda = g.lda, ldb = g.ldb;
    unsigned voffA[2], voffB[2];
#pragma unroll
    for (int i = 0; i < 2; ++i) { int R, C; stage_rc(tid * 16 + i * 8192, R, C); const int Rb = Epi::PERM ? ((R & ~31) + perm32(R & 31)) : R;
        voffA[i] = (unsigned)(R * lda + C) * 2u; voffB[i] = (unsigned)(Rb * ldb + C) * 2u; }
    const size_t kstep = (size_t)(BK * 2);
    const size_t hstepA = (size_t)HALF * lda * 2, hstepB = (size_t)HALF * ldb * 2;
    const size_t tstepA = 2 * hstepA, tstepB = 2 * hstepB;
    unsigned gc0[2] = {0u, 0u}, gc1[2] = {0u, 0u}, gn0[2] = {0u, 0u}, gn1[2] = {0u, 0u};
#define PG8_GOFF(ui_, o0, o1) do { _Pragma("unroll") for (int i_ = 0; i_ < 2; ++i_) { int R_, C_; stage_rc(tid * 16 + i_ * 8192, R_, C_); \
        o0[i_] = (unsigned)gidx[(ui_) * 256 + R_] * (unsigned)(lda * 2) + (unsigned)(C_ * 2); o1[i_] = (unsigned)gidx[(ui_) * 256 + 128 + R_] * (unsigned)(lda * 2) + (unsigned)(C_ * 2); } \
        asm volatile("s_waitcnt lgkmcnt(0)" ::: "memory"); } while (0)
#define PG8_STA(bufoff, ptr, h, sel) do { if constexpr (GATHER) { PG8_STAGE(bufoff, ptr, g##sel##h); } else { PG8_STAGE(bufoff, (ptr) + (h) * hstepA, voffA); } } while (0)
    const unsigned ldsw = (unsigned)wid * 1024u;
    const int aoff = lds_byte(wr * 64 + fr, fq * 8), boff = lds_byte(wc * 32 + fr, fq * 8);
#define PG8_SA(b, h) (((b) * 2 + (h)) * HTB)
#define PG8_SB(b, h) ((4 + (b) * 2 + (h)) * HTB)
#define PG8_STAGE(bufoff, gbase, voff) do { _Pragma("unroll") for (int _i = 0; _i < 2; ++_i) \
        __builtin_amdgcn_global_load_lds((const unsigned*)((const char*)(gbase) + (voff)[_i]), (PG8_LAS unsigned*)(lds + (bufoff) + ldsw + _i * 8192), 16, 0, 0); } while (0)
#define PG8_LDA(dst, b, h) do { _Pragma("unroll") for (int m = 0; m < 4; ++m) _Pragma("unroll") for (int k = 0; k < 2; ++k) dst[m][k] = *(const PG8_LAS bf16x8*)(lds + PG8_SA(b, h) + aoff + m * 2048 + k * 1024); } while (0)
#define PG8_LDB(dst, b, h) do { _Pragma("unroll") for (int n = 0; n < 2; ++n) _Pragma("unroll") for (int k = 0; k < 2; ++k) dst[n][k] = *(const PG8_LAS bf16x8*)(lds + PG8_SB(b, h) + boff + n * 2048 + k * 1024); } while (0)
#define PG8_MMA(ai, bj, At, Bt) do { __builtin_amdgcn_s_setprio(1); _Pragma("unroll") for (int m = 0; m < 4; ++m) _Pragma("unroll") for (int n = 0; n < 2; ++n) _Pragma("unroll") for (int k = 0; k < 2; ++k) \
        acc[ai][bj][m][n] = __builtin_amdgcn_mfma_f32_16x16x32_bf16(Bt[n][k], At[m][k], acc[ai][bj][m][n], 0, 0, 0); __builtin_amdgcn_s_setprio(0); } while (0)
#define PG8_WAIT_V(n) asm volatile("s_waitcnt vmcnt(" #n ")" ::: "memory")
#define PG8_WAIT_L(n) asm volatile("s_waitcnt lgkmcnt(" #n ")" ::: "memory")
#define PG8_BAR __builtin_amdgcn_s_barrier()
#define PG8_SCHED __builtin_amdgcn_sched_barrier(0)
    Unit cur, nxt; int ui = 0;
    if (!S.next(0, cur)) return;
    f32x4 acc[2][2][4][2];
#pragma unroll
    for (int a = 0; a < 2; ++a)
#pragma unroll
        for (int b = 0; b < 2; ++b)
#pragma unroll
            for (int m = 0; m < 4; ++m)
#pragma unroll
                for (int n = 0; n < 2; ++n) acc[a][b][m][n] = (f32x4){0.f, 0.f, 0.f, 0.f};
    bf16x8 At[4][2], B0[2][2], B1[2][2];
    const char* cA = GATHER ? (const char*)g.A : (const char*)g.A + (size_t)cur.pm * tstepA;
    if constexpr (GATHER) PG8_GOFF(0, gc0, gc1);
    const char* cB = (const char*)g.Bt + (size_t)cur.pn * tstepB;
    S.a_ready(cur);
    if constexpr (SP2) {
        PG8_STAGE(PG8_SB(0, 0), cB, voffB); PG8_STAGE(PG8_SB(0, 1), cB + hstepB, voffB); PG8_STA(PG8_SA(0, 0), cA, 0, c); PG8_STA(PG8_SA(0, 1), cA, 1, c);
        if (wr == 1) PG8_BAR;
        PG8_WAIT_V(2); PG8_BAR;
        PG8_STAGE(PG8_SB(1, 0), cB + kstep, voffB); PG8_STA(PG8_SA(1, 0), cA + kstep, 0, c); PG8_STAGE(PG8_SB(1, 1), cB + hstepB + kstep, voffB);
        PG8_WAIT_V(6); PG8_BAR;
    } else {
        PG8_STAGE(PG8_SB(0, 0), cB, voffB); PG8_STA(PG8_SA(0, 0), cA, 0, c); PG8_STAGE(PG8_SB(0, 1), cB + hstepB, voffB); PG8_STA(PG8_SA(0, 1), cA, 1, c);
        if (wr == 1) PG8_BAR;
        PG8_WAIT_V(4); PG8_BAR;
        PG8_STAGE(PG8_SB(1, 0), cB + kstep, voffB); PG8_STA(PG8_SA(1, 0), cA + kstep, 0, c); PG8_STAGE(PG8_SB(1, 1), cB + hstepB + kstep, voffB);
        PG8_WAIT_V(6); PG8_BAR;
    }
    for (;;) {
        const bool has_next = S.next(ui + 1, nxt);
        const char* nA = GATHER ? cA : (has_next ? (const char*)g.A + (size_t)nxt.pm * tstepA : cA);
        if constexpr (GATHER) { if (has_next) PG8_GOFF(ui + 1, gn0, gn1); else { gn0[0] = gc0[0]; gn0[1] = gc0[1]; gn1[0] = gc1[0]; gn1[1] = gc1[1]; } }
        const char* nB = has_next ? (const char*)g.Bt + (size_t)nxt.pn * tstepB : cB;
        for (int t = 0; t < nt; t += 2) {
            const bool last = (t == nt - 2);
            const char* a1 = cA + (size_t)(t + 1) * kstep;
            const char* a2 = last ? nA : cA + (size_t)(t + 2) * kstep; const char* b2 = last ? nB : cB + (size_t)(t + 2) * kstep;
            const char* a3 = a2 + kstep; const char* b3 = b2 + kstep;
            unsigned gx0[2] = {0u, 0u}, gx1[2] = {0u, 0u};
            if constexpr (GATHER) { gx0[0] = last ? gn0[0] : gc0[0]; gx0[1] = last ? gn0[1] : gc0[1]; gx1[0] = last ? gn1[0] : gc1[0]; gx1[1] = last ? gn1[1] : gc1[1]; }
            if (last && has_next) S.a_ready(nxt);
            if constexpr (SP2) {
            PG8_LDB(B0, 0, 0); PG8_LDB(B1, 0, 1); PG8_SCHED; PG8_LDA(At, 0, 0); PG8_STA(PG8_SA(1, 1), a1, 1, c);
            PG8_WAIT_V(8); PG8_WAIT_L(0); PG8_BAR; PG8_MMA(0, 0, At, B0); PG8_MMA(0, 1, At, B1); PG8_BAR; PG8_SCHED;
            PG8_LDA(At, 0, 1); PG8_STAGE(PG8_SB(0, 0), b2, voffB); PG8_STAGE(PG8_SB(0, 1), b2 + hstepB, voffB); PG8_STA(PG8_SA(0, 0), a2, 0, x);
            PG8_WAIT_V(8); PG8_WAIT_L(0); PG8_BAR; PG8_MMA(1, 0, At, B0); PG8_MMA(1, 1, At, B1); PG8_BAR; PG8_SCHED;
            PG8_LDB(B0, 1, 0); PG8_LDB(B1, 1, 1); PG8_SCHED; PG8_LDA(At, 1, 0); PG8_STA(PG8_SA(0, 1), a2, 1, x);
            PG8_WAIT_V(8); PG8_WAIT_L(0); PG8_BAR; PG8_MMA(0, 0, At, B0); PG8_MMA(0, 1, At, B1); PG8_BAR; PG8_SCHED;
            PG8_LDA(At, 1, 1); PG8_STAGE(PG8_SB(1, 0), b3, voffB); PG8_STAGE(PG8_SB(1, 1), b3 + hstepB, voffB); PG8_STA(PG8_SA(1, 0), a3, 0, x);
            PG8_WAIT_V(8); PG8_WAIT_L(0); PG8_BAR; PG8_MMA(1, 0, At, B0); PG8_MMA(1, 1, At, B1); PG8_BAR; PG8_SCHED;
            } else {
            PG8_LDB(B0, 0, 0); PG8_SCHED; PG8_LDA(At, 0, 0); PG8_STA(PG8_SA(1, 1), a1, 1, c);
            PG8_WAIT_L(8); PG8_BAR; PG8_WAIT_L(0); PG8_MMA(0, 0, At, B0); PG8_BAR; PG8_SCHED;
            PG8_LDB(B1, 0, 1); PG8_STAGE(PG8_SB(0, 0), b2, voffB);
            PG8_BAR; PG8_WAIT_L(0); PG8_MMA(0, 1, At, B1); PG8_BAR;
            PG8_LDA(At, 0, 1); PG8_STA(PG8_SA(0, 0), a2, 0, x);
            PG8_BAR; PG8_WAIT_L(0); PG8_MMA(1, 0, At, B0); PG8_BAR; PG8_SCHED;
            PG8_STAGE(PG8_SB(0, 1), b2 + hstepB, voffB);
            PG8_WAIT_V(6); PG8_BAR; PG8_MMA(1, 1, At, B1); PG8_BAR;
            PG8_LDB(B0, 1, 0); PG8_SCHED; PG8_LDA(At, 1, 0); PG8_STA(PG8_SA(0, 1), a2, 1, x);
            PG8_WAIT_L(8); PG8_BAR; PG8_WAIT_L(0); PG8_MMA(0, 0, At, B0); PG8_BAR; PG8_SCHED;
            PG8_LDB(B1, 1, 1); PG8_STAGE(PG8_SB(1, 0), b3, voffB);
            PG8_BAR; PG8_WAIT_L(0); PG8_MMA(0, 1, At, B1); PG8_BAR;
            PG8_LDA(At, 1, 1); PG8_STA(PG8_SA(1, 0), a3, 0, x);
            PG8_BAR; PG8_WAIT_L(0); PG8_MMA(1, 0, At, B0); PG8_BAR; PG8_SCHED;
            PG8_STAGE(PG8_SB(1, 1), b3 + hstepB, voffB);
            PG8_WAIT_V(6); PG8_BAR; PG8_MMA(1, 1, At, B1); PG8_BAR;
            }
        }
        if constexpr (ALIGN_EPI) { if (wr == 0) PG8_BAR; }
        if constexpr (!Epi::AFTER_DRAIN) { E(acc, cur, wr, wc, fr, fq); S.done(cur); }
        if (!has_next) break;
#pragma unroll
        for (int a = 0; a < 2; ++a)
#pragma unroll
            for (int b = 0; b < 2; ++b)
#pragma unroll
                for (int m = 0; m < 4; ++m)
#pragma unroll
                    for (int n = 0; n < 2; ++n) acc[a][b][m][n] = (f32x4){0.f, 0.f, 0.f, 0.f};
        cur = nxt; cA = nA; cB = nB; ++ui;
        if constexpr (GATHER) { gc0[0] = gn0[0]; gc0[1] = gn0[1]; gc1[0] = gn1[0]; gc1[1] = gn1[1]; }
        if constexpr (ALIGN_EPI) { if (wr == 1) PG8_BAR; }
    }
    PG8_WAIT_V(0);
    if constexpr (!ALIGN_EPI) { if (wr == 0) PG8_BAR; }
    PG8_BAR;
    if constexpr (Epi::AFTER_DRAIN) { E.fused(acc, cur, wr, wc, fr, fq, lds, wid, lane); S.done(cur); }
#undef PG8_SA
#undef PG8_SB
#undef PG8_STAGE
#undef PG8_STA
#undef PG8_GOFF
#undef PG8_LDA
#undef PG8_LDB
#undef PG8_MMA
#undef PG8_WAIT_V
#undef PG8_WAIT_L
#undef PG8_BAR
#undef PG8_SCHED
}
}

#define XB_TMO      128
#define XB_XCNT(j)  (256  + 64 * (j))
#define XB_XSUB(j)  (1280 + 64 * (j))
#define XB_XGEN(j)  (2304 + 64 * (j))
#define XB_TOP      3328
#define XB_TOPGEN   3392
#define XCD_BAR_WORDS 3456
#define XB_SPIN_CAP (1u << 24)

__device__ __forceinline__ unsigned xb_ld(unsigned* p)              { return __hip_atomic_load(p, __ATOMIC_RELAXED, __HIP_MEMORY_SCOPE_AGENT); }
__device__ __forceinline__ unsigned xb_add(unsigned* p, unsigned v) { return __hip_atomic_fetch_add(p, v, __ATOMIC_RELAXED, __HIP_MEMORY_SCOPE_AGENT); }
__device__ __forceinline__ unsigned xb_xcc_id() { return (unsigned)__builtin_amdgcn_s_getreg((3 << 11) | 20) & 0xFu; }
#define XB_SPIN(cond, bar) do { unsigned _sp = 0; while (cond) { __builtin_amdgcn_s_sleep(1); \
    if ((++_sp & 255u) == 0u) { if (xb_ld(&(bar)[XB_TMO])) break; if (_sp > XB_SPIN_CAP) { atomicAdd(&(bar)[XB_TMO], 1u); break; } } } } while (0)

struct XcdBarrier {
    unsigned* bar; unsigned x;
    volatile LAS unsigned* st;
};

__device__ __forceinline__ XcdBarrier xcd_barrier_post(unsigned* bar, volatile LAS unsigned* st) {
    XcdBarrier b; b.bar = bar; b.x = xb_xcc_id(); b.st = st;
    if (threadIdx.x == 0) (void)xb_add(&bar[XB_XCNT(b.x)], 1u);
    return b;
}
__device__ __forceinline__ void xcd_barrier_complete(unsigned* bar, unsigned x, unsigned& nloc, unsigned& nx) {
    const unsigned G = gridDim.x * gridDim.y * gridDim.z;
    unsigned sum, cnt, mine, sp = 0u;
    for (;;) {
        sum = 0u; cnt = 0u; mine = 0u;
#pragma unroll
        for (unsigned j = 0; j < 16; ++j) { const unsigned c = xb_ld(&bar[XB_XCNT(j)]); sum += c; cnt += (c > 0u) ? 1u : 0u; mine = (j == x) ? c : mine; }
        if (sum == G) break;
        __builtin_amdgcn_s_sleep(1);
        if ((++sp & 255u) == 0u) { if (xb_ld(&bar[XB_TMO])) break; if (sp > XB_SPIN_CAP) { atomicAdd(&bar[XB_TMO], 1u); break; } }
    }
    nloc = mine > 0u ? mine : 1u; nx = cnt > 0u ? cnt : 1u;
}

__device__ __forceinline__ void xcd_barrier(const XcdBarrier& b, bool inv_l1 = true) {
    asm volatile("s_waitcnt vmcnt(0)" ::: "memory");
    __syncthreads();
    if (threadIdx.x == 0) {
        unsigned* bar = b.bar;
        __builtin_amdgcn_s_waitcnt(0);
        unsigned nloc = b.st[0], nx = b.st[1];
        if (nloc == 0u) { xcd_barrier_complete(bar, b.x, nloc, nx); b.st[0] = nloc; b.st[1] = nx; }
        const unsigned old = xb_add(&bar[XB_XSUB(b.x)], 1u);
        const unsigned gen = old / nloc;
        if (old + 1u == (gen + 1u) * nloc) {
            __builtin_amdgcn_fence(__ATOMIC_RELEASE, "agent");
            asm volatile("s_waitcnt vmcnt(0)" ::: "memory");
            const unsigned og = xb_add(&bar[XB_TOP], 1u);
            const unsigned tg = og / nx;
            if (og + 1u == (tg + 1u) * nx) xb_add(&bar[XB_TOPGEN], 1u);
            else XB_SPIN(xb_ld(&bar[XB_TOPGEN]) == tg, bar);
            __builtin_amdgcn_fence(__ATOMIC_ACQUIRE, "agent");
            xb_add(&bar[XB_XGEN(b.x)], 1u);
            asm volatile("s_waitcnt vmcnt(0)" ::: "memory");
        } else {
            XB_SPIN(xb_ld(&bar[XB_XGEN(b.x)]) == gen, bar);
            if (inv_l1) __builtin_amdgcn_fence(__ATOMIC_ACQUIRE, "agent");
            asm volatile("s_waitcnt vmcnt(0)" ::: "memory");
        }
    }
    __syncthreads();
}
struct Args { const float* in[33]; float* out; unsigned char* ws; int ph_lo, ph_hi; };
enum { I_X = 0, I_C, I_CTX, I_CCTX, I_ADAW, I_ADAB, I_NMIXG, I_NFFNG, I_EVWIN, I_EVWOUT, I_LAMRE, I_LAMIM, I_LOGSTEP, I_BRE, I_BIM, I_CRE, I_CIM, I_S5D, I_GLUW, I_GLUB,
       I_SINK, I_ODWIN, I_ODWOUT, I_LQ1, I_LK1, I_LQ2, I_LK2, I_SUBLN, I_ROUTER, I_WGATE, I_WUP, I_WDOWN, I_FINALG };

DI void p0_ada_item(const Args& a, LAS unsigned char* lds, int item) {
    const int tid = threadIdx.x, lane = tid & 63, wave = tid >> 6;
    const int l = item / 96, j0 = (item % 96) * 64;
    LAS float* sc = (LAS float*)lds;
    LAS float* red = (LAS float*)(lds + 9 * 1024 * 4);
    for (int i = tid; i < 9 * 1024; i += NTHREADS) {
        const int r = i >> 10, k = i & 1023;
        const float v = (r < 8) ? a.in[I_C][r * 1024 + k] : a.in[I_CCTX][k];
        sc[i] = v / (1.0f + __expf(-v));
    }
    __syncthreads();
    float acc[9];
#pragma unroll
    for (int r = 0; r < 9; ++r) acc[r] = 0.f;
    const float* W = a.in[I_ADAW] + (size_t)l * 1024 * 6144 + j0 + lane;
    const int k0 = wave * 128;
#pragma unroll 1
    for (int kb = 0; kb < 128; kb += 32) {
        float w[32];
#pragma unroll
        for (int i = 0; i < 32; ++i) w[i] = __builtin_nontemporal_load(W + (size_t)(k0 + kb + i) * 6144);
#pragma unroll
        for (int i = 0; i < 32; ++i)
#pragma unroll
            for (int r = 0; r < 9; ++r) acc[r] += sc[r * 1024 + k0 + kb + i] * w[i];
    }
#pragma unroll
    for (int r = 0; r < 9; ++r) red[(wave * 9 + r) * 64 + lane] = acc[r];
    __syncthreads();
    for (int i = tid; i < 9 * 64; i += NTHREADS) {
        const int r = i >> 6, jj = i & 63; float s = 0.f;
#pragma unroll
        for (int w = 0; w < 8; ++w) s += red[(w * 9 + r) * 64 + jj];
        ((float*)(a.ws + WS_MOD))[(size_t)(l * 9 + r) * 6144 + j0 + jj] = s + a.in[I_ADAB][l * 6144 + j0 + jj];
    }
    __syncthreads();
}
DI void p0_rope(const Args& a) {
    for (int i = threadIdx.x; i < 1024; i += NTHREADS) {
        const int pos = i >> 4, fi = i & 15;
        const float inv = powf(10000.0f, -(float)fi / 16.0f);
        const float ang = (float)pos * inv;
        ((float*)(a.ws + WS_ROPE))[2 * i] = cosf(ang); ((float*)(a.ws + WS_ROPE))[2 * i + 1] = sinf(ang);
    }
}
DI void p0_s5_item(const Args& a, LAS unsigned char* lds, int item) {
    const int tid = threadIdx.x, g = item >> 1, dir = item & 1;
    LAS float* apr = (LAS float*)lds;
    LAS float* api = apr + 33 * 64;
    LAS float* bbr = api + 33 * 64;
    LAS float* bbi = bbr + 1024;
    LAS float* ccr = bbi + 1024;
    LAS float* cci = ccr + 1024;
    const int gp = (dir * S5G + g) * S5P;
    const float dt = __expf(a.in[I_LOGSTEP][dir * S5G + g]);
    for (int i = tid; i < 33 * 64; i += NTHREADS) {
        const int j = i >> 6, p = i & 63;
        const float lr = a.in[I_LAMRE][gp + p], li = a.in[I_LAMIM][gp + p];
        const float mag = expf((float)j * lr * dt), ang = (float)j * li * dt;
        apr[i] = mag * cosf(ang); api[i] = mag * sinf(ang);
    }
    for (int i = tid; i < 1024; i += NTHREADS) {
        const int p = i >> 4;
        const float lr = a.in[I_LAMRE][gp + p], li = a.in[I_LAMIM][gp + p];
        const float mag = expf(lr * dt), are = mag * cosf(li * dt), aim = mag * sinf(li * dt);
        const float den = lr * lr + li * li;
        const float fre = ((are - 1.0f) * lr + aim * li) / den, fim = (aim * lr - (are - 1.0f) * li) / den;
        const float br = a.in[I_BRE][(size_t)gp * 16 + i], bi = a.in[I_BIM][(size_t)gp * 16 + i];
        bbr[i] = fre * br - fim * bi; bbi[i] = fre * bi + fim * br;
        ccr[i] = a.in[I_CRE][(size_t)(dir * S5G + g) * 1024 + i]; cci[i] = a.in[I_CIM][(size_t)(dir * S5G + g) * 1024 + i];
    }
    __syncthreads();
    if (tid < 64) { float* ap = (float*)(a.ws + WS_APOW) + ((g * 2 + dir) * 64 + tid) * 2; ap[0] = apr[32 * 64 + tid]; ap[1] = api[32 * 64 + tid]; }
    {
        const int c = (tid >> 4) & 15, h = tid & 15, jh = tid >> 8;
        float cbr[64], cbi[64];
#pragma unroll
        for (int p = 0; p < 64; ++p) { const float cr = ccr[c * 64 + p], ci = cci[c * 64 + p], br = bbr[p * 16 + h], bi = bbi[p * 16 + h]; cbr[p] = cr * br - ci * bi; cbi[p] = cr * bi + ci * br; }
        float* kt = (float*)(a.ws + WS_KTAB) + (size_t)(g * 2 + dir) * 32 * 256;
        for (int j = jh * 16; j < jh * 16 + 16; ++j) {
            float s = 0.f;
#pragma unroll
            for (int p = 0; p < 64; p += 4) {
                const f32x4 ar = *(const LAS f32x4*)(apr + j * 64 + p), ai = *(const LAS f32x4*)(api + j * 64 + p);
#pragma unroll
                for (int q = 0; q < 4; ++q) s += cbr[p + q] * ar[q] - cbi[p + q] * ai[q];
            }
            kt[j * 256 + c * 16 + h] = s;
        }
    }
    bf16_t* bta = (bf16_t*)(a.ws + OV_BTA) + (size_t)g * 256 * 512;
    for (int i = tid; i < 128 * 256; i += NTHREADS) {
        const int row = i >> 8, cp = i & 255, ri = row >> 6, p = row & 63, s = cp >> 3, h = (cp & 7) * 2;
        const int e = dir ? s : 31 - s;
        const float pr = apr[e * 64 + p], pi = api[e * 64 + p];
        float v0, v1;
        if (ri == 0) { v0 = pr * bbr[p * 16 + h] - pi * bbi[p * 16 + h]; v1 = pr * bbr[p * 16 + h + 1] - pi * bbi[p * 16 + h + 1]; }
        else         { v0 = pr * bbi[p * 16 + h] + pi * bbr[p * 16 + h]; v1 = pr * bbi[p * 16 + h + 1] + pi * bbr[p * 16 + h + 1]; }
        *(unsigned*)(bta + (size_t)(dir * 128 + row) * 512 + s * 16 + h) = pk2(v0, v1);
    }
    bf16_t* btc = (bf16_t*)(a.ws + OV_BTC) + (size_t)g * 512 * S5_KC;
    for (int i = tid; i < 512 * 64; i += NTHREADS) {
        const int row = i >> 6, cp = i & 63, ri = cp >> 5, p = (cp & 31) * 2, t = row >> 4, c = row & 15;
        const int f = dir ? 32 - t : t + 1;
        float v[2];
#pragma unroll
        for (int q = 0; q < 2; ++q) {
            const float cr = ccr[c * 64 + p + q], ci = cci[c * 64 + p + q], pr = apr[f * 64 + p + q], pi = api[f * 64 + p + q];
            v[q] = ri == 0 ? (cr * pr - ci * pi) : -(cr * pi + ci * pr);
        }
        *(unsigned*)(btc + (size_t)row * S5_KC + 512 + dir * 128 + ri * 64 + p) = pk2(v[0], v[1]);
    }
    __syncthreads();
}
DI void p0_conv_item(const float* W, int K, int N, bf16_t* WT, int mode, int sel, int kb, int nb, int lane, LAS unsigned* scr) {
    const int nq = lane & 15, kq = lane >> 4;
    const float* src = W + (size_t)(kb * 64 + kq * 2) * N + nb * 64 + nq * 4;
    f32x4 v[16];
#pragma unroll
    for (int i = 0; i < 8; ++i) { v[2 * i] = *(const f32x4*)(src + (size_t)(i * 8) * N); v[2 * i + 1] = *(const f32x4*)(src + (size_t)(i * 8 + 1) * N); }
#pragma unroll
    for (int i = 0; i < 8; ++i)
#pragma unroll
        for (int j = 0; j < 4; ++j) scr[(nq * 4 + j) * 32 + ((i ^ (nq & 7)) << 2) + kq] = pk2(v[2 * i][j], v[2 * i + 1][j]);
#pragma unroll
    for (int r = 0; r < 8; ++r) {
        const int n = (lane >> 3) + 8 * r, c = lane & 7;
        const u32x4 d = *(const LAS u32x4*)(scr + n * 32 + ((c ^ ((n >> 2) & 7)) << 2));
        const int ng = nb * 64 + n;
        const int row = mode == 1 ? ((ng >> 7) * 256 + sel * 128 + (ng & 127)) : ng;
        *(u32x4*)(WT + (size_t)row * K + kb * 64 + c * 8) = d;
    }
}
constexpr int POOL_ITEMS = 16 * 1536;
constexpr int CW_PHDONE = 8704;
struct ConvItem { const float* W; bf16_t* WT; int K, N, mode, sel, kb, nb; };
DI ConvItem conv_decode(const Args& a, int pool, int item) {
    ConvItem c; const int le = pool * 16 + item / 1536; int r = item % 1536;
    if (r < 512) { c.W = a.in[I_WGATE] + (size_t)le * 1024 * 2048; c.WT = (bf16_t*)(a.ws + WS_W1T) + (size_t)le * 4096 * 1024; c.K = 1024; c.N = 2048; c.mode = 1; c.sel = 0; c.kb = r / 32; c.nb = r % 32; }
    else if (r < 1024) { r -= 512; c.W = a.in[I_WUP] + (size_t)le * 1024 * 2048; c.WT = (bf16_t*)(a.ws + WS_W1T) + (size_t)le * 4096 * 1024; c.K = 1024; c.N = 2048; c.mode = 1; c.sel = 1; c.kb = r / 32; c.nb = r % 32; }
    else { r -= 1024; c.W = a.in[I_WDOWN] + (size_t)le * 2048 * 1024; c.WT = (bf16_t*)(a.ws + WS_W2T) + (size_t)le * 1024 * 2048; c.K = 2048; c.N = 1024; c.mode = 0; c.sel = 0; c.kb = r / 16; c.nb = r % 16; }
    return c;
}
DI void conv_load(const ConvItem& c, int lane, f32x4 (&v)[16]) {
    const int nq = lane & 15, kq = lane >> 4;
    const float* src = c.W + (size_t)(c.kb * 64 + kq * 2) * c.N + c.nb * 64 + nq * 4;
#pragma unroll
    for (int i = 0; i < 8; ++i) { v[2 * i] = __builtin_nontemporal_load((const f32x4*)(src + (size_t)(i * 8) * c.N)); v[2 * i + 1] = __builtin_nontemporal_load((const f32x4*)(src + (size_t)(i * 8 + 1) * c.N)); }
}
DI void conv_store(const ConvItem& c, int lane, const f32x4 (&v)[16], LAS unsigned* scr) {
    const int nq = lane & 15, kq = lane >> 4;
#pragma unroll
    for (int i = 0; i < 8; ++i)
#pragma unroll
        for (int j = 0; j < 4; ++j) scr[(nq * 4 + j) * 32 + ((i ^ (nq & 7)) << 2) + kq] = pk2(v[2 * i][j], v[2 * i + 1][j]);
#pragma unroll
    for (int r = 0; r < 8; ++r) {
        const int n = (lane >> 3) + 8 * r, cc = lane & 7;
        const u32x4 d = *(const LAS u32x4*)(scr + n * 32 + ((cc ^ ((n >> 2) & 7)) << 2));
        const int ng = c.nb * 64 + n;
        const int row = c.mode == 1 ? ((ng >> 7) * 256 + c.sel * 128 + (ng & 127)) : ng;
        __builtin_nontemporal_store(d, (u32x4*)(c.WT + (size_t)row * c.K + c.kb * 64 + cc * 8));
    }
}
DI void steal_conv(const Args& a, LAS unsigned char* lds, int G, int phase, int last_pool, bool opportunistic, int& pos) {
    const int tid = threadIdx.x, lane = tid & 63, wave = __builtin_amdgcn_readfirstlane(tid >> 6);
    unsigned* ctl = (unsigned*)(a.ws + WS_CTL);
    LAS unsigned* scr = (LAS unsigned*)(lds + wave * 8192);
    const int NGW = G * NWAVES, ppw = (POOL_ITEMS + NGW - 1) / NGW;
    const int gw = blockIdx.x * NWAVES + wave, end = (last_pool + 1) * ppw;
    __syncthreads();
    if (tid == 0 && opportunistic) __hip_atomic_fetch_add(ctl + CW_PHDONE + 64 * phase, 1u, __ATOMIC_RELAXED, __HIP_MEMORY_SCOPE_AGENT);
#define CONV_MORE() (pos < end && (!opportunistic || (unsigned)__builtin_amdgcn_readfirstlane((int)__hip_atomic_load(ctl + CW_PHDONE + 64 * phase, __ATOMIC_RELAXED, __HIP_MEMORY_SCOPE_AGENT)) < (unsigned)G))
#define CONV_NEXT(c, ok) do { const int it_ = ((int)blockIdx.x * ppw + (pos % ppw)) * NWAVES + wave; ok = it_ < POOL_ITEMS; c = conv_decode(a, pos / ppw, ok ? it_ : 0); ++pos; } while (0)
    if (CONV_MORE()) {
        ConvItem ca, cb; f32x4 va[16], vb[16]; bool oka, okb;
        CONV_NEXT(ca, oka); if (oka) conv_load(ca, lane, va);
        for (;;) {
            okb = false; const bool moreb = CONV_MORE();
            if (moreb) { CONV_NEXT(cb, okb); if (okb) conv_load(cb, lane, vb); }
            if (oka) conv_store(ca, lane, va, scr);
            if (!moreb) break;
            oka = false; const bool morea = CONV_MORE();
            if (morea) { CONV_NEXT(ca, oka); if (oka) conv_load(ca, lane, va); }
            if (okb) conv_store(cb, lane, vb, scr);
            if (!morea) break;
        }
    }
#undef CONV_MORE
#undef CONV_NEXT
    __syncthreads();
}
DI void p0_phase(const Args& a, LAS unsigned char* lds, int G) {
    const int tid = threadIdx.x, lane = tid & 63, wave = __builtin_amdgcn_readfirstlane(tid >> 6);
    for (int it = blockIdx.x; it < 193; it += G) {
        if (it < 192) p0_ada_item(a, lds, it);
        else p0_rope(a);
    }
    __syncthreads();
    const int gw = blockIdx.x * NWAVES + wave, NGW = G * NWAVES;
    LAS unsigned* scr = (LAS unsigned*)(lds + wave * 8192);
    constexpr int I_IN0 = 16 * 20, I_GLU = 8 * 8, I_OUT0 = 16 * 16, I_IN1 = 16 * 48, I_OUT1 = 16 * 16, NITEMS = I_IN0 + I_GLU + I_OUT0 + I_IN1 + I_OUT1;
    for (int it = gw; it < NITEMS; it += NGW) {
        int r = it;
        if (r < I_IN0) { p0_conv_item(a.in[I_EVWIN], 1024, 1280, (bf16_t*)(a.ws + WS_WIN0T), 0, 0, r / 20, r % 20, lane, scr); continue; } r -= I_IN0;
        if (r < I_GLU) { p0_conv_item(a.in[I_GLUW], 512, 512, (bf16_t*)(a.ws + WS_WGLUT), 0, 0, r / 8, r % 8, lane, scr); continue; } r -= I_GLU;
        if (r < I_OUT0) { p0_conv_item(a.in[I_EVWOUT], 1024, 1024, (bf16_t*)(a.ws + WS_WOUT0T), 0, 0, r / 16, r % 16, lane, scr); continue; } r -= I_OUT0;
        if (r < I_IN1) { p0_conv_item(a.in[I_ODWIN], 1024, 3072, (bf16_t*)(a.ws + WS_WIN1T), 0, 0, r / 48, r % 48, lane, scr); continue; } r -= I_IN1;
        p0_conv_item(a.in[I_ODWOUT], 1024, 1024, (bf16_t*)(a.ws + WS_WOUT1T), 0, 0, r / 16, r % 16, lane, scr);
    }
}
DI const float* mod_ptr(const Args& a, int layer, int row) {
    const int r = row < ROWS_L ? (row >> 11) : 8;
    return (const float*)(a.ws + WS_MOD) + (size_t)(layer * 9 + r) * 6144;
}
DI f32x4 ld_bf16x4(const bf16_t* p);
DI void load_row_bf16(const bf16_t* p, int lane, f32x4 (&v)[4]) {
#pragma unroll
    for (int j = 0; j < 4; ++j) v[j] = ld_bf16x4(p + lane * 4 + 256 * j);
}
DI void load_row(const float* p, int lane, f32x4 (&v)[4]) {
#pragma unroll
    for (int j = 0; j < 4; ++j) v[j] = *(const f32x4*)(p + lane * 4 + 256 * j);
}
DI float row_rstd(const f32x4 (&v)[4]) {
    float s = 0.f;
#pragma unroll
    for (int j = 0; j < 4; ++j) s += (v[j].x * v[j].x + v[j].y * v[j].y) + (v[j].z * v[j].z + v[j].w * v[j].w);
    return 1.0f / sqrtf(wave_sum(s) * (1.0f / 1024.0f) + NORM_EPS);
}
DI void norm_mod(f32x4 (&v)[4], const float* g, const float* shift, const float* scale, int lane) {
    const float rs = row_rstd(v);
#pragma unroll
    for (int j = 0; j < 4; ++j) {
        const f32x4 gg = *(const f32x4*)(g + lane * 4 + 256 * j), sh = *(const f32x4*)(shift + lane * 4 + 256 * j), sc = *(const f32x4*)(scale + lane * 4 + 256 * j);
        v[j] = (v[j] * rs) * gg * (sc + 1.0f) + sh;
    }
}
DI void store_row_bf16(bf16_t* p, int lane, const f32x4 (&v)[4]) {
#pragma unroll
    for (int j = 0; j < 4; ++j) { u32x2 w; w.x = pk2(v[j].x, v[j].y); w.y = pk2(v[j].z, v[j].w); *(u32x2*)(p + lane * 4 + 256 * j) = w; }
}
DI float rt_xhalf(float v) {
    const unsigned u = __builtin_bit_cast(unsigned, v);
    auto r = __builtin_amdgcn_permlane32_swap(u, u, false, false);
    return __builtin_bit_cast(float, (threadIdx.x & 32) ? r[0] : r[1]);
}
template <int X> DI float rt_xswz(float v) {
    return __builtin_bit_cast(float, __builtin_amdgcn_ds_swizzle(__builtin_bit_cast(int, v), (X << 10) | 0x1f));
}
DI void router_fill(const Args& a, LAS float* ldsw, int layer) {
    const float* wr = a.in[I_ROUTER] + (size_t)layer * 1024 * 16;
    for (int i = threadIdx.x; i < 16384; i += NTHREADS) ldsw[(i & 15) * 1024 + (i >> 4)] = wr[i];
    __syncthreads();
}
DI void router_row(const Args& a, const LAS float* ldsw, int row, const f32x4 (&v)[4], int lane) {
    float lg[16];
    {
        f32x2 acc2[16];
#pragma unroll
        for (int e = 0; e < 16; ++e) acc2[e] = (f32x2){0.f, 0.f};
#pragma unroll
        for (int j = 0; j < 4; ++j) {
            const f32x2 vlo = {v[j].x, v[j].y}, vhi = {v[j].z, v[j].w};
            f32x4 w[16];
#pragma unroll
            for (int e = 0; e < 16; ++e) w[e] = *(const LAS f32x4*)(ldsw + e * 1024 + lane * 4 + 256 * j);
#pragma unroll
            for (int e = 0; e < 16; ++e) { acc2[e] += vlo * (f32x2){w[e].x, w[e].y}; acc2[e] += vhi * (f32x2){w[e].z, w[e].w}; }
            __builtin_amdgcn_sched_barrier(0);
        }
#pragma unroll
        for (int e = 0; e < 16; ++e) lg[e] = acc2[e].x + acc2[e].y;
    }
    const bool b5 = lane & 32, b4 = lane & 16, b3 = lane & 8, b2 = lane & 4;
    float k8[8], k4[4], k2[2];
#pragma unroll
    for (int i = 0; i < 8; ++i) { const float snd = b5 ? lg[i] : lg[i + 8]; k8[i] = (b5 ? lg[i + 8] : lg[i]) + rt_xhalf(snd); }
#pragma unroll
    for (int i = 0; i < 4; ++i) { const float snd = b4 ? k8[i] : k8[i + 4]; k4[i] = (b4 ? k8[i + 4] : k8[i]) + rt_xswz<16>(snd); }
#pragma unroll
    for (int i = 0; i < 2; ++i) { const float snd = b3 ? k4[i] : k4[i + 2]; k2[i] = (b3 ? k4[i + 2] : k4[i]) + rt_xswz<8>(snd); }
    float tot = (b2 ? k2[1] : k2[0]) + rt_xswz<4>(b2 ? k2[0] : k2[1]);
    tot += rt_xswz<1>(tot); tot += rt_xswz<2>(tot);
    float mx = fmaxf(tot, rt_xswz<4>(tot)); mx = fmaxf(mx, rt_xswz<8>(mx)); mx = fmaxf(mx, rt_xswz<16>(mx)); mx = fmaxf(mx, rt_xhalf(mx));
    const float ex = expf(tot - mx);
    float den = ex + rt_xswz<4>(ex); den += rt_xswz<8>(den); den += rt_xswz<16>(den); den += rt_xhalf(den);
    const float mine = ex / den;
    const int e = (lane >> 2) & 15;
    if ((lane & 3) == 0) {
        if (row < ROWS_L) ((float*)(a.ws + WS_AFFL))[((size_t)(row >> 11) * 16 + e) * NL + (row & 2047)] = mine;
        else { const int rc = row - ROWS_L; ((float*)(a.ws + WS_AFFC))[((size_t)(rc >> 8) * 16 + e) * NC + (rc & 255)] = mine; }
    }
}
DI void toeplitz_fill(const Args& a, int wv, int nwv, int lane) {
    for (int it = wv; it < S5G * 32; it += nwv) {
        const int g = it >> 5, t = it & 31;
        const float* kf = (const float*)(a.ws + WS_KTAB) + (size_t)(g * 2 + 0) * 32 * 256;
        const float* kr = kf + 32 * 256;
        bf16_t* base = (bf16_t*)(a.ws + OV_BTC) + ((size_t)g * 512 + t * 16) * S5_KC;
#pragma unroll
        for (int q = 0; q < 2; ++q) {
            const int col = q * 256 + lane * 4, s = col >> 4, h0 = col & 15;
            const float mf = s <= t ? 1.f : 0.f, mr = s >= t ? 1.f : 0.f;
            const float* pf = kf + (s <= t ? t - s : 0) * 256 + h0; const float* pr = kr + (s >= t ? s - t : 0) * 256 + h0;
#pragma unroll 8
            for (int c = 0; c < 16; ++c) {
                const f32x4 v = *(const f32x4*)(pf + c * 16) * mf + *(const f32x4*)(pr + c * 16) * mr;
                u32x2 w; w.x = pk2(v.x, v.y); w.y = pk2(v.z, v.w);
                *(u32x2*)(base + (size_t)c * S5_KC + col) = w;
            }
        }
    }
}
DI void p1_phase(const Args& a, LAS unsigned char* lds, int G) {
    const int tid = threadIdx.x, lane = tid & 63, wave = __builtin_amdgcn_readfirstlane(tid >> 6);
    const int ntab = G > 128 ? 64 : 0;
    for (int it = blockIdx.x; it < 64; it += (ntab ? 64 : G)) { if (ntab && (int)blockIdx.x >= ntab) break; p0_s5_item(a, lds, it); }
    if ((int)blockIdx.x < ntab) return;
    const int gw = ((int)blockIdx.x - ntab) * NWAVES + wave, NGW = (G - ntab) * NWAVES;
    f32x4 vn[4];
    if (gw < ROWS) load_row(gw < ROWS_L ? a.in[I_X] + (size_t)gw * DM : a.in[I_CTX] + (size_t)(gw - ROWS_L) * DM, lane, vn);
    for (int row = gw; row < ROWS; row += NGW) {
        f32x4 v[4];
#pragma unroll
        for (int j = 0; j < 4; ++j) v[j] = vn[j];
        const int nr = row + NGW;
        if (nr < ROWS) load_row(nr < ROWS_L ? a.in[I_X] + (size_t)nr * DM : a.in[I_CTX] + (size_t)(nr - ROWS_L) * DM, lane, vn);
        const float* md = mod_ptr(a, 0, row);
        norm_mod(v, a.in[I_NMIXG], md, md + 1024, lane);
        store_row_bf16((bf16_t*)(a.ws + WS_HX) + (size_t)row * DM, lane, v);
    }
}
DI void pnorm_router_phase(const Args& a, LAS unsigned char* lds, int G, int layer, int nrows) {
    const int tid = threadIdx.x, lane = tid & 63, wave = __builtin_amdgcn_readfirstlane(tid >> 6);
    const int gw = blockIdx.x * NWAVES + wave, NGW = G * NWAVES;
    LAS float* ldsw = (LAS float*)lds; router_fill(a, ldsw, layer);
    for (int row = gw; row < nrows; row += NGW) {
        f32x4 v[4]; load_row_bf16((const bf16_t*)(a.ws + WS_XS) + (size_t)row * DM, lane, v);
        const float* md = mod_ptr(a, layer, row);
        norm_mod(v, a.in[I_NFFNG] + layer * 1024, md + 3 * 1024, md + 4 * 1024, lane);
        store_row_bf16((bf16_t*)(a.ws + WS_HX) + (size_t)row * DM, lane, v);
        router_row(a, ldsw, row, v, lane);
    }
}
DI f32x4 ld_bf16x4(const bf16_t* p);
DI void pcombine_phase(const Args& a, int G, int layer, int nrows, int mrows) {
    const bool tails = false;
    const int tid = threadIdx.x, lane = tid & 63, wave = __builtin_amdgcn_readfirstlane(tid >> 6);
    const int gw = blockIdx.x * NWAVES + wave, NGW = G * NWAVES;
    const bf16_t* yb = (const bf16_t*)(a.ws + OV_YB);
    for (int row = gw; row < nrows; row += NGW) {
        bf16_t* xr = (bf16_t*)(a.ws + WS_XS) + (size_t)row * DM;
        f32x4 v[4]; load_row_bf16(xr, lane, v);
        f32x4 acc[4];
#pragma unroll
        for (int j = 0; j < 4; ++j) acc[j] = (f32x4){0.f, 0.f, 0.f, 0.f};
        const int* ts = (const int*)(a.ws + WS_TOKSLOT) + (size_t)row * 16;
        const int myslot = lane < 16 ? ts[lane] : -1;
        unsigned msk = (unsigned)__ballot(myslot >= 0);
        while (msk) {
            const int e0 = __builtin_ctz(msk); msk &= msk - 1;
            const int e1 = msk ? __builtin_ctz(msk) : e0; const bool two = msk != 0; msk &= msk - 1;
            const int s0 = __builtin_amdgcn_readlane(myslot, e0), s1 = __builtin_amdgcn_readlane(myslot, e1);
            const bf16_t* y0 = yb + ((size_t)e0 * mrows + s0) * DM; const bf16_t* y1 = yb + ((size_t)e1 * mrows + s1) * DM;
            u32x2 w0[4], w1[4];
#pragma unroll
            for (int j = 0; j < 3; ++j) { w0[j] = *(const u32x2*)(y0 + lane * 4 + 256 * j); w1[j] = *(const u32x2*)(y1 + lane * 4 + 256 * j); }
            const bool t0 = tails && (e0 & 1) && s0 >= 256, t1 = tails && (e1 & 1) && s1 >= 256;
            const float f1 = two ? 1.f : 0.f;
            if (!t0) w0[3] = *(const u32x2*)(y0 + lane * 4 + 768);
            if (!t1) w1[3] = *(const u32x2*)(y1 + lane * 4 + 768);
            if (t0 || t1) {
                const bf16_t* ybs = (const bf16_t*)(a.ws + OV_YBS);
                f32x4 ex = {0.f, 0.f, 0.f, 0.f};
                if (t0) { const int ss = (e0 >> 1) * 8 + (s0 >> 8) - 1;
#pragma unroll
                    for (int q = 0; q < 4; ++q) ex += ld_bf16x4(ybs + ((size_t)(q * 64 + ss) * 256 + (s0 & 255)) * 256 + lane * 4); w0[3] = (u32x2){0u, 0u}; }
                if (t1) { const int ss = (e1 >> 1) * 8 + (s1 >> 8) - 1;
#pragma unroll
                    for (int q = 0; q < 4; ++q) ex += ld_bf16x4(ybs + ((size_t)(q * 64 + ss) * 256 + (s1 & 255)) * 256 + lane * 4) * f1; w1[3] = (u32x2){0u, 0u}; }
                acc[3] += ex;
            }
#pragma unroll
            for (int j = 0; j < 4; ++j) {
                acc[j].x += bflo(w0[j].x) + f1 * bflo(w1[j].x); acc[j].y += bfhi(w0[j].x) + f1 * bfhi(w1[j].x);
                acc[j].z += bflo(w0[j].y) + f1 * bflo(w1[j].y); acc[j].w += bfhi(w0[j].y) + f1 * bfhi(w1[j].y);
            }
        }
        const float* md = mod_ptr(a, layer, row);
#pragma unroll
        for (int j = 0; j < 4; ++j) v[j] += *(const f32x4*)(md + 5 * 1024 + lane * 4 + 256 * j) * acc[j];
        if (layer == 0) {
            store_row_bf16(xr, lane, v);
            const float* m1 = mod_ptr(a, 1, row);
            norm_mod(v, a.in[I_NMIXG] + 1024, m1, m1 + 1024, lane);
            store_row_bf16((bf16_t*)(a.ws + WS_HX) + (size_t)row * DM, lane, v);
        } else {
            const float rs = row_rstd(v);
#pragma unroll
            for (int j = 0; j < 4; ++j) *(f32x4*)(a.out + (size_t)row * DM + lane * 4 + 256 * j) = (v[j] * rs) * *(const f32x4*)(a.in[I_FINALG] + lane * 4 + 256 * j);
        }
    }
}
DI void ptopk_phase(const Args& a, LAS unsigned char* lds, int G, int with_ctx, int mrows) {
    const int tid = threadIdx.x, lane = tid & 63, wave = __builtin_amdgcn_readfirstlane(tid >> 6);
    LAS int* hist = (LAS int*)lds;
    LAS int* st = (LAS int*)(lds + 1024);
    LAS int* wsum = (LAS int*)(lds + 1024 + 32);
    LAS unsigned* wtot = (LAS unsigned*)(lds + 1024 + 64);
    LAS int* list = (LAS int*)(lds + 2048);
    const int nitems = with_ctx ? 256 : 128;
    for (int it = blockIdx.x; it < nitems; it += G) {
        const bool lat = it < 128;
        const int r = lat ? it : it - 128, b = r >> 4, e = r & 15, n = lat ? NL : NC, cap = lat ? CAP_L : CAP_C;
        const float* src = lat ? (const float*)(a.ws + WS_AFFL) + ((size_t)b * 16 + e) * NL : (const float*)(a.ws + WS_AFFC) + ((size_t)b * 16 + e) * NC;
        const bool valid = tid * 4 < n;
        u32x4 key = {0u, 0u, 0u, 0u};
        if (valid) key = *(const u32x4*)(src + tid * 4);
        unsigned prefix = 0u; int remaining = cap;
#pragma unroll
        for (int pass = 0; pass < 4; ++pass) {
            const int shift = 24 - 8 * pass;
            if (tid < 256) hist[tid] = 0;
            __syncthreads();
            if (valid) {
#pragma unroll
                for (int i = 0; i < 4; ++i)
                    if (pass == 0 || (key[i] >> (shift + 8)) == prefix) __hip_atomic_fetch_add(&hist[(key[i] >> shift) & 255u], 1, __ATOMIC_RELAXED, __HIP_MEMORY_SCOPE_WORKGROUP);
            }
            __syncthreads();
            {
                const int mine = tid < 256 ? hist[tid] : 0;
                int sfx = mine;
#pragma unroll
                for (int o = 1; o < 64; o <<= 1) { const int y = __shfl_down(sfx, o); if (lane + o < 64) sfx += y; }
                if (tid < 256 && lane == 0) wsum[wave] = sfx;
                __syncthreads();
                if (tid < 256) {
                    int above = sfx - mine;
                    for (int w = wave + 1; w < 4; ++w) above += wsum[w];
                    if (above < remaining && remaining <= above + mine) { st[0] = tid; st[1] = remaining - above; }
                }
            }
            __syncthreads();
            prefix = (prefix << 8) | (unsigned)st[0]; remaining = st[1];
        }
        const unsigned T = prefix; const int req = remaining;
        unsigned cnt = 0u;
#pragma unroll
        for (int i = 0; i < 4; ++i) cnt += (valid && key[i] > T ? 1u : 0u) + (valid && key[i] == T ? 0x10000u : 0u);
        unsigned inc = cnt;
#pragma unroll
        for (int o = 1; o < 64; o <<= 1) { const unsigned y = __shfl_up(inc, o); if (lane >= o) inc += y; }
        if (lane == 63) wtot[wave] = inc;
        __syncthreads();
        unsigned off = inc - cnt;
        for (int w = 0; w < wave; ++w) off += wtot[w];
        int gtp = (int)(off & 0xffffu), eqp = (int)(off >> 16);
        if (valid) {
#pragma unroll
            for (int i = 0; i < 4; ++i) {
                const unsigned kv = key[i];
                const bool gt = kv > T, eq = kv == T;
                const bool sel = gt || (eq && eqp < req);
                const int t = tid * 4 + i, trow = lat ? b * NL + t : ROWS_L + b * NC + t;
                int erow = -1;
                if (sel) {
                    const int slot = gtp + (eqp < req ? eqp : req);
                    erow = lat ? b * CAP_L + slot : NB * CAP_L + b * CAP_C + slot;
                    ((float*)(a.ws + WS_GATE))[(size_t)e * mrows + erow] = __uint_as_float(kv);
                    list[slot] = trow;
                }
                ((int*)(a.ws + WS_TOKSLOT))[(size_t)trow * 16 + e] = erow;
                gtp += gt ? 1 : 0; eqp += eq ? 1 : 0;
            }
        }
        __syncthreads();
        const int ebase = lat ? b * CAP_L : NB * CAP_L + b * CAP_C;
        if (tid < cap) ((int*)(a.ws + WS_SELROW))[(size_t)e * mrows + ebase + tid] = list[tid];
        __syncthreads();
    }
}
DI void ps5_rec_phase(const Args& a, int G) {
    if (threadIdx.x >= 128) return;
    for (int it = blockIdx.x; it < 256; it += G) {
        const int gid = it * 128 + threadIdx.x;
        const int p = gid & 63, dir = (gid >> 6) & 1, b = (gid >> 7) & 7, g = gid >> 10;
        const float* ap = (const float*)(a.ws + WS_APOW) + ((g * 2 + dir) * 64 + p) * 2;
        const float ar = ap[0], ai = ap[1];
        const float* S = (const float*)(a.ws + OV_S) + (size_t)g * S5_MROWS * 256 + dir * 128 + p;
        bf16_t* H = (bf16_t*)(a.ws + OV_AS5) + (size_t)g * S5_MROWS * S5_KC + 512 + dir * 128 + p;
        float sr = 0.f, si = 0.f;
#pragma unroll 1
        for (int kh = 0; kh < 72; kh += 24) {
            float cr[24], ci[24];
#pragma unroll
            for (int kk = 0; kk < 24; ++kk) {
                const int k = kh + kk;
                const int row = dir == 0 ? (k < 8 ? 512 + b * 8 + k : b * 64 + (k - 8)) : (k < 8 ? 512 + b * 8 + (7 - k) : b * 64 + (63 - (k - 8)));
                cr[kk] = S[(size_t)row * 256]; ci[kk] = S[(size_t)row * 256 + 64];
            }
#pragma unroll
            for (int kk = 0; kk < 24; ++kk) {
                const int k = kh + kk;
                const int row = dir == 0 ? (k < 8 ? 512 + b * 8 + k : b * 64 + (k - 8)) : (k < 8 ? 512 + b * 8 + (7 - k) : b * 64 + (63 - (k - 8)));
                H[(size_t)row * S5_KC] = (bf16_t)f2bf(sr); H[(size_t)row * S5_KC + 64] = (bf16_t)f2bf(si);
                const float nr = ar * sr - ai * si + cr[kk], ni = ar * si + ai * sr + ci[kk];
                sr = nr; si = ni;
            }
        }
    }
}
struct ListOrder {
    int n, G, c;
    DI int idx(int i) const {
        const long L = (long)i * G + c; if (L >= n) return -1;
        const int w = (int)L, q = n / 8, r = n % 8, x = w % 8, off = w / 8;
        return (x < r ? x * (q + 1) : r * (q + 1) + (x - r) * q) + off;
    }
};
struct GroupOrder {
    ListOrder lo; int MT, NT, max_rounds;
    DI void init(int groups, int MT_, int NT_, int G, int c) { MT = MT_; NT = NT_; lo.n = groups * MT_ * NT_; lo.G = G; lo.c = c; max_rounds = 1 << 30; }
    DI bool next(int i, pg8::Unit& u) const {
        if (i >= max_rounds) return false;
        const int w = lo.idx(i); if (w < 0) return false;
        const int g = w / (MT * NT), rem = w % (MT * NT), j = rem / MT, mi = rem % MT;
        u.pm = g * MT + mi; u.pn = g * NT + j; return true;
    }
    DI void a_ready(const pg8::Unit&) const {}
    DI void done(const pg8::Unit&) const {}
};
struct OneUnit {
    int pm, pn;
    DI bool next(int i, pg8::Unit& u) const { if (i > 0) return false; u.pm = pm; u.pn = pn; return true; }
    DI void a_ready(const pg8::Unit&) const {}
    DI void done(const pg8::Unit&) const {}
};
constexpr int W1_SWAP = (int)((WS_HX - WS_WIN1T) / (512 * 1024));
static_assert((WS_HX - WS_WIN1T) % (512 * 1024) == 0, "tile-aligned operand bases");
struct Win1Order {
    ListOrder lo;
    DI void init(int G, int c) { lo.n = 64 * 12 + 8 * 8; lo.G = G; lo.c = c; }
    DI bool next(int i, pg8::Unit& u) const {
        const int w = lo.idx(i); if (w < 0) return false;
        if (w < 768) { const int mg = w / 96, rem = w % 96; u.pn = rem / 8; u.pm = mg * 8 + rem % 8; }
        else { const int r = w - 768; u.pn = 4 + r / 8; u.pm = 64 + r % 8; }
        if (u.pn >= 8) { const int ht = u.pm; u.pm = u.pn - W1_SWAP; u.pn = ht + W1_SWAP; }
        return true;
    }
    DI void a_ready(const pg8::Unit&) const {}
    DI void done(const pg8::Unit&) const {}
};

typedef pg8::f32x4 (ACC_T)[2][2][4][2];
constexpr float QSCALE = 0.125f * 1.4426950408889634f;
DI void st_bf16x4(bf16_t* p, f32x4 v) { u32x2 w; w.x = pk2(v.x, v.y); w.y = pk2(v.z, v.w); *(u32x2*)p = w; }
DI f32x4 ld_bf16x4(const bf16_t* p) { const u32x2 w = *(const u32x2*)p; return (f32x4){bflo(w.x), bfhi(w.x), bflo(w.y), bfhi(w.y)}; }
DI void st_bf16_pair(bf16_t* p, int fq, f32x4 v0, f32x4 v1) {
    const unsigned a0 = pk2(v0.x, v0.y), a1 = pk2(v0.z, v0.w), b0 = pk2(v1.x, v1.y), b1 = pk2(v1.z, v1.w);
    const auto r0 = __builtin_amdgcn_permlane16_swap(a0, b0, false, false);
    const auto r1 = __builtin_amdgcn_permlane16_swap(a1, b1, false, false);
    const u32x4 w = {r0[0], r1[0], r0[1], r1[1]};
    *(u32x4*)(p + 4 * (fq & 2) + 16 * (fq & 1)) = w;
}
DI void rope_pair(f32x4& x0, f32x4& x1, const float* tab, int pos, int fq) {
    const float* t = tab + (size_t)(pos * 16 + 4 * fq) * 2;
    const f32x4 cs0 = *(const f32x4*)t, cs1 = *(const f32x4*)(t + 4);
    const f32x4 c = {cs0.x, cs0.z, cs1.x, cs1.z}, s = {cs0.y, cs0.w, cs1.y, cs1.w};
    const f32x4 a = x0, b = x1;
    x0 = a * c - b * s; x1 = b * c + a * s;
}
struct EpiWin0 {
    static constexpr bool PERM = false, AFTER_DRAIN = false;
    unsigned char* ws;
    DI void operator()(const ACC_T& acc, const pg8::Unit& u, int wr, int wc, int fr, int fq) const {
        const float* tab = (const float*)(ws + WS_ROPE);
#pragma unroll
        for (int ai = 0; ai < 2; ++ai)
#pragma unroll
            for (int m = 0; m < 4; ++m) {
                const int row = u.pm * 256 + ai * 128 + wr * 64 + m * 16 + fr;
                const bool lat = row < ROWS_L;
                const int b = lat ? row >> 11 : (row - ROWS_L) >> 8, tok = lat ? row & 2047 : (row - ROWS_L) & 255;
                if (u.pn < 2) {
                    const int mrow = lat ? b * 64 + (tok >> 5) : 512 + b * 8 + (tok >> 5), s = tok & 31;
#pragma unroll
                    for (int bj = 0; bj < 2; ++bj) {
                        const unsigned a0 = pk2(acc[ai][bj][m][0].x, acc[ai][bj][m][0].y), a1 = pk2(acc[ai][bj][m][0].z, acc[ai][bj][m][0].w);
                        const unsigned b0 = pk2(acc[ai][bj][m][1].x, acc[ai][bj][m][1].y), b1 = pk2(acc[ai][bj][m][1].z, acc[ai][bj][m][1].w);
                        const auto r0 = __builtin_amdgcn_permlane16_swap(a0, b0, false, false); const auto r1 = __builtin_amdgcn_permlane16_swap(a1, b1, false, false);
                        const int g = (u.pn * 256 + bj * 128 + wc * 32) / 16 + (fq & 1);
                        *(u32x4*)((bf16_t*)(ws + OV_AS5) + ((size_t)g * S5_MROWS + mrow) * S5_KC + s * 16 + 4 * (fq & 2)) = (u32x4){r0[0], r1[0], r0[1], r1[1]};
                    }
                } else if (u.pn < 4) {
                    const int pos = (wc & 1) ? (tok & 63) : (tok >> 6);
#pragma unroll
                    for (int bj = 0; bj < 2; ++bj) {
                        f32x4 x0 = acc[ai][bj][m][0] * QSCALE, x1 = acc[ai][bj][m][1] * QSCALE;
                        if (lat) rope_pair(x0, x1, tab, pos, fq);
                        st_bf16_pair((bf16_t*)(ws + OV_Q0) + (size_t)row * 512 + (u.pn - 2) * 256 + bj * 128 + wc * 32, fq, x0, x1);
                    }
                } else {
                    const int kp = lat ? NC + tok : tok;
                    {
                        const int pos = (wc & 1) ? (tok & 63) : (tok >> 6);
                        f32x4 x0 = acc[ai][0][m][0], x1 = acc[ai][0][m][1];
                        if (lat) rope_pair(x0, x1, tab, pos, fq);
                        st_bf16_pair((bf16_t*)(ws + OV_K0) + ((size_t)b * NPOS + kp) * 128 + wc * 32, fq, x0, x1);
                    }
#pragma unroll
                    for (int n = 0; n < 2; ++n)
#pragma unroll
                        for (int j = 0; j < 4; ++j) {
                            const int cv = wc * 32 + n * 16 + fq * 4 + j;
                            ((bf16_t*)(ws + OV_VT0))[((size_t)b * 128 + cv) * NPOS + kp] = (bf16_t)f2bf(acc[ai][1][m][n][j]);
                        }
                }
            }
    }
};
struct EpiS5a {
    static constexpr bool PERM = false, AFTER_DRAIN = false;
    unsigned char* ws;
    DI void operator()(const ACC_T& acc, const pg8::Unit& u, int wr, int wc, int fr, int fq) const {
        const int g = u.pn, mt = u.pm % 3;
#pragma unroll
        for (int ai = 0; ai < 2; ++ai)
#pragma unroll
            for (int m = 0; m < 4; ++m) {
                const int n = mt * 256 + ai * 128 + wr * 64 + m * 16 + fr;
                if (n < S5_VALID) {
                    float* dst = (float*)(ws + OV_S) + ((size_t)g * S5_MROWS + n) * 256 + wc * 32 + fq * 4;
#pragma unroll
                    for (int bj = 0; bj < 2; ++bj)
#pragma unroll
                        for (int nn = 0; nn < 2; ++nn) *(f32x4*)(dst + bj * 128 + nn * 16) = acc[ai][bj][m][nn];
                }
            }
    }
};
DI float gelu_tanh(float x) {
    const float u = 0.7978845608028654f * (x + 0.044715f * x * x * x);
    const float e = __expf(2.0f * u);
    const float th = 1.0f - 2.0f * __builtin_amdgcn_rcpf(e + 1.0f);
    return 0.5f * x * (1.0f + th);
}
struct EpiS5c {
    static constexpr bool PERM = false, AFTER_DRAIN = false;
    unsigned char* ws; const float* dskip;
    DI void operator()(const ACC_T& acc, const pg8::Unit& u, int wr, int wc, int fr, int fq) const {
        const int g = u.pm / 3, mt = u.pm % 3, nt = u.pn & 1;
#pragma unroll
        for (int ai = 0; ai < 2; ++ai)
#pragma unroll
            for (int m = 0; m < 4; ++m) {
                const int n = mt * 256 + ai * 128 + wr * 64 + m * 16 + fr;
                if (n < S5_VALID) {
                    const int tokrow0 = n < 512 ? (n >> 6) * NL + (n & 63) * 32 : ROWS_L + ((n - 512) >> 3) * NC + ((n - 512) & 7) * 32;
                    const bf16_t* ur = (const bf16_t*)(ws + OV_AS5) + ((size_t)g * S5_MROWS + n) * S5_KC;
#pragma unroll
                    for (int bj = 0; bj < 2; ++bj) {
                        f32x4 y[2];
#pragma unroll
                        for (int nn = 0; nn < 2; ++nn) {
                            const int oc = nt * 256 + bj * 128 + wc * 32 + nn * 16 + fq * 4, c0 = oc & 15;
                            const f32x4 uu = ld_bf16x4(ur + oc), dd = *(const f32x4*)(dskip + g * 16 + c0);
                            y[nn] = acc[ai][bj][m][nn] + dd * uu;
                            y[nn].x = gelu_tanh(y[nn].x); y[nn].y = gelu_tanh(y[nn].y); y[nn].z = gelu_tanh(y[nn].z); y[nn].w = gelu_tanh(y[nn].w);
                        }
                        const unsigned a0 = pk2(y[0].x, y[0].y), a1 = pk2(y[0].z, y[0].w), b0 = pk2(y[1].x, y[1].y), b1 = pk2(y[1].z, y[1].w);
                        const auto r0 = __builtin_amdgcn_permlane16_swap(a0, b0, false, false); const auto r1 = __builtin_amdgcn_permlane16_swap(a1, b1, false, false);
                        const int t = (nt * 256 + bj * 128 + wc * 32) / 16 + (fq & 1);
                        *(u32x4*)((bf16_t*)(ws + OV_Z) + (size_t)(tokrow0 + t) * 512 + g * 16 + 4 * (fq & 2)) = (u32x4){r0[0], r1[0], r0[1], r1[1]};
                    }
                }
            }
    }
};
struct EpiGlu {
    static constexpr bool PERM = false, AFTER_DRAIN = false;
    unsigned char* ws; const float* bias;
    DI void operator()(const ACC_T& acc, const pg8::Unit& u, int wr, int wc, int fr, int fq) const {
#pragma unroll
        for (int ai = 0; ai < 2; ++ai)
#pragma unroll
            for (int m = 0; m < 4; ++m) {
                const int row = u.pm * 256 + ai * 128 + wr * 64 + m * 16 + fr;
#pragma unroll
                for (int bj = 0; bj < 2; ++bj) {
                    f32x4 o[2];
#pragma unroll
                    for (int n = 0; n < 2; ++n) {
                        const int col = u.pn * 256 + bj * 128 + wc * 32 + n * 16 + fq * 4;
                        const f32x4 z = ld_bf16x4((const bf16_t*)(ws + OV_Z) + (size_t)row * 512 + col), t = acc[ai][bj][m][n] + *(const f32x4*)(bias + col);
                        o[n].x = z.x * __builtin_amdgcn_rcpf(1.0f + __expf(-t.x)); o[n].y = z.y * __builtin_amdgcn_rcpf(1.0f + __expf(-t.y)); o[n].z = z.z * __builtin_amdgcn_rcpf(1.0f + __expf(-t.z)); o[n].w = z.w * __builtin_amdgcn_rcpf(1.0f + __expf(-t.w));
                    }
                    st_bf16_pair((bf16_t*)(ws + WS_MIX) + (size_t)row * DM + u.pn * 256 + bj * 128 + wc * 32, fq, o[0], o[1]);
                }
            }
    }
};
struct EpiResid {
    static constexpr bool PERM = false, AFTER_DRAIN = false;
    unsigned char* ws; const float* x; const float* ctx; int layer;
    DI void operator()(const ACC_T& acc, const pg8::Unit& u, int wr, int wc, int fr, int fq) const {
#pragma unroll
        for (int ai = 0; ai < 2; ++ai)
#pragma unroll
            for (int m = 0; m < 4; ++m) {
                const int row = u.pm * 256 + ai * 128 + wr * 64 + m * 16 + fr;
                const int r = row < ROWS_L ? (row >> 11) : 8;
                const float* md = (const float*)(ws + WS_MOD) + (size_t)(layer * 9 + r) * 6144 + 2 * 1024;
                bf16_t* xs = (bf16_t*)(ws + WS_XS) + (size_t)row * DM;
                const float* base = row < ROWS_L ? x + (size_t)row * DM : ctx + (size_t)(row - ROWS_L) * DM;
#pragma unroll
                for (int bj = 0; bj < 2; ++bj) {
                    f32x4 o[2];
#pragma unroll
                    for (int n = 0; n < 2; ++n) {
                        const int col = u.pn * 256 + bj * 128 + wc * 32 + n * 16 + fq * 4;
                        const f32x4 bv = layer == 0 ? *(const f32x4*)(base + col) : ld_bf16x4(xs + col);
                        o[n] = bv + *(const f32x4*)(md + col) * acc[ai][bj][m][n];
                    }
                    st_bf16_pair(xs + u.pn * 256 + bj * 128 + wc * 32, fq, o[0], o[1]);
                }
            }
    }
};
struct EpiSwiglu {
    static constexpr bool PERM = false, AFTER_DRAIN = false;
    unsigned char* ws; int MT;
    DI void operator()(const ACC_T& acc, const pg8::Unit& u, int wr, int wc, int fr, int fq) const {
        const int j = u.pn & 15;
#pragma unroll
        for (int ai = 0; ai < 2; ++ai)
#pragma unroll
            for (int m = 0; m < 4; ++m) {
                const size_t row = (size_t)u.pm * 256 + ai * 128 + wr * 64 + m * 16 + fr;
                f32x4 o[2];
#pragma unroll
                for (int n = 0; n < 2; ++n) {
                    const f32x4 gt = acc[ai][0][m][n], up = acc[ai][1][m][n];
                    o[n].x = gt.x * __builtin_amdgcn_rcpf(1.0f + __expf(-gt.x)) * up.x; o[n].y = gt.y * __builtin_amdgcn_rcpf(1.0f + __expf(-gt.y)) * up.y; o[n].z = gt.z * __builtin_amdgcn_rcpf(1.0f + __expf(-gt.z)) * up.z; o[n].w = gt.w * __builtin_amdgcn_rcpf(1.0f + __expf(-gt.w)) * up.w;
                }
                st_bf16_pair((bf16_t*)(ws + OV_HID) + row * DE + j * 128 + wc * 32, fq, o[0], o[1]);
            }
    }
};
struct EpiMoeOut {
    static constexpr bool PERM = false, AFTER_DRAIN = false;
    unsigned char* ws;
    DI void operator()(const ACC_T& acc, const pg8::Unit& u, int wr, int wc, int fr, int fq) const {
        const int j = u.pn & 3;
#pragma unroll
        for (int ai = 0; ai < 2; ++ai)
#pragma unroll
            for (int m = 0; m < 4; ++m) {
                const size_t row = (size_t)u.pm * 256 + ai * 128 + wr * 64 + m * 16 + fr;
                const float gt = ((const float*)(ws + WS_GATE))[row];
#pragma unroll
                for (int bj = 0; bj < 2; ++bj)
                    st_bf16_pair((bf16_t*)(ws + OV_YB) + row * DM + j * 256 + bj * 128 + wc * 32, fq, acc[ai][bj][m][0] * gt, acc[ai][bj][m][1] * gt);
            }
    }
};
struct EpiMoeTail {
    static constexpr bool PERM = false, AFTER_DRAIN = false;
    unsigned char* ws; int q, s;
    DI void operator()(const ACC_T& acc, const pg8::Unit& u, int wr, int wc, int fr, int fq) const {
        bf16_t* dst = (bf16_t*)(ws + OV_YBS) + ((size_t)(q * 64 + s) * 256) * 256;
#pragma unroll
        for (int ai = 0; ai < 2; ++ai)
#pragma unroll
            for (int m = 0; m < 4; ++m) {
                const int r = ai * 128 + wr * 64 + m * 16 + fr;
                const float gt = ((const float*)(ws + WS_GATE))[(size_t)u.pm * 256 + r];
#pragma unroll
                for (int bj = 0; bj < 2; ++bj)
#pragma unroll
                    for (int n = 0; n < 2; ++n)
                        st_bf16x4(dst + (size_t)r * 256 + bj * 128 + wc * 32 + n * 16 + fq * 4, acc[ai][bj][m][n] * gt);
            }
    }
};
struct EpiWin1 {
    static constexpr bool PERM = false, AFTER_DRAIN = false;
    unsigned char* ws;
    DI void operator()(const ACC_T& acc, const pg8::Unit& u, int wr, int wc, int fr, int fq) const {
        if (u.pm < 0) {
            const int vt = u.pm + W1_SWAP - 8, ht = u.pn - W1_SWAP;
            const int b = ht < 64 ? ht >> 3 : ht - 64, kp0 = ht < 64 ? NC + (ht & 7) * 256 : 0;
#pragma unroll
            for (int ai = 0; ai < 2; ++ai)
#pragma unroll
                for (int m = 0; m < 4; ++m) {
                    const int cv = vt * 256 + ai * 128 + wr * 64 + m * 16 + fr;
                    bf16_t* dst = (bf16_t*)(ws + OV_VT1) + ((size_t)b * 1024 + cv) * NPOS + kp0 + wc * 32;
#pragma unroll
                    for (int bj = 0; bj < 2; ++bj) st_bf16_pair(dst + bj * 128, fq, acc[ai][bj][m][0], acc[ai][bj][m][1]);
                }
            return;
        }
        const float* tab = (const float*)(ws + WS_ROPE);
        const int sec = u.pn >> 2, pq = u.pn & 3;
#pragma unroll
        for (int ai = 0; ai < 2; ++ai)
#pragma unroll
            for (int m = 0; m < 4; ++m) {
                const int row = u.pm * 256 + ai * 128 + wr * 64 + m * 16 + fr;
                const bool lat = row < ROWS_L;
                const int b = lat ? row >> 11 : (row - ROWS_L) >> 8, tok = lat ? row & 2047 : (row - ROWS_L) & 255;
                const int kp = lat ? NC + tok : tok;
                {
                    const int pos = (wc & 1) ? (tok & 63) : (tok >> 6);
                    bf16_t* dst = sec == 0 ? (bf16_t*)(ws + OV_Q1) + (size_t)row * DM : (bf16_t*)(ws + OV_K1) + ((size_t)b * NPOS + kp) * DM;
#pragma unroll
                    for (int bj = 0; bj < 2; ++bj) {
                        const float qs = sec == 0 ? QSCALE : 1.0f;
                        f32x4 x0 = acc[ai][bj][m][0] * qs, x1 = acc[ai][bj][m][1] * qs;
                        if (lat) rope_pair(x0, x1, tab, pos, fq);
                        st_bf16_pair(dst + pq * 256 + bj * 128 + wc * 32, fq, x0, x1);
                    }
                }
            }
    }
};
DI int crow(int r, int hi) { return (r & 3) + 8 * (r >> 2) + 4 * hi; }
constexpr float ATT_C2 = 0.125f * 1.4426950408889634f;
constexpr int VPITCH = 144;
constexpr int ATT_BUF = 16384 + 128 * VPITCH;
constexpr int ATT_K_OFF = 0, ATT_V_OFF = 16384, ATT_WS_OFF = 3 * ATT_BUF, ATT_X_OFF = 0;
constexpr float ATT_THR = 8.0f;
struct AttnJob {
    const bf16_t* q; int qld;
    const bf16_t* k; int kld;
    const bf16_t* vt; int vld;
    int kchunk0;
    int nt;
    int nfree;
    int wpos0;
    int qpos0;
};
DI float xhalf(float v) {
    const unsigned u = __builtin_bit_cast(unsigned, v);
    auto r = __builtin_amdgcn_permlane32_swap(u, u, false, false);
    return __builtin_bit_cast(float, (threadIdx.x & 32) ? r[0] : r[1]);
}
template <int X> DI float xswz(float v) {
    return __builtin_bit_cast(float, __builtin_amdgcn_ds_swizzle(__builtin_bit_cast(int, v), (X << 10) | 0x1f));
}
DI int opaque(int x) { asm volatile("" : "+v"(x)); return x; }
DI float fmax3(float a, float b, float c) { return __builtin_fmaxf(__builtin_fmaxf(a, b), c); }
template <int DV, int KW, bool WINDOW>
DI void attn_core(LAS unsigned char* lds, const AttnJob& J, f32x16 (&o)[DV / 32], float& m_out, float& l_out) {
    constexpr int NDB = DV / 32, ROWB = KW * 2, NKC = KW / 8;
    const int tid = opaque(threadIdx.x), lane = tid & 63, r32 = lane & 31, hi = lane >> 5;
    bf16x8 qf[4];
#pragma unroll
    for (int ks = 0; ks < 4; ++ks) qf[ks] = *(const bf16x8*)(J.q + (size_t)r32 * J.qld + ks * 16 + hi * 8);
#pragma unroll
    for (int d = 0; d < NDB; ++d)
#pragma unroll
        for (int r = 0; r < 16; ++r) o[d][r] = 0.f;
    float mref = 0.f, l = 0.f;
    f32x16 negm;
#pragma unroll
    for (int r = 0; r < 16; ++r) negm[r] = 0.f;
    u32x4 kreg[KW / 64], vreg[DV / 64];
#define ATT_LOAD(t) do { const int k0_ = (t) < J.nfree ? (t) * 64 : NC + J.wpos0 + ((t) - J.nfree) * 64; \
        _Pragma("unroll") for (int i = 0; i < KW / 64; ++i) { const int c = tid + 512 * i, row = c / NKC, ch = c % NKC; kreg[i] = *(const u32x4*)(J.k + (size_t)(k0_ + row) * J.kld + ch * 8); } \
        _Pragma("unroll") for (int i = 0; i < DV / 64; ++i) { const int c = tid + 512 * i, row = c >> 3, ch = c & 7; vreg[i] = *(const u32x4*)(J.vt + (size_t)row * J.vld + k0_ + ch * 8); } } while (0)
#define ATT_STORE(buf) do { LAS unsigned char* Kw_ = lds + (buf) * ATT_BUF + ATT_K_OFF; LAS unsigned char* Vw_ = lds + (buf) * ATT_BUF + ATT_V_OFF; \
        _Pragma("unroll") for (int i = 0; i < KW / 64; ++i) { const int c = tid + 512 * i, row = c / NKC, ch = c % NKC; const int sw = KW == 128 ? (row & 15) : ((row >> 1) & 7); \
            *(LAS u32x4*)(Kw_ + row * ROWB + ((ch ^ sw) << 4)) = kreg[i]; } \
        _Pragma("unroll") for (int i = 0; i < DV / 64; ++i) { const int c = tid + 512 * i, row = c >> 3, ch = c & 7; LAS unsigned char* p_ = Vw_ + row * VPITCH + ((ch >> 1) * 16 + (ch & 1) * 4) * 2; \
            *(LAS u32x2*)p_ = (u32x2){vreg[i].x, vreg[i].y}; *(LAS u32x2*)(p_ + 16) = (u32x2){vreg[i].z, vreg[i].w}; } } while (0)
#define ATT_SOFTMAX(s, t_, hh_, pa0, pa1) do { \
        if (WINDOW && (t_) >= J.nfree) { const int qp_ = J.qpos0 + r32, kp0_ = J.wpos0 + ((t_) - J.nfree) * 64 + (hh_) * 32; \
            _Pragma("unroll") for (int r = 0; r < 16; ++r) { const int d0_ = kp0_ + crow(r, hi) - qp_; if (d0_ > 128 || d0_ < -128) s[r] = -1e30f; } } \
        float mx_ = fmax3(s[0], s[1], s[2]); \
        _Pragma("unroll") for (int r = 3; r < 15; r += 2) mx_ = fmax3(mx_, s[r], s[r + 1]); \
        mx_ = __builtin_fmaxf(mx_, s[15]); mx_ = __builtin_fmaxf(mx_, xhalf(mx_)); \
        if (__any(mx_ > ATT_THR)) { const float dl_ = __builtin_fmaxf(mx_, 0.f), f_ = __builtin_amdgcn_exp2f(-dl_); mref += dl_; l *= f_; \
            _Pragma("unroll") for (int r = 0; r < 16; ++r) { s[r] -= dl_; negm[r] = -mref; } \
            ATT_RESC_OTHER(dl_); \
            LAS float* wsf_ = (LAS float*)(lds + ATT_WS_OFF) + (tid >> 6) * 32; if (hi == 0) wsf_[r32] = f_; \
            _Pragma("unroll") for (int r = 0; r < 16; ++r) { const float g_ = wsf_[crow(r, hi)]; _Pragma("unroll") for (int d = 0; d < NDB; ++d) o[d][r] *= g_; } } \
        float ls_ = 0.f; \
        _Pragma("unroll") for (int r = 0; r < 16; ++r) { s[r] = __builtin_amdgcn_exp2f(s[r]); ls_ += s[r]; } \
        l += ls_; \
        { u32x4 w0_, w1_; w0_.x = pk2(s[0], s[1]); w0_.y = pk2(s[2], s[3]); w0_.z = pk2(s[4], s[5]); w0_.w = pk2(s[6], s[7]); \
          w1_.x = pk2(s[8], s[9]); w1_.y = pk2(s[10], s[11]); w1_.z = pk2(s[12], s[13]); w1_.w = pk2(s[14], s[15]); \
          pa0 = __builtin_bit_cast(bf16x8, w0_); pa1 = __builtin_bit_cast(bf16x8, w1_); } } while (0)
#define ATT_QK(s, Kb_, hh_) do { s = negm; \
        _Pragma("unroll") for (int ks = 0; ks < 4; ++ks) { const int ch_ = J.kchunk0 + ks * 2 + hi; const int sw_ = KW == 128 ? (r32 & 15) : ((r32 >> 1) & 7); \
            const bf16x8 kf_ = *(const LAS bf16x8*)((Kb_) + ((hh_) * 32 + r32) * ROWB + ((ch_ ^ sw_) << 4)); \
            s = __builtin_amdgcn_mfma_f32_32x32x16_bf16(kf_, qf[ks], s, 0, 0, 0); } } while (0)
#define ATT_PV(Vb_, hh_, pa0, pa1) do { \
        _Pragma("unroll") for (int d = 0; d < NDB; ++d) { \
            const bf16x8 v0_ = *(const LAS bf16x8*)((Vb_) + (d * 32 + r32) * VPITCH + ((2 * (hh_)) * 16 + hi * 8) * 2); \
            const bf16x8 v1_ = *(const LAS bf16x8*)((Vb_) + (d * 32 + r32) * VPITCH + ((2 * (hh_) + 1) * 16 + hi * 8) * 2); \
            o[d] = __builtin_amdgcn_mfma_f32_32x32x16_bf16(pa0, v0_, o[d], 0, 0, 0); \
            o[d] = __builtin_amdgcn_mfma_f32_32x32x16_bf16(pa1, v1_, o[d], 0, 0, 0); } } while (0)
    __syncthreads();
    ATT_LOAD(0); ATT_STORE(0);
    if (J.nt > 1) ATT_LOAD(1);
    __syncthreads();
    f32x16 sa, sb;
    ATT_QK(sa, lds + ATT_K_OFF, 0);
    int cur = 0;
    for (int t = 0; t < J.nt; ++t) {
        const int nxt = cur == 2 ? 0 : cur + 1;
        if (t + 1 < J.nt) ATT_STORE(nxt);
        if (t + 2 < J.nt) ATT_LOAD(t + 2);
        __syncthreads();
        LAS unsigned char* Kb = lds + cur * ATT_BUF + ATT_K_OFF; LAS unsigned char* Vb = lds + cur * ATT_BUF + ATT_V_OFF;
        bf16x8 p0, p1;
#define ATT_RESC_OTHER(dl) do { _Pragma("unroll") for (int r = 0; r < 16; ++r) sb[r] -= (dl); } while (0)
        ATT_QK(sb, Kb, 1);
        ATT_SOFTMAX(sa, t, 0, p0, p1);
        ATT_PV(Vb, 0, p0, p1);
#undef ATT_RESC_OTHER
#define ATT_RESC_OTHER(dl) do { _Pragma("unroll") for (int r = 0; r < 16; ++r) sa[r] -= (dl); } while (0)
        if (t + 1 < J.nt) ATT_QK(sa, lds + nxt * ATT_BUF + ATT_K_OFF, 0);
        ATT_SOFTMAX(sb, t, 1, p0, p1);
        ATT_PV(Vb, 1, p0, p1);
#undef ATT_RESC_OTHER
        cur = nxt;
    }
    __syncthreads();
#undef ATT_SOFTMAX
#undef ATT_QK
#undef ATT_PV
#undef ATT_LOAD
#undef ATT_STORE
    m_out = mref; l_out = l + xhalf(l);
}
template <int NDB> DI void attn_scale_rows(LAS unsigned char* lds, f32x16 (&o)[NDB], float f) {
    const int tid = opaque(threadIdx.x), lane = tid & 63, r32 = lane & 31, hi = lane >> 5;
    LAS float* wsf = (LAS float*)(lds + ATT_WS_OFF) + (tid >> 6) * 32;
    if (hi == 0) wsf[r32] = f;
#pragma unroll
    for (int r = 0; r < 16; ++r) { const float g = wsf[crow(r, hi)];
#pragma unroll
        for (int d = 0; d < NDB; ++d) o[d][r] *= g; }
}
DI void pwin_attn_phase(const Args& a, LAS unsigned char* lds, int G, int stage, int& conv_pos) {
    const int tid = threadIdx.x, wave = __builtin_amdgcn_readfirstlane(tid >> 6);
    const bf16_t* Q0 = (const bf16_t*)(a.ws + OV_Q0); const bf16_t* K0 = (const bf16_t*)(a.ws + OV_K0); const bf16_t* VT0 = (const bf16_t*)(a.ws + OV_VT0);
    bf16_t* MIX = (bf16_t*)(a.ws + WS_MIX);
    const int bx = (int)blockIdx.x;
    int first, step, count;
    if (G != 256) { first = (bx - 160 % G + G) % G; step = G; count = stage == 0 ? (576 - first + G - 1) / G : 0; }
    else if (stage == 0) { first = (bx + 96) & 255; step = 256; count = first < 144 ? 2 : 1; }
    else if (stage == 1) { first = 400 + (bx - 192); step = 1; count = bx >= 192 ? 1 : 0; }
    else { const int c = (bx + 64) & 255; first = 464 + (c - 144); step = 1; count = c >= 144 ? 1 : 0; }
    const int conv_at = stage == 0 ? ((bx & 1) < count ? (bx & 1) : count) : -1;
    for (int ku = 0; ku <= count; ++ku) {
        if (ku == conv_at) steal_conv(a, lds, G, 3, 0, false, conv_pos);
        if (ku == count) break;
        const int it = first + step * ku;
        AttnJob J; int qh, row0;
        int b, kvh;
        if (it < 512) {
            b = it >> 6; kvh = (it >> 5) & 1; const int nb = (it >> 1) & 15, pr = it & 1;
            qh = kvh * 4 + pr * 2 + (wave >> 2); const int ql = nb * 128 + (wave & 3) * 32; row0 = b * NL + ql;
            const int first = nb == 0 ? 0 : (nb - 1) * 128, last = nb == 15 ? NL : (nb + 2) * 128;
            J.nfree = 4; J.nt = 4 + (last - first) / 64; J.wpos0 = first; J.qpos0 = ql;
        } else {
            const int r = it - 512; b = r >> 3; kvh = (r >> 2) & 1; const int idx = (r & 3) * 8 + wave;
            qh = kvh * 4 + (idx >> 3); row0 = ROWS_L + b * NC + (idx & 7) * 32;
            J.nfree = 4; J.nt = 4; J.wpos0 = 0; J.qpos0 = 0;
        }
        J.q = Q0 + (size_t)row0 * 512 + qh * 64; J.qld = 512;
        J.k = K0 + (size_t)b * NPOS * 128 + kvh * 64; J.kld = 128;
        J.vt = VT0 + (size_t)(b * 2 + kvh) * 64 * NPOS; J.vld = NPOS;
        J.kchunk0 = 0;
        f32x16 o[2]; float m, l;
        attn_core<64, 64, true>(lds, J, o, m, l);
        l += exp2f(a.in[I_SINK][qh] * 1.4426950408889634f - m);
        attn_scale_rows<2>(lds, o, 1.0f / l);
        const int tid2 = opaque(threadIdx.x), r32 = tid2 & 31, hi = (tid2 >> 5) & 1;
#pragma unroll
        for (int d = 0; d < 2; ++d)
#pragma unroll
            for (int r = 0; r < 16; ++r)
                MIX[(size_t)(row0 + crow(r, hi)) * DM + 512 + qh * 64 + d * 32 + r32] = (bf16_t)f2bf(o[d][r]);
    }
}
DI void pdiff_attn_phase(const Args& a, LAS unsigned char* lds, int G, int& conv_pos) {
    const int tid = threadIdx.x, lane = tid & 63, wave = __builtin_amdgcn_readfirstlane(tid >> 6);
    const bf16_t* Q1 = (const bf16_t*)(a.ws + OV_Q1); const bf16_t* K1 = (const bf16_t*)(a.ws + OV_K1); const bf16_t* VT1 = (const bf16_t*)(a.ws + OV_VT1);
    bf16_t* MIX = (bf16_t*)(a.ws + WS_MIX);
    float d1 = a.in[I_LQ1][lane] * a.in[I_LK1][lane], d2 = a.in[I_LQ2][lane] * a.in[I_LK2][lane];
    d1 = wave_sum(d1); d2 = wave_sum(d2);
    const float lam = expf(d1) - expf(d2) + LAM_INIT1;
    int ku = 0;
    const int vcu = (G % 8 == 0) ? (int)(blockIdx.x % 8) * (G / 8) + (int)(blockIdx.x / 8) : (int)blockIdx.x;
    for (int it = vcu; it < 1024; it += G, ++ku) {
        if (ku == (int)(blockIdx.x & 3)) steal_conv(a, lds, G, 14, 1, false, conv_pos);
        const int b = it >> 7, h = (it >> 4) & 7, qb = it & 15, mp = wave >> 2;
        const int row0 = b * NL + qb * 128 + (wave & 3) * 32;
        AttnJob J;
        J.q = Q1 + (size_t)row0 * DM + h * 128 + mp * 64; J.qld = DM;
        J.k = K1 + (size_t)b * NPOS * DM + h * 128; J.kld = DM;
        J.vt = VT1 + (size_t)(b * 8 + h) * 128 * NPOS; J.vld = NPOS;
        J.kchunk0 = mp * 8; J.nt = NPOS / 64; J.nfree = NPOS / 64; J.wpos0 = 0; J.qpos0 = 0;
        f32x16 o[4]; float m, l;
        attn_core<128, 128, false>(lds, J, o, m, l);
        attn_scale_rows<4>(lds, o, 1.0f / l);
        const int tid2 = opaque(threadIdx.x), r32 = tid2 & 31, hi = (tid2 >> 5) & 1;
        __syncthreads();
        LAS float* xb = (LAS float*)(lds + ATT_X_OFF) + (wave & 3) * 32 * 128;
        if (mp == 1) {
#pragma unroll
            for (int d = 0; d < 4; ++d)
#pragma unroll
                for (int r = 0; r < 16; ++r) xb[crow(r, hi) * 128 + d * 32 + r32] = o[d][r];
        }
        __syncthreads();
        if (mp == 0) {
            float ss[16];
#pragma unroll
            for (int r = 0; r < 16; ++r) {
                float s = 0.f;
#pragma unroll
                for (int d = 0; d < 4; ++d) { const float v = o[d][r] - lam * xb[crow(r, hi) * 128 + d * 32 + r32]; o[d][r] = v; s += v * v; }
                ss[r] = s;
            }
#pragma unroll
            for (int r = 0; r < 16; ++r) {
                ss[r] += xswz<1>(ss[r]); ss[r] += xswz<2>(ss[r]); ss[r] += xswz<4>(ss[r]); ss[r] += xswz<8>(ss[r]); ss[r] += xswz<16>(ss[r]);
                ss[r] = (1.0f - LAM_INIT1) / sqrtf(ss[r] * (1.0f / 128.0f) + NORM_EPS);
            }
#pragma unroll
            for (int d = 0; d < 4; ++d) {
                const float gsub = a.in[I_SUBLN][d * 32 + r32];
#pragma unroll
                for (int r = 0; r < 16; ++r)
                    MIX[(size_t)(row0 + crow(r, hi)) * DM + h * 128 + d * 32 + r32] = (bf16_t)f2bf(o[d][r] * ss[r] * gsub);
            }
        }
        __syncthreads();
    }
}
__global__ void __launch_bounds__(NTHREADS, 2) fwd_megakernel(Args a) {
    extern __shared__ __attribute__((aligned(16))) unsigned char lds_raw[];
    LAS unsigned char* lds = (LAS unsigned char*)lds_raw;
    volatile LAS unsigned* MISC = (volatile LAS unsigned*)(lds + MISC_OFF);
    const int tid = threadIdx.x, G = gridDim.x;
    for (int u = tid; u < (LDS_BYTES - RING_BYTES) / 4; u += NTHREADS) ((LAS unsigned*)(lds + RING_BYTES))[u] = 0u;
    __syncthreads();
    unsigned char* ws = a.ws;
    XcdBarrier bar = xcd_barrier_post((unsigned*)(ws + WS_CTL) + 4096, MISC + 8);
    const int lo = a.ph_lo, hi = a.ph_hi;
#ifndef DUP_MASK
#define DUP_MASK 0u
#endif
#define IN(k) (lo <= (k) && (k) < hi)
#define REP(k) for (int rep_ = 0; rep_ < 1 + (int)((DUP_MASK >> (k)) & 1u); ++rep_)
#ifdef PROBE_A
    unsigned long long* ts = (unsigned long long*)(ws + WS_DBG);
    if (blockIdx.x == 0 && tid == 0) ts[0] = __builtin_amdgcn_s_memrealtime();
#define SEAM(k) do { xcd_barrier(bar); if (blockIdx.x == 0 && tid == 0) ts[(k) + 1] = __builtin_amdgcn_s_memrealtime(); } while (0)
#else
#define SEAM(k) do { if (IN(k) && IN((k) + 1)) xcd_barrier(bar, (k) == 9 || (k) == 12 || (k) == 15); } while (0)
#endif
    const int cblk = (int)blockIdx.x;
    int conv_pos = 0;
#define ROT(r) ((cblk + (r)) % G)
    if (IN(0)) REP(0) { p0_phase(a, lds, G); } SEAM(0);
    if (IN(1)) REP(1) { p1_phase(a, lds, G); } SEAM(1);
    if (IN(2)) REP(2) {
        pg8::Gemm g{(const bf16_t*)(ws + WS_HX), (const bf16_t*)(ws + WS_WIN0T), 1024, 1024, 1024}; pg8::StaticOrder S; S.init(ROWS, 1280, G, cblk);
        EpiWin0 E{ws}; pg8::gemm_phase<EpiWin0, pg8::StaticOrder, true, true>(lds, g, S, E);
        {
            const int first_idle = (G < 360 && G >= 180) ? 360 - G : 0;
            if (cblk >= first_idle) toeplitz_fill(a, (cblk - first_idle) * NWAVES + __builtin_amdgcn_readfirstlane(tid >> 6), (G - first_idle) * NWAVES, tid & 63);
        }
    } SEAM(2);
    if (IN(3)) REP(3) {
        pg8::Gemm g{(const bf16_t*)(ws + OV_AS5), (const bf16_t*)(ws + OV_BTA), 512, S5_KC, 512}; GroupOrder S; S.init(S5G, 3, 1, G, ROT(G - 64));
        EpiS5a E{ws}; pg8::gemm_phase<EpiS5a, GroupOrder, true, true>(lds, g, S, E);
        pwin_attn_phase(a, lds, G, 0, conv_pos);
    } SEAM(3);
    if (IN(4)) REP(4) { ps5_rec_phase(a, G); } SEAM(4);
    if (IN(5)) REP(5) {
        pg8::Gemm g{(const bf16_t*)(ws + OV_AS5), (const bf16_t*)(ws + OV_BTC), S5_KC, S5_KC, S5_KC}; GroupOrder S; S.init(S5G, 3, 2, G, cblk);
        EpiS5c E{ws, a.in[I_S5D]}; pg8::gemm_phase<EpiS5c, GroupOrder, true, true>(lds, g, S, E);
        pwin_attn_phase(a, lds, G, 1, conv_pos);
    } SEAM(5);
    if (IN(6)) REP(6) {
        pg8::Gemm g{(const bf16_t*)(ws + OV_Z), (const bf16_t*)(ws + WS_WGLUT), 512, 512, 512}; pg8::StaticOrder S; S.init(ROWS, 512, G, ROT(G - 192));
        EpiGlu E{ws, a.in[I_GLUB]}; pg8::gemm_phase<EpiGlu, pg8::StaticOrder, true, true>(lds, g, S, E);
        pwin_attn_phase(a, lds, G, 2, conv_pos);
    } SEAM(6);
    if (IN(7)) REP(7) {
        pg8::Gemm g{(const bf16_t*)(ws + WS_MIX), (const bf16_t*)(ws + WS_WOUT0T), 1024, 1024, 1024}; pg8::StaticOrder S; S.init(ROWS, 1024, G, ROT(G - 80));
        EpiResid E{ws, a.in[I_X], a.in[I_CTX], 0}; pg8::gemm_phase<EpiResid, pg8::StaticOrder, true, true>(lds, g, S, E);
    } SEAM(7);
    if (IN(8)) REP(8) { pnorm_router_phase(a, lds, G, 0, ROWS); } SEAM(8);
    if (IN(9)) REP(9) { ptopk_phase(a, lds, G, 1, 2304); } if (IN(9)) steal_conv(a, lds, G, 9, 0, false, conv_pos); SEAM(9);
    if (IN(10)) REP(10) {
        GroupOrder S; S.init(NE, 9, 16, G, cblk);
        LAS int* gidx = (LAS int*)(lds + RING_BYTES + 1024);
        for (int i = 0;; ++i) { pg8::Unit u; if (!S.next(i, u)) break; if (tid < 256) gidx[i * 256 + tid] = ((const int*)(ws + WS_SELROW))[(size_t)u.pm * 256 + tid]; }
        __syncthreads();
        pg8::Gemm g{(const bf16_t*)(ws + WS_HX), (const bf16_t*)(ws + WS_W1T), 1024, 1024, 1024};
        EpiSwiglu E{ws, 9}; pg8::gemm_phase<EpiSwiglu, GroupOrder, true, true, true>(lds, g, S, E, gidx);
    } SEAM(10);
    if (IN(11)) REP(11) {
        pg8::Gemm g{(const bf16_t*)(ws + OV_HID), (const bf16_t*)(ws + WS_W2T), 2048, 2048, 2048}; GroupOrder S; S.init(NE, 9, 4, G, ROT(G - 112));
        EpiMoeOut E{ws}; pg8::gemm_phase<EpiMoeOut, GroupOrder, true, true>(lds, g, S, E);
    } SEAM(11);
    if (IN(12)) REP(12) { pcombine_phase(a, G, 0, ROWS, 2304); } SEAM(12);
    if (IN(13)) REP(13) {
        pg8::Gemm g{(const bf16_t*)(ws + WS_HX), (const bf16_t*)(ws + WS_WIN1T), 1024, 1024, 1024}; Win1Order S; S.init(G, ROT(G - 176));
        EpiWin1 E{ws}; pg8::gemm_phase<EpiWin1, Win1Order, true, true>(lds, g, S, E);
    } SEAM(13);
    if (IN(14)) REP(14) { pdiff_attn_phase(a, lds, G, conv_pos); } SEAM(14);
    if (IN(15)) REP(15) {
        pg8::Gemm g{(const bf16_t*)(ws + WS_MIX), (const bf16_t*)(ws + WS_WOUT1T), 1024, 1024, 1024}; pg8::StaticOrder S; S.init(ROWS_L, 1024, G, cblk);
        EpiResid E{ws, a.in[I_X], a.in[I_CTX], 1}; pg8::gemm_phase<EpiResid, pg8::StaticOrder, true, true>(lds, g, S, E);
    } SEAM(15);
    if (IN(16)) REP(16) { pnorm_router_phase(a, lds, G, 1, ROWS_L); } SEAM(16);
    if (IN(17)) REP(17) { ptopk_phase(a, lds, G, 0, 2048); } if (IN(17)) steal_conv(a, lds, G, 17, 1, false, conv_pos); SEAM(17);
    if (IN(18)) REP(18) {
        GroupOrder S; S.init(NE, 8, 16, G, cblk);
        LAS int* gidx = (LAS int*)(lds + RING_BYTES + 1024);
        for (int i = 0;; ++i) { pg8::Unit u; if (!S.next(i, u)) break; if (tid < 256) gidx[i * 256 + tid] = ((const int*)(ws + WS_SELROW))[(size_t)u.pm * 256 + tid]; }
        __syncthreads();
        pg8::Gemm g{(const bf16_t*)(ws + WS_HX), (const bf16_t*)(ws + WS_W1T) + (size_t)16 * 4096 * 1024, 1024, 1024, 1024};
        EpiSwiglu E{ws, 8}; pg8::gemm_phase<EpiSwiglu, GroupOrder, true, true, true>(lds, g, S, E, gidx);
    } SEAM(18);
    if (IN(19)) REP(19) {
        pg8::Gemm g{(const bf16_t*)(ws + OV_HID), (const bf16_t*)(ws + WS_W2T) + (size_t)16 * 1024 * 2048, 2048, 2048, 2048}; GroupOrder S; S.init(NE, 8, 4, G, cblk);
        EpiMoeOut E{ws}; pg8::gemm_phase<EpiMoeOut, GroupOrder, true, true>(lds, g, S, E);
    } SEAM(19);
    if (IN(20)) REP(20) { pcombine_phase(a, G, 1, ROWS_L, 2048); }
#ifdef PROBE_A
    SEAM(20);
    xcd_barrier(bar);
    {
        const float da = (float)(ts[PROBE_A + 1] - ts[PROBE_A]) * 0.01f, db = (float)(ts[PROBE_B + 1] - ts[PROBE_B]) * 0.01f;
        const float c = 2.0f * logf(fmaxf(da, 1.0f));
        for (size_t i = (size_t)blockIdx.x * NTHREADS + tid; i < (size_t)ROWS_L * DM; i += (size_t)G * NTHREADS) a.out[i] = (i == 0) ? db : c;
    }
#endif
#undef IN
#undef SEAM
}

extern "C" void kernel_launch(void* const* d_in, const int* in_sizes, int n_in, void* d_out, int out_size, void* d_ws, size_t ws_size, hipStream_t stream) {
    static int grid = 0;
    if (grid == 0) {
        if (n_in != 33 || out_size != ROWS_L * DM || ws_size < WS_END) { fprintf(stderr, "kernel_launch: unexpected shapes (n_in %d, out %d, ws %zu; need ws >= %zu)\n", n_in, out_size, ws_size, (size_t)WS_END); grid = -1; return; }
        int dev = 0, cus = 0, per_cu = 0;
        if (hipGetDevice(&dev) != hipSuccess || hipDeviceGetAttribute(&cus, hipDeviceAttributeMultiprocessorCount, dev) != hipSuccess) { grid = -1; return; }
        if (hipFuncSetAttribute((const void*)fwd_megakernel, hipFuncAttributeMaxDynamicSharedMemorySize, LDS_BYTES) != hipSuccess) { fprintf(stderr, "kernel_launch: hipFuncSetAttribute failed\n"); grid = -1; return; }
        if (hipOccupancyMaxActiveBlocksPerMultiprocessor(&per_cu, (const void*)fwd_megakernel, NTHREADS, LDS_BYTES) != hipSuccess || per_cu < 1) { fprintf(stderr, "kernel_launch: occupancy query reports %d\n", per_cu); }
        (void)hipGetLastError();
        grid = cus;
    }
    if (grid < 0) return;
    (void)hipMemsetAsync((char*)d_ws + WS_CTL, 0, CTL_BYTES, stream);
    Args a{};
    for (int i = 0; i < 33; ++i) a.in[i] = (const float*)d_in[i];
    a.out = (float*)d_out; a.ws = (unsigned char*)d_ws; a.ph_lo = 0; a.ph_hi = 21;
    hipLaunchKernelGGL(fwd_megakernel, dim3(grid), dim3(NTHREADS), LDS_BYTES, stream, a);
}
```
